# Optimizing an MI355X kernel written in HIP

```python
import math
import jax
import jax.numpy as jnp
from jax import lax
import numpy as np

D_MODEL = 1024
BATCH = 4
SEQ = 8192
DEPTH = 1

GRID_W = 64
CTX_LEN = 256
NH_A = 8
DK_A = 64
DV_A = 128
D_A = NH_A * DV_A
CHUNK = 128
GATE_CAP = 15.0
NH_B = 16
DH_B = 64
D_B = NH_B * DH_B
WIN_R = 8
WIN_C = 16
QB_R_MAX = 8
QB_C = 16
D_FF = -(-8 * D_MODEL // (3 * 256)) * 256
ROPE_THETA = 10000.0
EPS = 1e-6
N_MOD = 6
_PART_NAMES = ('q_a', 'k_a', 'v_a', 'o_a', 'gates_a', 'q_b', 'k_b', 'v_b', 'merge')
_PART_SIZES = (NH_A * DK_A, NH_A * DK_A, D_A, D_A, 4 * NH_A, D_B, D_B, D_B, 2 * D_MODEL)
D_IN = sum(_PART_SIZES)

kernel_name = 'hybrid_mlstm_natten_dit_layer'


def _rmsnorm(x, g):
    xf = x.astype(jnp.float32)
    y = xf * lax.rsqrt(jnp.mean(xf * xf, axis=-1, keepdims=True) + EPS)
    return (y * g.astype(jnp.float32)).astype(x.dtype)


def _proj(h, w_in, names):
    offs = np.cumsum((0,) + _PART_SIZES)
    sel = [i for i, n in enumerate(_PART_NAMES) if n in names]
    if len(sel) == len(_PART_NAMES):
        w = w_in
    else:
        w = jnp.concatenate([w_in[:, int(offs[i]):int(offs[i + 1])] for i in sel], axis=1)
    sizes = [_PART_SIZES[i] for i in sel]
    parts = jnp.split(h @ w, [int(s) for s in np.cumsum(sizes)[:-1]], axis=-1)
    return {_PART_NAMES[i]: p for i, p in zip(sel, parts)}


def _rope_axis(x, pos):
    half = x.shape[-1] // 2
    inv = ROPE_THETA ** (-jnp.arange(half, dtype=jnp.float32) / half)
    ang = pos.astype(jnp.float32)[:, None] * inv
    cos, sin = jnp.cos(ang)[:, None, :], jnp.sin(ang)[:, None, :]
    x1 = x[..., :half].astype(jnp.float32)
    x2 = x[..., half:].astype(jnp.float32)
    return jnp.concatenate([x1 * cos - x2 * sin, x2 * cos + x1 * sin], axis=-1).astype(x.dtype)


def _rope2d(x, row, col):
    d = x.shape[-1] // 2
    return jnp.concatenate([_rope_axis(x[..., :d], row), _rope_axis(x[..., d:], col)], axis=-1)


def _zero_state(b):
    return (jnp.zeros((b, NH_A, DK_A, DV_A), jnp.float32),
            jnp.zeros((b, NH_A, DK_A), jnp.float32),
            jnp.zeros((b, NH_A), jnp.float32))


def _mlstm_inputs(p, b_g, pos):
    bn, L, _ = p['q_a'].shape
    q = p['q_a'].reshape(bn, L, NH_A, DK_A)
    k = p['k_a'].reshape(bn, L, NH_A, DK_A)
    if pos is not None:
        q = _rope2d(q, pos[0], pos[1])
        k = _rope2d(k, pos[0], pos[1])
    v = p['v_a'].reshape(bn, L, NH_A, DV_A)
    bhl = lambda t: t.astype(jnp.float32).transpose(0, 2, 1, 3)
    g = p['gates_a'].reshape(bn, L, 4, NH_A).astype(jnp.float32) + b_g.astype(jnp.float32)
    g = GATE_CAP * jnp.tanh(g / GATE_CAP)
    g = g.transpose(2, 0, 3, 1)
    return (bhl(q) * DK_A ** -0.5, bhl(k), bhl(v),
            g[0], jax.nn.log_sigmoid(g[1]), g[2], jax.nn.log_sigmoid(g[3]))


def _mlstm_scan(q, k, v, ig, lf, state, with_output):
    bn, nh, L, _ = q.shape
    lc = min(CHUNK, L)
    nc = L // lc

    def to_chunks(t):
        t = t.reshape(t.shape[:2] + (nc, lc) + t.shape[3:])
        return jnp.moveaxis(t, 2, 0)

    causal = jnp.tril(jnp.ones((lc, lc), dtype=bool))

    def body(carry, xs):
        C, n, m = carry
        qc, kc, vc, igc, lfc = xs
        b = jnp.cumsum(lfc, axis=-1)
        b_last = b[..., -1]
        g_end = b_last[..., None] - b + igc
        m_new = jnp.maximum(b_last + m, jnp.max(g_end, axis=-1))
        w_end = jnp.exp(g_end - m_new[..., None])
        decay = jnp.exp(b_last + m - m_new)
        kw = kc * w_end[..., None]
        C_new = decay[..., None, None] * C + jnp.einsum('bhsd,bhse->bhde', kw, vc)
        n_new = decay[..., None] * n + jnp.sum(kw, axis=2)
        if not with_output:
            return (C_new, n_new, m_new), None
        log_d = jnp.where(causal, b[..., :, None] - b[..., None, :] + igc[..., None, :], -jnp.inf)
        log_inter = b + m[..., None]
        m_t = jnp.maximum(log_inter, jnp.max(log_d, axis=-1))
        a = jnp.exp(log_inter - m_t)
        s = jnp.einsum('bhtd,bhsd->bhts', qc, kc) * jnp.exp(log_d - m_t[..., None])
        num = a[..., None] * jnp.einsum('bhtd,bhde->bhte', qc, C) + jnp.einsum('bhts,bhse->bhte', s, vc)
        den = a * jnp.einsum('bhtd,bhd->bht', qc, n) + jnp.sum(s, axis=-1)
        h = num / jnp.maximum(jnp.abs(den), jnp.exp(-m_t))[..., None]
        return (C_new, n_new, m_new), h

    state, h = lax.scan(body, state, tuple(to_chunks(t) for t in (q, k, v, ig, lf)))
    if with_output:
        h = jnp.moveaxis(h, 0, 2).reshape(bn, nh, L, DV_A)
    return h, state


def _mlstm_bidir(inp, states0, with_output):
    q, k, v, ig_f, lf_f, ig_b, lf_b = inp
    h_f, st_f = _mlstm_scan(q, k, v, ig_f, lf_f, states0[0], with_output)
    fl = lambda t: jnp.flip(t, axis=2)
    h_b, st_b = _mlstm_scan(fl(q), fl(k), fl(v), fl(ig_b), fl(lf_b), states0[1], with_output)
    h = h_f + fl(h_b) if with_output else None
    return h, st_f, st_b


def _qk_norm(t, g):
    bn, L, _ = t.shape
    return _rmsnorm(t.reshape(bn, L, NH_B, DH_B), g)


def _axis_blocks(n, k, qb):
    kb = min(k + qb - 1, n)
    q0 = np.arange(0, n, qb)
    kstart = np.clip(q0 - k // 2, 0, n - kb)
    qpos = q0[:, None] + np.arange(qb)
    kpos = kstart[:, None] + np.arange(kb)
    wstart = np.clip(qpos - k // 2, 0, n - k)
    inwin = (kpos[:, None, :] >= wstart[:, :, None]) & (kpos[:, None, :] < wstart[:, :, None] + k)
    off = kpos[:, None, :] - qpos[:, :, None]
    return kpos, inwin, off


def _neighbourhood_attention(q, k, v, kc, vc, rpb, rows):
    bn, S, nh, d = q.shape
    kh = min(WIN_R, rows)
    qr = math.gcd(rows, QB_R_MAX)
    r_k, r_in, r_off = _axis_blocks(rows, kh, qr)
    c_k, c_in, c_off = _axis_blocks(GRID_W, WIN_C, QB_C)
    nbr, nbc = rows // qr, GRID_W // QB_C
    kr, kcol = r_k.shape[1], c_k.shape[1]
    nq, nk = qr * QB_C, kr * kcol
    ktok = (r_k[:, None, :, None] * GRID_W + c_k[None, :, None, :]).reshape(nbr, nbc, nk)
    mask = (r_in[:, None, :, None, :, None] & c_in[None, :, None, :, None, :]).reshape(nbr, nbc, nq, nk)
    dr = np.clip(r_off + WIN_R - 1, 0, 2 * WIN_R - 2)
    dc = np.clip(c_off + WIN_C - 1, 0, 2 * WIN_C - 2)
    qb = q.reshape(bn, nbr, qr, nbc, QB_C, nh, d).transpose(1, 0, 3, 2, 4, 5, 6).reshape(nbr, bn, nbc, nq, nh, d)

    def row_block(args):
        q_x, ktok_x, mask_x, dr_x = args
        kb = k[:, ktok_x]
        vb = v[:, ktok_x]
        bias = rpb[:, dr_x[None, :, None, :, None], dc[:, None, :, None, :]]
        bias = jnp.where(mask_x, bias.reshape(nh, nbc, nq, nk).astype(jnp.float32), -jnp.inf)
        s_win = jnp.einsum('byqhd,bykhd->bhyqk', q_x, kb).astype(jnp.float32) + bias[None]
        s_ctx = jnp.einsum('byqhd,bchd->bhyqc', q_x, kc).astype(jnp.float32)
        p = jax.nn.softmax(jnp.concatenate([s_win, s_ctx], axis=-1), axis=-1)
        return (jnp.einsum('bhyqk,bykhd->byqhd', p[..., :nk].astype(v.dtype), vb)
                + jnp.einsum('bhyqc,bchd->byqhd', p[..., nk:].astype(vc.dtype), vc))

    o = lax.map(row_block, (qb, jnp.asarray(ktok, jnp.int32), jnp.asarray(mask), jnp.asarray(dr, jnp.int32)))
    o = o.reshape(nbr, bn, nbc, qr, QB_C, nh, d).transpose(1, 0, 3, 2, 4, 5, 6)
    return o.reshape(bn, S, nh * d)


def _ctx_attention(q, k, v):
    bn, L, nh, d = q.shape
    s = jnp.einsum('bqhd,bkhd->bhqk', q, k).astype(jnp.float32)
    p = jax.nn.softmax(s, axis=-1).astype(v.dtype)
    return jnp.einsum('bhqk,bkhd->bqhd', p, v).reshape(bn, L, nh * d)


def _merge(h_a, o_gate, na_out, merge, g_norm, w_a, w_b, w_o):
    bn, nh, L, dv = h_a.shape
    ha = _rmsnorm(h_a.transpose(0, 2, 1, 3), g_norm.reshape(NH_A, DV_A)).reshape(bn, L, D_A)
    ha = ha.astype(o_gate.dtype) * jax.nn.sigmoid(o_gate)
    g_a, g_b = jnp.split(jax.nn.sigmoid(merge), 2, axis=-1)
    return (g_a * (ha @ w_a) + g_b * (na_out @ w_b)) @ w_o


def _swiglu(h, wg, wu, wd):
    return (jax.nn.silu(h @ wg) * (h @ wu)) @ wd


def setup_inputs(seed: int = 0) -> dict:
    key = jax.random.key(seed)
    ks = jax.random.split(key, 20)
    D = D_MODEL
    nrm = lambda kk, shape, scale: jax.random.normal(kk, shape, jnp.float32) * scale
    forget_bias = jnp.linspace(3.0, 6.0, NH_A, dtype=jnp.float32)
    gate_rows = jnp.array([0.0, 1.0, 0.0, 1.0], jnp.float32)[:, None]
    return {
        'x': nrm(ks[0], (BATCH, SEQ, D), 1.0),
        'c': nrm(ks[1], (BATCH, D), 1.0),
        'ctx': nrm(ks[2], (BATCH, CTX_LEN, D), 1.0),
        'c_ctx': nrm(ks[3], (D,), 1.0),
        'w_mod': nrm(ks[4], (DEPTH, D, N_MOD * D), 0.5 * D ** -0.5),
        'b_mod': nrm(ks[5], (DEPTH, N_MOD * D), 0.02),
        'norm1_g': 1.0 + nrm(ks[6], (DEPTH, D), 0.02),
        'w_in': nrm(ks[7], (DEPTH, D, D_IN), D ** -0.5),
        'b_gates': nrm(ks[8], (DEPTH, 4, NH_A), 0.1) + gate_rows * forget_bias,
        'mlstm_norm_g': 1.0 + nrm(ks[9], (DEPTH, D_A), 0.02),
        'qn_g': 1.0 + nrm(ks[10], (DEPTH, DH_B), 0.02),
        'kn_g': 1.0 + nrm(ks[11], (DEPTH, DH_B), 0.02),
        'rpb': nrm(ks[12], (DEPTH, NH_B, 2 * WIN_R - 1, 2 * WIN_C - 1), 0.1),
        'w_branch_a': nrm(ks[13], (DEPTH, D_A, D), D_A ** -0.5),
        'w_branch_b': nrm(ks[14], (DEPTH, D_B, D), D_B ** -0.5),
        'w_out': nrm(ks[15], (DEPTH, D, D), D ** -0.5),
        'norm2_g': 1.0 + nrm(ks[16], (DEPTH, D), 0.02),
        'w_ffn_gate': nrm(ks[17], (DEPTH, D, D_FF), D ** -0.5),
        'w_ffn_up': nrm(ks[18], (DEPTH, D, D_FF), D ** -0.5),
        'w_ffn_down': nrm(ks[19], (DEPTH, D_FF, D), D_FF ** -0.5),
    }


def reference(x, c, ctx, c_ctx, w_mod, b_mod, norm1_g, w_in, b_gates, mlstm_norm_g, qn_g, kn_g,
              rpb, w_branch_a, w_branch_b, w_out, norm2_g, w_ffn_gate, w_ffn_up, w_ffn_down):
    bn, S, _ = x.shape
    L_ctx = ctx.shape[1]
    rows = S // GRID_W
    t = jnp.arange(S)
    pos = (t // GRID_W, t % GRID_W)
    for l in range(DEPTH):
        last = l == DEPTH - 1
        sh1, sc1, g1, sh2, sc2, g2 = jnp.split(jax.nn.silu(c) @ w_mod[l] + b_mod[l], N_MOD, axis=-1)
        sh1c, sc1c, g1c, sh2c, sc2c, g2c = jnp.split(jax.nn.silu(c_ctx) @ w_mod[l] + b_mod[l], N_MOD, axis=-1)
        hx = _rmsnorm(x, norm1_g[l]) * (1.0 + sc1[:, None]) + sh1[:, None]
        hc = _rmsnorm(ctx, norm1_g[l]) * (1.0 + sc1c) + sh1c
        px = _proj(hx, w_in[l], _PART_NAMES)
        ctx_parts = _PART_NAMES if not last else ('q_a', 'k_a', 'v_a', 'gates_a', 'k_b', 'v_b')
        pc = _proj(hc, w_in[l], ctx_parts)
        hc_a, st_f, st_b = _mlstm_bidir(_mlstm_inputs(pc, b_gates[l], None),
                                        (_zero_state(bn), _zero_state(bn)), not last)
        hx_a, _, _ = _mlstm_bidir(_mlstm_inputs(px, b_gates[l], pos), (st_f, st_b), True)
        kc_b = _qk_norm(pc['k_b'], kn_g[l])
        vc_b = pc['v_b'].reshape(bn, L_ctx, NH_B, DH_B)
        qx_b = _qk_norm(px['q_b'], qn_g[l]) * DH_B ** -0.5
        kx_b = _qk_norm(px['k_b'], kn_g[l])
        vx_b = px['v_b'].reshape(bn, S, NH_B, DH_B)
        na_x = _neighbourhood_attention(qx_b, kx_b, vx_b, kc_b, vc_b, rpb[l], rows)
        mix_x = _merge(hx_a, px['o_a'], na_x, px['merge'], mlstm_norm_g[l],
                       w_branch_a[l], w_branch_b[l], w_out[l])
        x_new = x + g1[:, None] * mix_x
        hx2 = _rmsnorm(x_new, norm2_g[l]) * (1.0 + sc2[:, None]) + sh2[:, None]
        x_new = x_new + g2[:, None] * _swiglu(hx2, w_ffn_gate[l], w_ffn_up[l], w_ffn_down[l])
        if not last:
            qc_b = _qk_norm(pc['q_b'], qn_g[l]) * DH_B ** -0.5
            na_c = _ctx_attention(qc_b, kc_b, vc_b)
            mix_c = _merge(hc_a, pc['o_a'], na_c, pc['merge'], mlstm_norm_g[l],
                           w_branch_a[l], w_branch_b[l], w_out[l])
            ctx = ctx + g1c * mix_c
            hc2 = _rmsnorm(ctx, norm2_g[l]) * (1.0 + sc2c) + sh2c
            ctx = ctx + g2c * _swiglu(hc2, w_ffn_gate[l], w_ffn_up[l], w_ffn_down[l])
        x = x_new
    return x
```

```cpp
#include <hip/hip_runtime.h>
#include <cstdio>
#include <cstdint>

typedef unsigned short bf16;
#define DI __device__ __forceinline__
DI float bf2f(bf16 b) { return __uint_as_float(((unsigned)b) << 16); }
DI bf16 f2bf(float f) { unsigned u = __float_as_uint(f); return (bf16)((u + 0x7fffu + ((u >> 16) & 1u)) >> 16); }
DI float sigmoidf_(float x) { return 1.f / (1.f + __expf(-x)); }
DI float logsigmoidf_(float x) { return fminf(x, 0.f) - log1pf(__expf(-fabsf(x))); }

constexpr int NB = 4, SEQ = 8192, DM = 1024, CTX = 256, GW = 64, GROWS = 128;
constexpr int M_LAT = NB * SEQ, M_CTX = NB * CTX, M_ALL = M_LAT + M_CTX;
constexpr int NHA = 8, DKA = 64, DVA = 128, NHB = 16, DHB = 64;
constexpr int DIN = 8224, DFF = 2816, NCH = 66;
constexpr float EPS = 1e-6f, GCAP = 15.f;
constexpr int C_QA = 0, C_KA = 512, C_VA = 1024, C_OA = 2048, C_G = 3072, C_QB = 3104, C_KB = 4128, C_VB = 5152, C_MG = 6176;

constexpr size_t MiB = 1u << 20;
constexpr size_t WS_MODV = 1 * MiB;
constexpr size_t WS_ROPE = WS_MODV + 128 * 1024;
constexpr size_t WS_SUMSQ = WS_ROPE + 32 * 1024;
constexpr size_t WS_CH = WS_SUMSQ + 128 * 1024;
constexpr size_t WS_MIN = WS_CH + 64 * 1024;
constexpr size_t WS_NU = WS_MIN + 32 * 1024;
constexpr size_t WS_GATES = 3 * MiB;
constexpr size_t WS_W = 8 * MiB;
constexpr size_t WS_HX = 48 * MiB, WS_QA = 114 * MiB, WS_KA = 147 * MiB, WS_VA = 180 * MiB, WS_OA = 246 * MiB, WS_QB = 310 * MiB, WS_KB = 374 * MiB, WS_VB = 440 * MiB, WS_END = 506 * MiB;
constexpr size_t WS_T1 = WS_QA, WS_XS = WS_HX, WS_HFF = WS_QB;

struct P {
    const float *x, *c, *ctx, *c_ctx, *w_mod, *b_mod, *norm1_g, *w_in, *b_gates, *mlstm_g, *qn_g, *kn_g, *rpb, *w_a, *w_b, *w_o, *norm2_g, *w_fg, *w_fu, *w_fd;
    float* out; unsigned char* ws;
};

__global__ void __launch_bounds__(256) nk_mod(P p) {
    const int col = blockIdx.x * 256 + threadIdx.x, r = blockIdx.y;
    const float* src = r < 4 ? p.c + r * DM : p.c_ctx;
    float acc = p.b_mod[col];
    for (int k = 0; k < DM; ++k) { const float v = src[k]; acc += (v / (1.f + expf(-v))) * p.w_mod[(size_t)k * 6144 + col]; }
    ((float*)(p.ws + WS_MODV))[r * 6144 + col] = acc;
}
__global__ void __launch_bounds__(256) nk_tables(P p) {
    const int i = blockIdx.x * 256 + threadIdx.x;
    if (i < 128 * 16) { const int pos = i / 16, f = i % 16; const float inv = powf(10000.f, -(float)f / 16.f); const float ang = (float)pos * inv;
        float* t = (float*)(p.ws + WS_ROPE); t[2 * i] = (float)cos((double)ang); t[2 * i + 1] = (float)sin((double)ang); }
    if (i < M_LAT) ((float*)(p.ws + WS_SUMSQ))[i] = 0.f;
}
__global__ void __launch_bounds__(256) nk_norm1(P p) {
    const int row = blockIdx.x * 4 + (threadIdx.x >> 6), lane = threadIdx.x & 63;
    const float* xr = row < M_LAT ? p.x + (size_t)row * DM : p.ctx + (size_t)(row - M_LAT) * DM;
    const int mr = row < M_LAT ? row / SEQ : 4;
    const float* modv = (const float*)(p.ws + WS_MODV) + mr * 6144;
    float v[16]; float ss = 0.f;
#pragma unroll
    for (int j = 0; j < 16; ++j) { v[j] = xr[lane + 64 * j]; ss += v[j] * v[j]; }
    for (int o = 1; o < 64; o <<= 1) ss += __shfl_xor(ss, o);
    const float rstd = rsqrtf(ss * (1.f / DM) + EPS);
    bf16* o = (bf16*)(p.ws + WS_HX) + (size_t)row * DM;
#pragma unroll
    for (int j = 0; j < 16; ++j) { const int k = lane + 64 * j; o[k] = f2bf(v[j] * rstd * p.norm1_g[k] * (1.f + modv[1024 + k]) + modv[k]); }
}
__global__ void __launch_bounds__(256) nk_inproj(P p, int cb0) {
    __shared__ bf16 hx[8][DM];
    __shared__ float ot[8][256];
    const int tid = threadIdx.x, cb = blockIdx.x + cb0, row0 = blockIdx.y * 8;
    const int col0 = cb < 12 ? cb * 256 : (cb == 12 ? C_G : C_QB + (cb - 13) * 256);
    const bool valid = cb != 12 || tid < 32;
    const int col = col0 + tid;
    const bf16* HX = (const bf16*)(p.ws + WS_HX);
    for (int i = tid; i < 8 * DM; i += 256) hx[i / DM][i % DM] = HX[(size_t)(row0 + i / DM) * DM + i % DM];
    __syncthreads();
    float acc[8];
#pragma unroll
    for (int r = 0; r < 8; ++r) acc[r] = 0.f;
    if (valid) for (int k = 0; k < DM; ++k) { const float w = p.w_in[(size_t)k * DIN + col];
#pragma unroll
        for (int r = 0; r < 8; ++r) acc[r] += bf2f(hx[r][k]) * w; }
#pragma unroll
    for (int r = 0; r < 8; ++r) ot[r][tid] = acc[r];
    __syncthreads();
    if (!valid) return;
    const float* rope = (const float*)(p.ws + WS_ROPE);
#pragma unroll
    for (int r = 0; r < 8; ++r) {
        const int row = row0 + r; const bool lat = row < M_LAT; const float v = ot[r][tid];
        if (col < C_VA) {
            const bool isq = col < C_KA; const int cc = isq ? col : col - C_KA; const int d = cc & 63;
            float o = v;
            if (lat) { const int t = row % SEQ; const int pos = (d & 32) ? (t % GW) : (t / GW); const int f = d & 15; const bool first = (d & 16) == 0;
                const float cs = rope[(pos * 16 + f) * 2], sn = rope[(pos * 16 + f) * 2 + 1];
                const float other = ot[r][first ? tid + 16 : tid - 16];
                o = first ? v * cs - other * sn : v * cs + other * sn; }
            if (isq) o *= 0.125f;
            ((bf16*)(p.ws + (isq ? WS_QA : WS_KA)))[(size_t)row * 512 + cc] = f2bf(o);
        } else if (col < C_OA) { ((bf16*)(p.ws + WS_VA))[(size_t)row * 1024 + col - C_VA] = f2bf(v);
        } else if (col < C_G) { if (lat) ((bf16*)(p.ws + WS_OA))[(size_t)row * 1024 + col - C_OA] = f2bf(sigmoidf_(v));
        } else if (col < C_QB) { const int g = col - C_G; const float raw = v + p.b_gates[g]; const float cp = GCAP * tanhf(raw / GCAP);
            ((float*)(p.ws + WS_GATES))[(size_t)row * 32 + g] = ((g >> 3) & 1) ? logsigmoidf_(cp) : cp;
        } else if (col < C_VB) {
            const bool isq = col < C_KB; const int cc = isq ? col - C_QB : col - C_KB; const int d = cc & 63, hb = tid & ~63;
            float ss = 0.f; for (int i = 0; i < 64; ++i) { const float u = ot[r][hb + i]; ss += u * u; }
            const float y = v * rsqrtf(ss * (1.f / 64.f) + EPS);
            if (isq) { if (lat) ((bf16*)(p.ws + WS_QB))[(size_t)row * 1024 + cc] = f2bf(y * p.qn_g[d] * 0.125f); }
            else ((bf16*)(p.ws + WS_KB))[(size_t)row * 1024 + cc] = f2bf(y * p.kn_g[d]);
        } else if (col < C_MG) { ((bf16*)(p.ws + WS_VB))[(size_t)row * 1024 + col - C_VB] = f2bf(v);
        } else { if (lat) ((bf16*)p.out)[(size_t)row * 2048 + col - C_MG] = f2bf(sigmoidf_(v)); }
    }
}
__global__ void __launch_bounds__(64) nk_na(P p) {
    __shared__ float q[64]; __shared__ float sc[384]; __shared__ int tok[384];
    const int row = blockIdx.x, h = blockIdx.y, j = threadIdx.x;
    const int b = row / SEQ, t = row % SEQ, qr = t / GW, qc = t % GW;
    bf16* QB = (bf16*)(p.ws + WS_QB); const bf16* KB = (const bf16*)(p.ws + WS_KB); const bf16* VB = (const bf16*)(p.ws + WS_VB);
    q[j] = bf2f(QB[(size_t)row * 1024 + h * 64 + j]);
    __syncthreads();
    const int wr0 = min(max(qr - 4, 0), GROWS - 8), wc0 = min(max(qc - 8, 0), GW - 16);
    for (int kk = j; kk < 384; kk += 64) {
        int krow_; float bias = 0.f;
        if (kk < 128) { const int kr = wr0 + kk / 16, kc = wc0 + kk % 16; krow_ = b * SEQ + kr * GW + kc; bias = p.rpb[(h * 15 + (kr - qr + 7)) * 31 + (kc - qc + 15)]; }
        else krow_ = M_LAT + b * CTX + (kk - 128);
        const bf16* kp = KB + (size_t)krow_ * 1024 + h * 64; float s = 0.f;
        for (int d = 0; d < 64; ++d) s += q[d] * bf2f(kp[d]);
        sc[kk] = s + bias; tok[kk] = krow_;
    }
    __syncthreads();
    float mx = -1e30f; for (int kk = 0; kk < 384; ++kk) mx = fmaxf(mx, sc[kk]);
    float sum = 0.f, o = 0.f;
    for (int kk = 0; kk < 384; ++kk) { const float e = __expf(sc[kk] - mx); sum += e; o += e * bf2f(VB[(size_t)tok[kk] * 1024 + h * 64 + j]); }
    QB[(size_t)row * 1024 + h * 64 + j] = f2bf(o / sum);
}
DI int chunk_row0(int b, int c) { return c < 2 ? M_LAT + b * CTX + 128 * c : b * SEQ + 128 * (c - 2); }
__global__ void __launch_bounds__(256) nk_mA(P p) {
    __shared__ float wf[128], wb[128], st[4];
    const int c = blockIdx.x, h = blockIdx.y, b = blockIdx.z, tid = threadIdx.x;
    const int row0 = chunk_row0(b, c);
    const float* G = (const float*)(p.ws + WS_GATES);
    if (tid == 0) {
        float bl = 0.f; for (int i = 0; i < 128; ++i) bl += G[(size_t)(row0 + i) * 32 + 8 + h];
        float cs = 0.f, mx = -1e30f;
        for (int i = 0; i < 128; ++i) { cs += G[(size_t)(row0 + i) * 32 + 8 + h]; const float ge = bl - cs + G[(size_t)(row0 + i) * 32 + h]; wf[i] = ge; mx = fmaxf(mx, ge); }
        for (int i = 0; i < 128; ++i) wf[i] = __expf(wf[i] - mx);
        st[0] = bl; st[1] = mx;
        float ex = 0.f, mxb = -1e30f;
        for (int i = 0; i < 128; ++i) { const float ge = ex + G[(size_t)(row0 + i) * 32 + 16 + h]; wb[i] = ge; mxb = fmaxf(mxb, ge); ex += G[(size_t)(row0 + i) * 32 + 24 + h]; }
        for (int i = 0; i < 128; ++i) wb[i] = __expf(wb[i] - mxb);
        st[2] = ex; st[3] = mxb;
    }
    __syncthreads();
    const bf16* KA = (const bf16*)(p.ws + WS_KA); const bf16* VA = (const bf16*)(p.ws + WS_VA);
    bf16* UC = (bf16*)p.out;
    for (int e = tid; e < 2 * 128 * 64; e += 256) {
        const int dir = e >> 13, dv = (e >> 6) & 127, dk = e & 63; const float* w = dir ? wb : wf;
        float s = 0.f;
        for (int i = 0; i < 128; ++i) s += bf2f(VA[(size_t)(row0 + i) * 1024 + h * 128 + dv]) * bf2f(f2bf(bf2f(KA[(size_t)(row0 + i) * 512 + h * 64 + dk]) * w[i]));
        UC[((((size_t)dir * NB + b) * NHA + h) * NCH + c) * 8192 + dv * 64 + dk] = f2bf(s);
    }
    if (tid < 128) { const int dir = tid >> 6, dk = tid & 63; const float* w = dir ? wb : wf; float s = 0.f;
        for (int i = 0; i < 128; ++i) s += bf2f(f2bf(bf2f(KA[(size_t)(row0 + i) * 512 + h * 64 + dk]) * w[i]));
        ((float*)(p.ws + WS_NU))[((((size_t)b * NHA + h) * 2 + dir) * NCH + c) * 64 + dk] = s; }
    if (tid < 4) ((float*)(p.ws + WS_CH))[((((size_t)b * NHA + h) * 2 + (tid >> 1)) * NCH + c) * 2 + (tid & 1)] = st[tid];
}
__global__ void __launch_bounds__(256) nk_mB(P p) {
    const int bhd = blockIdx.y, e = blockIdx.x * 256 + threadIdx.x;
    const int dir = bhd & 1, bh = bhd >> 1, b = bh / NHA, h = bh % NHA;
    const float* CH = (const float*)(p.ws + WS_CH) + (size_t)bhd * NCH * 2;
    bf16* UC = (bf16*)p.out + (((size_t)dir * NB + b) * NHA + h) * NCH * 8192;
    float* NU = (float*)(p.ws + WS_NU) + (size_t)bhd * NCH * 64;
    float* MIN = (float*)(p.ws + WS_MIN) + (size_t)bhd * NCH;
    float m = 0.f, s = 0.f;
    for (int i = 0; i < NCH; ++i) {
        const int c = dir == 0 ? i : (i < 2 ? 1 - i : NCH + 1 - i);
        const float bl = CH[c * 2], ml = CH[c * 2 + 1];
        const float mn = fmaxf(bl + m, ml), dec = __expf(bl + m - mn), scl = __expf(ml - mn);
        if (e < 8192) { const float u = bf2f(UC[(size_t)c * 8192 + e]); UC[(size_t)c * 8192 + e] = f2bf(s); s = dec * s + scl * u; }
        else if (e < 8256) { const float u = NU[c * 64 + e - 8192]; NU[c * 64 + e - 8192] = s; s = dec * s + scl * u; }
        if (e == 0) MIN[c] = m;
        m = mn;
    }
}
__global__ void __launch_bounds__(256) nk_mC(P p) {
    extern __shared__ float sm[];
    float* S = sm;
    float* ef = S + 128 * 129; float* Mf = ef + 128; float* af = Mf + 128; float* ff = af + 128;
    float* eb = ff + 128; float* Mb = eb + 128; float* ab = Mb + 128; float* fb = ab + 128; float* invf = fb + 128; float* invb = invf + 128;
    float* H = invb + 128;
    const int j = blockIdx.x, h = blockIdx.y, b = blockIdx.z, tid = threadIdx.x, c = j + 2;
    const int row0 = b * SEQ + 128 * j;
    const float* G = (const float*)(p.ws + WS_GATES);
    const bf16* QA = (const bf16*)(p.ws + WS_QA); const bf16* KA = (const bf16*)(p.ws + WS_KA); bf16* VA = (bf16*)(p.ws + WS_VA);
    const size_t bhd_f = ((size_t)b * NHA + h) * 2, bhd_b = bhd_f + 1;
    const float m_f = ((const float*)(p.ws + WS_MIN))[bhd_f * NCH + c], m_b = ((const float*)(p.ws + WS_MIN))[bhd_b * NCH + c];
    const float* n_f = (const float*)(p.ws + WS_NU) + (bhd_f * NCH + c) * 64; const float* n_b = (const float*)(p.ws + WS_NU) + (bhd_b * NCH + c) * 64;
    const bf16* C_f = (const bf16*)p.out + ((((size_t)0 * NB + b) * NHA + h) * NCH + c) * 8192; const bf16* C_b = (const bf16*)p.out + ((((size_t)1 * NB + b) * NHA + h) * NCH + c) * 8192;
    if (tid == 0) {
        float cs = 0.f, pm = m_f;
        for (int i = 0; i < 128; ++i) { cs += G[(size_t)(row0 + i) * 32 + 8 + h]; const float e = G[(size_t)(row0 + i) * 32 + h] - cs; ef[i] = e; pm = fmaxf(pm, e); Mf[i] = pm; af[i] = __expf(m_f - pm); ff[i] = __expf(-(cs + pm)); }
    }
    if (tid == 64) {
        float ss = 0.f, pm = m_b;
        for (int i = 127; i >= 0; --i) { ss += G[(size_t)(row0 + i) * 32 + 24 + h]; const float e = G[(size_t)(row0 + i) * 32 + 16 + h] - ss; eb[i] = e; pm = fmaxf(pm, e); Mb[i] = pm; ab[i] = __expf(m_b - pm); fb[i] = __expf(-(ss + pm)); }
    }
    for (int e = tid; e < 128 * 128; e += 256) { const int t = e >> 7, s = e & 127; float acc = 0.f;
        for (int d = 0; d < 64; ++d) acc += bf2f(QA[(size_t)(row0 + t) * 512 + h * 64 + d]) * bf2f(KA[(size_t)(row0 + s) * 512 + h * 64 + d]);
        S[t * 129 + s] = acc; }
    __syncthreads();
    { const int t = tid & 127; const bool fw = tid < 128; float den = 0.f, qn = 0.f;
        const float* nn = fw ? n_f : n_b;
        for (int d = 0; d < 64; ++d) qn += bf2f(QA[(size_t)(row0 + t) * 512 + h * 64 + d]) * nn[d];
        if (fw) { for (int s = 0; s <= t; ++s) den += S[t * 129 + s] * __expf(ef[s] - Mf[t]); den += af[t] * qn; invf[t] = 1.f / fmaxf(fabsf(den), ff[t]); }
        else { for (int s = t; s < 128; ++s) den += S[t * 129 + s] * __expf(eb[s] - Mb[t]); den += ab[t] * qn; invb[t] = 1.f / fmaxf(fabsf(den), fb[t]); } }
    __syncthreads();
    for (int e = tid; e < 128 * 128; e += 256) { const int t = e >> 7, s = e & 127;
        const float wf_ = s <= t ? __expf(ef[s] - Mf[t]) * invf[t] : 0.f, wb_ = s >= t ? __expf(eb[s] - Mb[t]) * invb[t] : 0.f;
        S[t * 129 + s] *= (wf_ + wb_); }
    __syncthreads();
    for (int e = tid; e < 128 * 128; e += 256) { const int t = e >> 7, dv = e & 127; float acc = 0.f;
        for (int s = 0; s < 128; ++s) acc += S[t * 129 + s] * bf2f(VA[(size_t)(row0 + s) * 1024 + h * 128 + dv]);
        float qc1 = 0.f, qc2 = 0.f;
        for (int d = 0; d < 64; ++d) { const float qv = bf2f(QA[(size_t)(row0 + t) * 512 + h * 64 + d]); qc1 += qv * bf2f(C_f[dv * 64 + d]); qc2 += qv * bf2f(C_b[dv * 64 + d]); }
        H[t * 128 + dv] = acc + af[t] * invf[t] * qc1 + ab[t] * invb[t] * qc2; }
    __syncthreads();
    for (int e = tid; e < 128 * 128; e += 256) { const int t = e >> 7, dv = e & 127;
        float ss = 0.f; for (int i = 0; i < 128; ++i) { const float u = H[t * 128 + ((i + dv) & 127)]; ss += u * u; }
        const float rn = rsqrtf(ss * (1.f / 128.f) + EPS);
        VA[(size_t)(row0 + t) * 1024 + h * 128 + dv] = f2bf(H[t * 128 + dv] * rn * p.mlstm_g[h * 128 + dv] * bf2f(((const bf16*)(p.ws + WS_OA))[(size_t)(row0 + t) * 1024 + h * 128 + dv])); }
}
template <int K> DI void load_a(bf16 (*a)[K], const bf16* A, int row0, int tid) { for (int i = tid; i < 8 * K; i += 256) a[i / K][i % K] = A[(size_t)(row0 + i / K) * K + i % K]; }
__global__ void __launch_bounds__(256) nk_merge(P p) {
    __shared__ bf16 a1[8][DM]; __shared__ bf16 a2[8][DM];
    const int tid = threadIdx.x, col = blockIdx.x * 256 + tid, row0 = blockIdx.y * 8;
    load_a<DM>(a1, (const bf16*)(p.ws + WS_VA), row0, tid); load_a<DM>(a2, (const bf16*)(p.ws + WS_QB), row0, tid);
    __syncthreads();
    float s1[8], s2[8];
#pragma unroll
    for (int r = 0; r < 8; ++r) { s1[r] = 0.f; s2[r] = 0.f; }
    for (int k = 0; k < DM; ++k) { const float wa = p.w_a[(size_t)k * DM + col], wb = p.w_b[(size_t)k * DM + col];
#pragma unroll
        for (int r = 0; r < 8; ++r) { s1[r] += bf2f(a1[r][k]) * wa; s2[r] += bf2f(a2[r][k]) * wb; } }
    const bf16* MG = (const bf16*)p.out;
#pragma unroll
    for (int r = 0; r < 8; ++r) { const size_t row = row0 + r; ((bf16*)(p.ws + WS_T1))[row * DM + col] = f2bf(bf2f(MG[row * 2048 + col]) * s1[r] + bf2f(MG[row * 2048 + 1024 + col]) * s2[r]); }
}
__global__ void __launch_bounds__(256) nk_outproj(P p) {
    __shared__ bf16 a1[8][DM]; __shared__ float red[8][4];
    const int tid = threadIdx.x, col = blockIdx.x * 256 + tid, row0 = blockIdx.y * 8, b = row0 / SEQ;
    load_a<DM>(a1, (const bf16*)(p.ws + WS_T1), row0, tid);
    __syncthreads();
    float s1[8];
#pragma unroll
    for (int r = 0; r < 8; ++r) s1[r] = 0.f;
    for (int k = 0; k < DM; ++k) { const float w = p.w_o[(size_t)k * DM + col];
#pragma unroll
        for (int r = 0; r < 8; ++r) s1[r] += bf2f(a1[r][k]) * w; }
    const float* modv = (const float*)(p.ws + WS_MODV) + b * 6144;
    const float g1 = modv[2048 + col], s2 = p.norm2_g[col] * (1.f + modv[4096 + col]);
#pragma unroll
    for (int r = 0; r < 8; ++r) { const size_t row = row0 + r; const float xn = p.x[row * DM + col] + g1 * s1[r];
        p.out[row * DM + col] = xn; ((bf16*)(p.ws + WS_XS))[row * DM + col] = f2bf(xn * s2);
        float q = xn * xn; for (int o = 1; o < 64; o <<= 1) q += __shfl_xor(q, o);
        if ((tid & 63) == 0) red[r][tid >> 6] = q; }
    __syncthreads();
    if (tid < 8) atomicAdd((float*)(p.ws + WS_SUMSQ) + row0 + tid, red[tid][0] + red[tid][1] + red[tid][2] + red[tid][3]);
}
__global__ void __launch_bounds__(256) nk_ffn1(P p) {
    __shared__ bf16 a1[8][DM];
    const int tid = threadIdx.x, col = blockIdx.x * 256 + tid, row0 = blockIdx.y * 8, b = row0 / SEQ;
    load_a<DM>(a1, (const bf16*)(p.ws + WS_XS), row0, tid);
    __syncthreads();
    const float* sh2 = (const float*)(p.ws + WS_MODV) + b * 6144 + 3072;
    float sg[8], su[8], bg = 0.f, bu = 0.f;
#pragma unroll
    for (int r = 0; r < 8; ++r) { sg[r] = 0.f; su[r] = 0.f; }
    for (int k = 0; k < DM; ++k) { const float wg = p.w_fg[(size_t)k * DFF + col], wu = p.w_fu[(size_t)k * DFF + col]; const float sh = sh2[k]; bg += sh * wg; bu += sh * wu;
#pragma unroll
        for (int r = 0; r < 8; ++r) { const float a = bf2f(a1[r][k]); sg[r] += a * wg; su[r] += a * wu; } }
#pragma unroll
    for (int r = 0; r < 8; ++r) { const size_t row = row0 + r; const float rstd = rsqrtf(((const float*)(p.ws + WS_SUMSQ))[row] * (1.f / DM) + EPS);
        const float g = rstd * sg[r] + bg, u = rstd * su[r] + bu;
        ((bf16*)(p.ws + WS_HFF))[row * DFF + col] = f2bf(g * sigmoidf_(g) * u); }
}
__global__ void __launch_bounds__(256) nk_ffn2(P p) {
    __shared__ bf16 a1[8][DFF];
    const int tid = threadIdx.x, col = blockIdx.x * 256 + tid, row0 = blockIdx.y * 8, b = row0 / SEQ;
    load_a<DFF>(a1, (const bf16*)(p.ws + WS_HFF), row0, tid);
    __syncthreads();
    float s1[8];
#pragma unroll
    for (int r = 0; r < 8; ++r) s1[r] = 0.f;
    for (int k = 0; k < DFF; ++k) { const float w = p.w_fd[(size_t)k * DM + col];
#pragma unroll
        for (int r = 0; r < 8; ++r) s1[r] += bf2f(a1[r][k]) * w; }
    const float g2 = ((const float*)(p.ws + WS_MODV))[b * 6144 + 5120 + col];
#pragma unroll
    for (int r = 0; r < 8; ++r) { const size_t row = row0 + r; p.out[row * DM + col] += g2 * s1[r]; }
}

extern "C" void kernel_launch(void* const* d_in, const int* in_sizes, int n_in, void* d_out, int out_size, void* d_ws, size_t ws_size, hipStream_t stream) {
    if (n_in != 20 || ws_size < WS_END || out_size != M_LAT * DM) { fprintf(stderr, "kernel_launch: unexpected shapes (n_in %d, ws %zu, out %d)\n", n_in, ws_size, out_size); return; }
    P p{};
    const float** f = (const float**)&p;
    for (int i = 0; i < 20; ++i) f[i] = (const float*)d_in[i];
    p.out = (float*)d_out; p.ws = (unsigned char*)d_ws;
    static bool attr = false;
    if (!attr) { (void)hipFuncSetAttribute((const void*)nk_mC, hipFuncAttributeMaxDynamicSharedMemorySize, 140 * 1024); attr = true; }
    nk_mod<<<dim3(24, 5), 256, 0, stream>>>(p);
    nk_tables<<<128, 256, 0, stream>>>(p);
    nk_norm1<<<M_ALL / 4, 256, 0, stream>>>(p);
    nk_inproj<<<dim3(25, M_ALL / 8), 256, 0, stream>>>(p, 0);
    nk_na<<<dim3(M_LAT, NHB), 64, 0, stream>>>(p);
    nk_mA<<<dim3(NCH, NHA, NB), 256, 0, stream>>>(p);
    nk_mB<<<dim3(33, 64), 256, 0, stream>>>(p);
    nk_mC<<<dim3(64, NHA, NB), 256, (128 * 129 + 1280 + 128 * 128) * 4, stream>>>(p);
    nk_inproj<<<dim3(8, M_LAT / 8), 256, 0, stream>>>(p, 25);
    nk_merge<<<dim3(4, M_LAT / 8), 256, 0, stream>>>(p);
    nk_outproj<<<dim3(4, M_LAT / 8), 256, 0, stream>>>(p);
    nk_ffn1<<<dim3(11, M_LAT / 8), 256, 0, stream>>>(p);
    nk_ffn2<<<dim3(4, M_LAT / 8), 256, 0, stream>>>(p);
}
```

```cpp
#include <hip/hip_runtime.h>
#include <hip/hip_cooperative_groups.h>
#include <cstdio>
#include <cstdint>
namespace cg = cooperative_groups;

typedef unsigned short bf16;
#define DI __device__ __forceinline__
#define LAS __attribute__((address_space(3)))
DI float bf2f(bf16 b) { return __uint_as_float(((unsigned)b) << 16); }
DI bf16 f2bf(float f) { unsigned u = __float_as_uint(f); return (bf16)((u + 0x7fffu + ((u >> 16) & 1u)) >> 16); }
DI float sigmoidf_(float x) { return 1.f / (1.f + __expf(-x)); }
DI float logsigmoidf_(float x) { return fminf(x, 0.f) - log1pf(__expf(-fabsf(x))); }

constexpr int NB = 4, SEQ = 8192, DM = 1024, CTX = 256, GW = 64, GROWS = 128;
constexpr int M_LAT = NB * SEQ, M_CTX = NB * CTX, M_ALL = M_LAT + M_CTX;
constexpr int NHA = 8, DKA = 64, DVA = 128, NHB = 16, DHB = 64;
constexpr int DIN = 8224, DFF = 2816, NCH = 66;
constexpr float EPS = 1e-6f, GCAP = 15.f;
constexpr int C_QA = 0, C_KA = 512, C_VA = 1024, C_OA = 2048, C_G = 3072, C_QB = 3104, C_KB = 4128, C_VB = 5152, C_MG = 6176;

constexpr size_t MiB = 1u << 20;
constexpr size_t WS_MODV = 1 * MiB;
constexpr size_t WS_ROPE = WS_MODV + 128 * 1024;
constexpr size_t WS_SUMSQ = WS_ROPE + 32 * 1024;
constexpr size_t WS_CH = WS_SUMSQ + 128 * 1024;
constexpr size_t WS_MIN = WS_CH + 64 * 1024;
constexpr size_t WS_BGU = WS_MIN + 32 * 1024;
constexpr size_t WS_NU = WS_BGU + 128 * 1024;
constexpr size_t WS_GATES = 3 * MiB;
constexpr size_t WS_W = 8 * MiB;
constexpr size_t WS_WIN = WS_W, WS_WA = 25 * MiB, WS_WB = 27 * MiB, WS_WO = 29 * MiB, WS_WGU = 31 * MiB, WS_WD = 42 * MiB;
constexpr size_t WS_HX = 48 * MiB, WS_QA = 114 * MiB, WS_KA = 147 * MiB, WS_VA = 180 * MiB, WS_OA = 246 * MiB, WS_QB = 310 * MiB, WS_KB = 374 * MiB, WS_VB = 440 * MiB, WS_END = 506 * MiB;
constexpr size_t WS_T1 = WS_QA, WS_XS = WS_HX, WS_HFF = WS_QB, WS_TMP = WS_KB;
constexpr size_t WS_UC = WS_HX;
static_assert(WS_NU + 4 * 8 * 2 * 66 * 64 * 4 <= WS_GATES && WS_GATES + (size_t)M_ALL * 32 * 4 <= WS_W, "misc map");
static_assert(WS_WIN + (size_t)33 * 256 * 1024 * 2 <= WS_WA && WS_WGU + (size_t)5632 * 1024 * 2 <= WS_WD && WS_WD + (size_t)1024 * 2816 * 2 <= WS_HX, "weight map");

struct P {
    const float *x, *c, *ctx, *c_ctx, *w_mod, *b_mod, *norm1_g, *w_in, *b_gates, *mlstm_g, *qn_g, *kn_g, *rpb, *w_a, *w_b, *w_o, *norm2_g, *w_fg, *w_fu, *w_fd;
    float* out; unsigned char* ws;
};
namespace pg8 {
#define PG8_LAS __attribute__((address_space(3)))
typedef unsigned short bf16_t;
typedef short bf16x8 __attribute__((ext_vector_type(8)));
typedef float f32x4 __attribute__((ext_vector_type(4)));
typedef unsigned u32x4 __attribute__((ext_vector_type(4)));
constexpr int BM = 256, BK = 64, HALF = 128, HTB = HALF * BK * 2  , STAGE_BYTES = 8 * HTB, NXCD = 8, WGM = 8;

__host__ __device__ __forceinline__ int lds_byte(int r, int c) { const int st = (r >> 4) * 2 + (c >> 5), rr = r & 15, cc = c & 31, ob = rr * 64 + cc * 2; return st * 1024 + (ob ^ (((ob >> 9) & 1) << 5)); }
__host__ __device__ __forceinline__ void stage_rc(int b, int& R, int& C) { const int st = b / 1024, sb = b % 1024, swz = sb ^ (((sb >> 9) & 1) << 5); R = (st >> 1) * 16 + swz / 64; C = (st & 1) * 32 + (swz % 64) / 2; }
__host__ __device__ __forceinline__ int perm32(int rho) { const int n = rho >> 4, i = rho & 15; return 8 * (i >> 2) + 4 * n + (i & 3); }

struct Unit { int pm, pn; };
struct Gemm { const bf16_t* A; const bf16_t* Bt; int M, N, K; };

struct StaticOrder {
    int nM, nN, nwg, G, c;
    __host__ __device__ void init(int M, int N, int G_, int c_) { nM = M / BM; nN = N / BM; nwg = nM * nN; G = G_; c = c_; }
    __host__ __device__ bool next(int i, Unit& u) const {
        const long L = (long)i * G + c; if (L >= nwg) return false;
        int wgid = (int)L; { const int q = nwg / NXCD, r = nwg % NXCD, xcd = wgid % NXCD, off = wgid / NXCD; wgid = (xcd < r ? xcd * (q + 1) : r * (q + 1) + (xcd - r) * q) + off; }
        const int nig = WGM * nN, gid = wgid / nig, fm = gid * WGM, gsz = (nM - fm) < WGM ? (nM - fm) : WGM;
        u.pm = fm + ((wgid % nig) % gsz); u.pn = (wgid % nig) / gsz; return true;
    }
    __device__ __forceinline__ void a_ready(const Unit&) const {}
    __device__ __forceinline__ void done(const Unit&) const {}
};
__device__ __forceinline__ unsigned cvt_pk_bf16(float lo, float hi) { unsigned r; asm volatile("v_cvt_pk_bf16_f32 %0, %1, %2" : "=v"(r) : "v"(lo), "v"(hi)); return r; }
typedef float f32x2 __attribute__((ext_vector_type(2)));
template <class Epi, class Sched, bool ALIGN_EPI = false, bool SP2 = false>
__device__ __forceinline__ void gemm_phase(PG8_LAS unsigned char* lds, const Gemm g, const Sched& S, const Epi& E) {
    const int tid = threadIdx.x, wid = __builtin_amdgcn_readfirstlane(tid >> 6), lane = tid & 63, wr = wid >> 2, wc = wid & 3, fr = lane & 15, fq = lane >> 4;
    const int K = g.K, nt = K / BK;
    unsigned voffA[2], voffB[2];
#pragma unroll
    for (int i = 0; i < 2; ++i) { int R, C; stage_rc(tid * 16 + i * 8192, R, C); const int Rb = Epi::PERM ? ((R & ~31) + perm32(R & 31)) : R;
        voffA[i] = (unsigned)(R * K + C) * 2u; voffB[i] = (unsigned)(Rb * K + C) * 2u; }
    const size_t kstep = (size_t)(BK * 2);
    const size_t hstep = (size_t)HALF * K * 2;
    const size_t tstep = 2 * hstep;
    const unsigned ldsw = (unsigned)wid * 1024u;
    const int aoff = lds_byte(wr * 64 + fr, fq * 8), boff = lds_byte(wc * 32 + fr, fq * 8);
#define PG8_SA(b, h) (((b) * 2 + (h)) * HTB)
#define PG8_SB(b, h) ((4 + (b) * 2 + (h)) * HTB)
#define PG8_STAGE(bufoff, gbase, voff) do { _Pragma("unroll") for (int _i = 0; _i < 2; ++_i) \
        __builtin_amdgcn_global_load_lds((const unsigned*)((const char*)(gbase) + (voff)[_i]), (PG8_LAS unsigned*)(lds + (bufoff) + ldsw + _i * 8192), 16, 0, 0); } while (0)
#define PG8_LDA(dst, b, h) do { _Pragma("unroll") for (int m = 0; m < 4; ++m) _Pragma("unroll") for (int k = 0; k < 2; ++k) dst[m][k] = *(const PG8_LAS bf16x8*)(lds + PG8_SA(b, h) + aoff + m * 2048 + k * 1024); } while (0)
#define PG8_LDB(dst, b, h) do { _Pragma("unroll") for (int n = 0; n < 2; ++n) _Pragma("unroll") for (int k = 0; k < 2; ++k) dst[n][k] = *(const PG8_LAS bf16x8*)(lds + PG8_SB(b, h) + boff + n * 2048 + k * 1024); } while (0)
#define PG8_MMA(ai, bj, At, Bt) do { __builtin_amdgcn_s_setprio(1); _Pragma("unroll") for (int m = 0; m < 4; ++m) _Pragma("unroll") for (int n = 0; n < 2; ++n) _Pragma("unroll") for (int k = 0; k < 2; ++k) \
        acc[ai][bj][m][n] = __builtin_amdgcn_mfma_f32_16x16x32_bf16(Bt[n][k], At[m][k], acc[ai][bj][m][n], 0, 0, 0); __builtin_amdgcn_s_setprio(0); } while (0)
#define PG8_WAIT_V(n) asm volatile("s_waitcnt vmcnt(" #n ")" ::: "memory")
#define PG8_WAIT_L(n) asm volatile("s_waitcnt lgkmcnt(" #n ")" ::: "memory")
#define PG8_BAR __builtin_amdgcn_s_barrier()
#define PG8_SCHED __builtin_amdgcn_sched_barrier(0)
    Unit cur, nxt; int ui = 0;
    if (!S.next(0, cur)) return;
    f32x4 acc[2][2][4][2];
#pragma unroll
    for (int a = 0; a < 2; ++a)
#pragma unroll
        for (int b = 0; b < 2; ++b)
#pragma unroll
            for (int m = 0; m < 4; ++m)
#pragma unroll
                for (int n = 0; n < 2; ++n) acc[a][b][m][n] = (f32x4){0.f, 0.f, 0.f, 0.f};
    bf16x8 At[4][2], B0[2][2], B1[2][2];
    const char* cA = (const char*)g.A + (size_t)cur.pm * tstep; const char* cB = (const char*)g.Bt + (size_t)cur.pn * tstep;
    S.a_ready(cur);
    if constexpr (SP2) {
        PG8_STAGE(PG8_SB(0, 0), cB, voffB); PG8_STAGE(PG8_SB(0, 1), cB + hstep, voffB); PG8_STAGE(PG8_SA(0, 0), cA, voffA); PG8_STAGE(PG8_SA(0, 1), cA + hstep, voffA);
        if (wr == 1) PG8_BAR;
        PG8_WAIT_V(2); PG8_BAR;
        PG8_STAGE(PG8_SB(1, 0), cB + kstep, voffB); PG8_STAGE(PG8_SA(1, 0), cA + kstep, voffA); PG8_STAGE(PG8_SB(1, 1), cB + hstep + kstep, voffB);
        PG8_WAIT_V(6); PG8_BAR;
    } else {
        PG8_STAGE(PG8_SB(0, 0), cB, voffB); PG8_STAGE(PG8_SA(0, 0), cA, voffA); PG8_STAGE(PG8_SB(0, 1), cB + hstep, voffB); PG8_STAGE(PG8_SA(0, 1), cA + hstep, voffA);
        if (wr == 1) PG8_BAR;
        PG8_WAIT_V(4); PG8_BAR;
        PG8_STAGE(PG8_SB(1, 0), cB + kstep, voffB); PG8_STAGE(PG8_SA(1, 0), cA + kstep, voffA); PG8_STAGE(PG8_SB(1, 1), cB + hstep + kstep, voffB);
        PG8_WAIT_V(6); PG8_BAR;
    }
    for (;;) {
        const bool has_next = S.next(ui + 1, nxt);
        const char* nA = has_next ? (const char*)g.A + (size_t)nxt.pm * tstep : cA; const char* nB = has_next ? (const char*)g.Bt + (size_t)nxt.pn * tstep : cB;
        for (int t = 0; t < nt; t += 2) {
            const bool last = (t == nt - 2);
            const char* a1 = cA + (size_t)(t + 1) * kstep;
            const char* a2 = last ? nA : cA + (size_t)(t + 2) * kstep; const char* b2 = last ? nB : cB + (size_t)(t + 2) * kstep;
            const char* a3 = a2 + kstep; const char* b3 = b2 + kstep;
            if (last && has_next) S.a_ready(nxt);
            if constexpr (SP2) {
            PG8_LDB(B0, 0, 0); PG8_LDB(B1, 0, 1); PG8_SCHED; PG8_LDA(At, 0, 0); PG8_STAGE(PG8_SA(1, 1), a1 + hstep, voffA);
            PG8_WAIT_V(8); PG8_WAIT_L(0); PG8_BAR; PG8_MMA(0, 0, At, B0); PG8_MMA(0, 1, At, B1); PG8_BAR; PG8_SCHED;
            PG8_LDA(At, 0, 1); PG8_STAGE(PG8_SB(0, 0), b2, voffB); PG8_STAGE(PG8_SB(0, 1), b2 + hstep, voffB); PG8_STAGE(PG8_SA(0, 0), a2, voffA);
            PG8_WAIT_V(8); PG8_WAIT_L(0); PG8_BAR; PG8_MMA(1, 0, At, B0); PG8_MMA(1, 1, At, B1); PG8_BAR; PG8_SCHED;
            PG8_LDB(B0, 1, 0); PG8_LDB(B1, 1, 1); PG8_SCHED; PG8_LDA(At, 1, 0); PG8_STAGE(PG8_SA(0, 1), a2 + hstep, voffA);
            PG8_WAIT_V(8); PG8_WAIT_L(0); PG8_BAR; PG8_MMA(0, 0, At, B0); PG8_MMA(0, 1, At, B1); PG8_BAR; PG8_SCHED;
            PG8_LDA(At, 1, 1); PG8_STAGE(PG8_SB(1, 0), b3, voffB); PG8_STAGE(PG8_SB(1, 1), b3 + hstep, voffB); PG8_STAGE(PG8_SA(1, 0), a3, voffA);
            PG8_WAIT_V(8); PG8_WAIT_L(0); PG8_BAR; PG8_MMA(1, 0, At, B0); PG8_MMA(1, 1, At, B1); PG8_BAR; PG8_SCHED;
            } else {
            PG8_LDB(B0, 0, 0); PG8_SCHED; PG8_LDA(At, 0, 0); PG8_STAGE(PG8_SA(1, 1), a1 + hstep, voffA);
            PG8_WAIT_L(8); PG8_BAR; PG8_WAIT_L(0); PG8_MMA(0, 0, At, B0); PG8_BAR; PG8_SCHED;
            PG8_LDB(B1, 0, 1); PG8_STAGE(PG8_SB(0, 0), b2, voffB);
            PG8_BAR; PG8_WAIT_L(0); PG8_MMA(0, 1, At, B1); PG8_BAR;
            PG8_LDA(At, 0, 1); PG8_STAGE(PG8_SA(0, 0), a2, voffA);
            PG8_BAR; PG8_WAIT_L(0); PG8_MMA(1, 0, At, B0); PG8_BAR; PG8_SCHED;
            PG8_STAGE(PG8_SB(0, 1), b2 + hstep, voffB);
            PG8_WAIT_V(6); PG8_BAR; PG8_MMA(1, 1, At, B1); PG8_BAR;
            PG8_LDB(B0, 1, 0); PG8_SCHED; PG8_LDA(At, 1, 0); PG8_STAGE(PG8_SA(0, 1), a2 + hstep, voffA);
            PG8_WAIT_L(8); PG8_BAR; PG8_WAIT_L(0); PG8_MMA(0, 0, At, B0); PG8_BAR; PG8_SCHED;
            PG8_LDB(B1, 1, 1); PG8_STAGE(PG8_SB(1, 0), b3, voffB);
            PG8_BAR; PG8_WAIT_L(0); PG8_MMA(0, 1, At, B1); PG8_BAR;
            PG8_LDA(At, 1, 1); PG8_STAGE(PG8_SA(1, 0), a3, voffA);
            PG8_BAR; PG8_WAIT_L(0); PG8_MMA(1, 0, At, B0); PG8_BAR; PG8_SCHED;
            PG8_STAGE(PG8_SB(1, 1), b3 + hstep, voffB);
            PG8_WAIT_V(6); PG8_BAR; PG8_MMA(1, 1, At, B1); PG8_BAR;
            }
        }
        if constexpr (ALIGN_EPI) { if (wr == 0) PG8_BAR; }
        if constexpr (!Epi::AFTER_DRAIN) { E(acc, cur, wr, wc, fr, fq); S.done(cur); }
        if (!has_next) break;
#pragma unroll
        for (int a = 0; a < 2; ++a)
#pragma unroll
            for (int b = 0; b < 2; ++b)
#pragma unroll
                for (int m = 0; m < 4; ++m)
#pragma unroll
                    for (int n = 0; n < 2; ++n) acc[a][b][m][n] = (f32x4){0.f, 0.f, 0.f, 0.f};
        cur = nxt; cA = nA; cB = nB; ++ui;
        if constexpr (ALIGN_EPI) { if (wr == 1) PG8_BAR; }
    }
    PG8_WAIT_V(0);
    if constexpr (!ALIGN_EPI) { if (wr == 0) PG8_BAR; }
    PG8_BAR;
    if constexpr (Epi::AFTER_DRAIN) { E.fused(acc, cur, wr, wc, fr, fq, lds, wid, lane); S.done(cur); }
#undef PG8_SA
#undef PG8_SB
#undef PG8_STAGE
#undef PG8_LDA
#undef PG8_LDB
#undef PG8_MMA
#undef PG8_WAIT_V
#undef PG8_WAIT_L
#undef PG8_BAR
#undef PG8_SCHED
}
}
#define XB_TMO      128
#define XB_XCNT(j)  (256  + 64 * (j))
#define XB_XSUB(j)  (1280 + 64 * (j))
#define XB_XGEN(j)  (2304 + 64 * (j))
#define XB_TOP      3328
#define XB_TOPGEN   3392
#define XCD_BAR_WORDS 3456
#define XB_SPIN_CAP (1u << 18)

__device__ __forceinline__ unsigned xb_ld(unsigned* p)              { return __hip_atomic_load(p, __ATOMIC_RELAXED, __HIP_MEMORY_SCOPE_AGENT); }
__device__ __forceinline__ unsigned xb_add(unsigned* p, unsigned v) { return __hip_atomic_fetch_add(p, v, __ATOMIC_RELAXED, __HIP_MEMORY_SCOPE_AGENT); }
__device__ __forceinline__ unsigned xb_xcc_id() { return (unsigned)__builtin_amdgcn_s_getreg((3 << 11) | 20) & 0xFu; }
#define XB_SPIN(cond, bar) do { unsigned _sp = 0; while (cond) { __builtin_amdgcn_s_sleep(1); \
    if ((++_sp & 255u) == 0u) { if (xb_ld(&(bar)[XB_TMO])) break; if (_sp > XB_SPIN_CAP) { atomicAdd(&(bar)[XB_TMO], 1u); break; } } } } while (0)

struct XcdBarrier {
    unsigned* bar; unsigned x;
    volatile LAS unsigned* st;
};

__device__ __forceinline__ XcdBarrier xcd_barrier_post(unsigned* bar, volatile LAS unsigned* st) {
    XcdBarrier b; b.bar = bar; b.x = xb_xcc_id(); b.st = st;
    if (threadIdx.x == 0) (void)xb_add(&bar[XB_XCNT(b.x)], 1u);
    return b;
}
__device__ __forceinline__ void xcd_barrier_complete(unsigned* bar, unsigned x, unsigned& nloc, unsigned& nx) {
    const unsigned G = gridDim.x * gridDim.y * gridDim.z;
    unsigned sum, cnt, mine, sp = 0u;
    for (;;) {
        sum = 0u; cnt = 0u; mine = 0u;
#pragma unroll
        for (unsigned j = 0; j < 16; ++j) { const unsigned c = xb_ld(&bar[XB_XCNT(j)]); sum += c; cnt += (c > 0u) ? 1u : 0u; mine = (j == x) ? c : mine; }
        if (sum == G) break;
        __builtin_amdgcn_s_sleep(1);
        if ((++sp & 255u) == 0u) { if (xb_ld(&bar[XB_TMO])) break; if (sp > XB_SPIN_CAP) { atomicAdd(&bar[XB_TMO], 1u); break; } }
    }
    nloc = mine > 0u ? mine : 1u; nx = cnt > 0u ? cnt : 1u;
}

__device__ __forceinline__ void xcd_barrier(const XcdBarrier& b) {
    asm volatile("s_waitcnt vmcnt(0)" ::: "memory");
    __syncthreads();
    if (threadIdx.x == 0) {
        unsigned* bar = b.bar;
        __builtin_amdgcn_s_waitcnt(0);
        unsigned nloc = b.st[0], nx = b.st[1];
        if (nloc == 0u) { xcd_barrier_complete(bar, b.x, nloc, nx); b.st[0] = nloc; b.st[1] = nx; }
        const unsigned old = xb_add(&bar[XB_XSUB(b.x)], 1u);
        const unsigned gen = old / nloc;
        if (old + 1u == (gen + 1u) * nloc) {
            __builtin_amdgcn_fence(__ATOMIC_RELEASE, "agent");
            asm volatile("s_waitcnt vmcnt(0)" ::: "memory");
            const unsigned og = xb_add(&bar[XB_TOP], 1u);
            const unsigned tg = og / nx;
            if (og + 1u == (tg + 1u) * nx) xb_add(&bar[XB_TOPGEN], 1u);
            else XB_SPIN(xb_ld(&bar[XB_TOPGEN]) == tg, bar);
            __builtin_amdgcn_fence(__ATOMIC_ACQUIRE, "agent");
            xb_add(&bar[XB_XGEN(b.x)], 1u);
            asm volatile("s_waitcnt vmcnt(0)" ::: "memory");
        } else {
            XB_SPIN(xb_ld(&bar[XB_XGEN(b.x)]) == gen, bar);
            __builtin_amdgcn_fence(__ATOMIC_ACQUIRE, "agent");
            asm volatile("s_waitcnt vmcnt(0)" ::: "memory");
        }
    }
    __syncthreads();
}
using pg8::f32x4; using pg8::Unit;
typedef unsigned u32x4 __attribute__((ext_vector_type(4)));
typedef unsigned u32x2 __attribute__((ext_vector_type(2)));
constexpr int NWAVES = 8, NTHR = 512;
constexpr int LDS_BYTES = 147456;
constexpr int LDSCTL_OFF = 131072 + 8192;
constexpr size_t WS_CTL = 0, CTL_ZERO_BYTES = 64 * 1024;
#define LDS_WAIT() asm volatile("s_waitcnt lgkmcnt(0)" ::: "memory")
DI float fsig(float x) { return __builtin_amdgcn_rcpf(1.f + __expf(-x)); }
DI u32x4 pack8(const f32x4& a, const f32x4& b) { u32x4 w; w.x = pg8::cvt_pk_bf16(a[0], a[1]); w.y = pg8::cvt_pk_bf16(a[2], a[3]); w.z = pg8::cvt_pk_bf16(b[0], b[1]); w.w = pg8::cvt_pk_bf16(b[2], b[3]); return w; }
DI u32x2 pack4(const f32x4& a) { u32x2 w; w.x = pg8::cvt_pk_bf16(a[0], a[1]); w.y = pg8::cvt_pk_bf16(a[2], a[3]); return w; }
DI void unpack8(const u32x4& w, f32x4& a, f32x4& b) {
    a[0] = __uint_as_float(w.x << 16); a[1] = __uint_as_float(w.x & 0xffff0000u); a[2] = __uint_as_float(w.y << 16); a[3] = __uint_as_float(w.y & 0xffff0000u);
    b[0] = __uint_as_float(w.z << 16); b[1] = __uint_as_float(w.z & 0xffff0000u); b[2] = __uint_as_float(w.w << 16); b[3] = __uint_as_float(w.w & 0xffff0000u); }


struct EpiInproj {
    static constexpr bool PERM = false, AFTER_DRAIN = false;
    unsigned char* ws; const float *b_gates, *qn_g, *kn_g; bf16* MG;
    DI void operator()(const f32x4 (&acc)[2][2][4][2], const Unit& u, int wr, int wc, int fr, int fq) const {
        const int pn = u.pn; const bool lat = u.pm < M_LAT / 256;
        const int row0 = u.pm * 256 + wr * 64 + fr;
        if (pn < 4) {
            const bool isq = pn < 2; bf16* T = (bf16*)(ws + (isq ? WS_QA : WS_KA)); const int tcol = 256 * (pn & 1) + 64 * wc + 4 * fq;
            const float* rope = (const float*)(ws + WS_ROPE); const float sc = isq ? 0.125f : 1.f;
#pragma unroll
            for (int ai = 0; ai < 2; ++ai)
#pragma unroll
                for (int m = 0; m < 4; ++m) { const int row = row0 + ai * 128 + m * 16; bf16* rp = T + (size_t)row * 512 + tcol;
                    const int t = row & (SEQ - 1);
#pragma unroll
                    for (int bj = 0; bj < 2; ++bj) { f32x4 cs = {1.f, 1.f, 1.f, 1.f}, sn = {0.f, 0.f, 0.f, 0.f};
                        if (lat) { const int pos = bj ? (t & 63) : (t >> 6); cs = *(const f32x4*)(rope + pos * 32 + 4 * fq); sn = *(const f32x4*)(rope + pos * 32 + 16 + 4 * fq); }
                        const f32x4 x1 = acc[ai][bj][m][0], x2 = acc[ai][bj][m][1];
                        const f32x4 o1 = (x1 * cs - x2 * sn) * sc, o2 = (x2 * cs + x1 * sn) * sc;
                        *(u32x2*)(rp + 32 * bj) = pack4(o1); *(u32x2*)(rp + 32 * bj + 16) = pack4(o2); } }
        } else if (pn < 8 || (pn >= 20 && pn < 24)) {
            bf16* T = (bf16*)(ws + (pn < 8 ? WS_VA : WS_VB)); const int tcol = 256 * (pn & 3) + 64 * wc + 8 * fq;
#pragma unroll
            for (int ai = 0; ai < 2; ++ai)
#pragma unroll
                for (int m = 0; m < 4; ++m) { bf16* rp = T + (size_t)(row0 + ai * 128 + m * 16) * 1024 + tcol;
#pragma unroll
                    for (int bj = 0; bj < 2; ++bj) *(u32x4*)(rp + 32 * bj) = pack8(acc[ai][bj][m][0], acc[ai][bj][m][1]); }
        } else if (pn < 12) {
            if (!lat) return;
            bf16* T = (bf16*)(ws + WS_OA); const int tcol = 256 * (pn & 3) + 64 * wc + 8 * fq;
#pragma unroll
            for (int ai = 0; ai < 2; ++ai)
#pragma unroll
                for (int m = 0; m < 4; ++m) { bf16* rp = T + (size_t)(row0 + ai * 128 + m * 16) * 1024 + tcol;
#pragma unroll
                    for (int bj = 0; bj < 2; ++bj) { f32x4 a = acc[ai][bj][m][0], b = acc[ai][bj][m][1];
#pragma unroll
                        for (int j = 0; j < 4; ++j) { a[j] = fsig(a[j]); b[j] = fsig(b[j]); }
                        *(u32x4*)(rp + 32 * bj) = pack8(a, b); } }
        } else if (pn < 20) {
            const bool isq = pn < 16; if (isq && !lat) return;
            bf16* T = (bf16*)(ws + (isq ? WS_QB : WS_KB)); const int tcol = 256 * (pn & 3) + 64 * wc + 8 * fq;
            const float* g = isq ? qn_g : kn_g; const float sc = isq ? 0.125f : 1.f;
            f32x4 gv[2][2];
#pragma unroll
            for (int bj = 0; bj < 2; ++bj)
#pragma unroll
                for (int n = 0; n < 2; ++n) gv[bj][n] = *(const f32x4*)(g + 32 * bj + 8 * fq + 4 * n) * sc;
#pragma unroll
            for (int ai = 0; ai < 2; ++ai)
#pragma unroll
                for (int m = 0; m < 4; ++m) { bf16* rp = T + (size_t)(row0 + ai * 128 + m * 16) * 1024 + tcol;
                    float ss = 0.f;
#pragma unroll
                    for (int bj = 0; bj < 2; ++bj)
#pragma unroll
                        for (int n = 0; n < 2; ++n) { const f32x4 v = acc[ai][bj][m][n]; ss += (v[0] * v[0] + v[1] * v[1]) + (v[2] * v[2] + v[3] * v[3]); }
                    ss += __shfl_xor(ss, 16); ss += __shfl_xor(ss, 32);
                    const float rs = rsqrtf(ss * (1.f / 64.f) + EPS);
#pragma unroll
                    for (int bj = 0; bj < 2; ++bj) *(u32x4*)(rp + 32 * bj) = pack8(acc[ai][bj][m][0] * rs * gv[bj][0], acc[ai][bj][m][1] * rs * gv[bj][1]); }
        } else if (pn >= 25) {
            if (!lat) return;
            const int tcol = 256 * (pn - 25) + 64 * wc + 8 * fq;
#pragma unroll
            for (int ai = 0; ai < 2; ++ai)
#pragma unroll
                for (int m = 0; m < 4; ++m) { bf16* rp = MG + (size_t)(row0 + ai * 128 + m * 16) * 2048 + tcol;
#pragma unroll
                    for (int bj = 0; bj < 2; ++bj) { f32x4 a = acc[ai][bj][m][0], b = acc[ai][bj][m][1];
#pragma unroll
                        for (int j = 0; j < 4; ++j) { a[j] = fsig(a[j]); b[j] = fsig(b[j]); }
                        *(u32x4*)(rp + 32 * bj) = pack8(a, b); } }
        } else {
            if (wc != 0) return;
            float* G = (float*)(ws + WS_GATES);
#pragma unroll
            for (int n = 0; n < 2; ++n) { const int g0 = 16 * n + 4 * fq; const f32x4 bias = *(const f32x4*)(b_gates + g0); const bool lf = (g0 >> 3) & 1;
#pragma unroll
                for (int ai = 0; ai < 2; ++ai)
#pragma unroll
                    for (int m = 0; m < 4; ++m) { f32x4 v = acc[ai][0][m][n] + bias;
#pragma unroll
                        for (int j = 0; j < 4; ++j) { const float cp = GCAP * tanhf(v[j] * (1.f / GCAP)); v[j] = lf ? logsigmoidf_(cp) : cp; }
                        *(f32x4*)(G + (size_t)(row0 + ai * 128 + m * 16) * 32 + g0) = v; } }
        }
    }
};
struct EpiMG {
    static constexpr bool PERM = false, AFTER_DRAIN = false;
    bf16* MG; int mask;
    DI void operator()(const f32x4 (&acc)[2][2][4][2], const Unit& u, int wr, int wc, int fr, int fq) const {
        if (!((mask >> u.pn) & 1)) return;
        const int row0 = u.pm * 256 + wr * 64 + fr, tcol = 256 * u.pn + 64 * wc + 8 * fq;
#pragma unroll
        for (int ai = 0; ai < 2; ++ai)
#pragma unroll
            for (int m = 0; m < 4; ++m) { bf16* rp = MG + (size_t)(row0 + ai * 128 + m * 16) * 2048 + tcol;
#pragma unroll
                for (int bj = 0; bj < 2; ++bj) { f32x4 a = acc[ai][bj][m][0], b = acc[ai][bj][m][1];
#pragma unroll
                    for (int j = 0; j < 4; ++j) { a[j] = fsig(a[j]); b[j] = fsig(b[j]); }
                    *(u32x4*)(rp + 32 * bj) = pack8(a, b); } }
    }
};
template <bool SECOND> struct EpiMerge {
    static constexpr bool PERM = false, AFTER_DRAIN = false;
    const bf16* MG; float* TMP; bf16* T1;
    DI void operator()(const f32x4 (&acc)[2][2][4][2], const Unit& u, int wr, int wc, int fr, int fq) const {
        const int row0 = u.pm * 256 + wr * 64 + fr, tcol = 256 * u.pn + 64 * wc + 8 * fq;
#pragma unroll
        for (int ai = 0; ai < 2; ++ai)
#pragma unroll
            for (int m = 0; m < 4; ++m) { const size_t row = row0 + ai * 128 + m * 16;
#pragma unroll
                for (int bj = 0; bj < 2; ++bj) { const int col = tcol + 32 * bj;
                    f32x4 ga, gb; unpack8(*(const u32x4*)(MG + row * 2048 + (SECOND ? 1024 : 0) + col), ga, gb);
                    float* tp = TMP + row * 1024 + col;
                    if (!SECOND) { *(f32x4*)tp = ga * acc[ai][bj][m][0]; *(f32x4*)(tp + 4) = gb * acc[ai][bj][m][1]; }
                    else { const f32x4 t0 = *(const f32x4*)tp, t1 = *(const f32x4*)(tp + 4);
                        *(u32x4*)(T1 + row * 1024 + col) = pack8(t0 + ga * acc[ai][bj][m][0], t1 + gb * acc[ai][bj][m][1]); } } }
    }
};
struct EpiOut {
    static constexpr bool PERM = false, AFTER_DRAIN = false;
    const float* x; float* out; bf16* XS; float* sumsq; const float* modv; const float* norm2_g;
    DI void operator()(const f32x4 (&acc)[2][2][4][2], const Unit& u, int wr, int wc, int fr, int fq) const {
        const int row0 = u.pm * 256 + wr * 64 + fr, tcol = 256 * u.pn + 64 * wc + 8 * fq, b = u.pm >> 5;
        const float* mv = modv + b * 6144;
        f32x4 g1[2][2], s2[2][2];
#pragma unroll
        for (int bj = 0; bj < 2; ++bj)
#pragma unroll
            for (int n = 0; n < 2; ++n) { const int col = tcol + 32 * bj + 4 * n; g1[bj][n] = *(const f32x4*)(mv + 2048 + col); s2[bj][n] = *(const f32x4*)(norm2_g + col) * (*(const f32x4*)(mv + 4096 + col) + 1.f); }
#pragma unroll
        for (int ai = 0; ai < 2; ++ai)
#pragma unroll
            for (int m = 0; m < 4; ++m) { const size_t row = row0 + ai * 128 + m * 16; float ss = 0.f;
#pragma unroll
                for (int bj = 0; bj < 2; ++bj) { const size_t o = row * 1024 + tcol + 32 * bj;
                    const f32x4 x0 = *(const f32x4*)(x + o) + g1[bj][0] * acc[ai][bj][m][0], x1 = *(const f32x4*)(x + o + 4) + g1[bj][1] * acc[ai][bj][m][1];
                    *(f32x4*)(out + o) = x0; *(f32x4*)(out + o + 4) = x1;
                    *(u32x4*)(XS + o) = pack8(x0 * s2[bj][0], x1 * s2[bj][1]);
                    ss += (x0[0] * x0[0] + x0[1] * x0[1]) + (x0[2] * x0[2] + x0[3] * x0[3]) + (x1[0] * x1[0] + x1[1] * x1[1]) + (x1[2] * x1[2] + x1[3] * x1[3]); }
                ss += __shfl_xor(ss, 16); ss += __shfl_xor(ss, 32);
                if (fq == 0) atomicAdd(sumsq + row, ss); }
    }
};
struct EpiFfn1 {
    static constexpr bool PERM = false, AFTER_DRAIN = false;
    bf16* HFF; const float* sumsq; const float* bgu;
    DI void operator()(const f32x4 (&acc)[2][2][4][2], const Unit& u, int wr, int wc, int fr, int fq) const {
        const int row0 = u.pm * 256 + wr * 64 + fr, hcol = 128 * u.pn + 32 * wc + 8 * fq, b = u.pm >> 5;
        const float* bg = bgu + (size_t)b * 2 * DFF + hcol; const float* bu = bg + DFF;
        const f32x4 bg0 = *(const f32x4*)bg, bg1 = *(const f32x4*)(bg + 4), bu0 = *(const f32x4*)bu, bu1 = *(const f32x4*)(bu + 4);
#pragma unroll
        for (int ai = 0; ai < 2; ++ai)
#pragma unroll
            for (int m = 0; m < 4; ++m) { const size_t row = row0 + ai * 128 + m * 16;
                const float rs = rsqrtf(sumsq[row] * (1.f / DM) + EPS);
                f32x4 g0 = acc[ai][0][m][0] * rs + bg0, g1 = acc[ai][0][m][1] * rs + bg1; const f32x4 u0 = acc[ai][1][m][0] * rs + bu0, u1 = acc[ai][1][m][1] * rs + bu1;
#pragma unroll
                for (int j = 0; j < 4; ++j) { g0[j] = g0[j] * fsig(g0[j]) * u0[j]; g1[j] = g1[j] * fsig(g1[j]) * u1[j]; }
                *(u32x4*)(HFF + row * DFF + hcol) = pack8(g0, g1); }
    }
};
struct EpiFfn2 {
    static constexpr bool PERM = false, AFTER_DRAIN = false;
    float* out; const float* modv;
    DI void operator()(const f32x4 (&acc)[2][2][4][2], const Unit& u, int wr, int wc, int fr, int fq) const {
        const int row0 = u.pm * 256 + wr * 64 + fr, tcol = 256 * u.pn + 64 * wc + 8 * fq, b = u.pm >> 5;
        const float* mv = modv + b * 6144 + 5120;
        f32x4 g2[2][2];
#pragma unroll
        for (int bj = 0; bj < 2; ++bj)
#pragma unroll
            for (int n = 0; n < 2; ++n) g2[bj][n] = *(const f32x4*)(mv + tcol + 32 * bj + 4 * n);
#pragma unroll
        for (int ai = 0; ai < 2; ++ai)
#pragma unroll
            for (int m = 0; m < 4; ++m) { const size_t row = row0 + ai * 128 + m * 16;
#pragma unroll
                for (int bj = 0; bj < 2; ++bj) { float* o = out + row * 1024 + tcol + 32 * bj;
                    *(f32x4*)o = *(const f32x4*)o + g2[bj][0] * acc[ai][bj][m][0]; *(f32x4*)(o + 4) = *(const f32x4*)(o + 4) + g2[bj][1] * acc[ai][bj][m][1]; } }
    }
};

DI void conv_item(const float* W, int ldw, int L0, bool zero, bool perm8, bf16* dst, int K, int k0, LAS float* scr, int lane) {
#pragma unroll 8
    for (int i = 0; i < 32; ++i) { const int kk = 2 * i + (lane >> 5); scr[kk * 33 + (lane & 31)] = zero ? 0.f : W[(size_t)(k0 + kk) * ldw + L0 + (lane & 31)]; }
    LDS_WAIT(); asm volatile("" ::: "memory");
    const int c = lane & 7;
#pragma unroll
    for (int jj = 0; jj < 4; ++jj) { const int i = (lane >> 3) + 8 * jj; const int src = perm8 ? (8 * ((i >> 2) & 3) + 4 * (i >> 4) + (i & 3)) : i;
        const LAS float* s = scr + (8 * c) * 33 + src;
        u32x4 o; o.x = pg8::cvt_pk_bf16(s[0], s[33]); o.y = pg8::cvt_pk_bf16(s[2 * 33], s[3 * 33]); o.z = pg8::cvt_pk_bf16(s[4 * 33], s[5 * 33]); o.w = pg8::cvt_pk_bf16(s[6 * 33], s[7 * 33]);
        *(u32x4*)(dst + (size_t)i * K + k0 + 8 * c) = o; }
    LDS_WAIT(); asm volatile("" ::: "memory");
}
DI int inproj_src_col(int pn) {
    return pn < 2 ? C_QA + 256 * pn : pn < 4 ? C_KA + 256 * (pn - 2) : pn < 8 ? C_VA + 256 * (pn - 4) : pn < 12 ? C_OA + 256 * (pn - 8) : pn < 16 ? C_QB + 256 * (pn - 12)
         : pn < 20 ? C_KB + 256 * (pn - 16) : pn < 24 ? C_VB + 256 * (pn - 20) : pn == 24 ? C_G : C_MG + 256 * (pn - 25);
}
constexpr int CI_WIN = 33 * 8 * 16, CI_SQ = 4 * 8 * 16, CI_GU = 22 * 8 * 16, CI_WD = 4 * 8 * 44, CI_TOTAL = CI_WIN + 3 * CI_SQ + CI_GU + CI_WD;
DI void phase_convert(const P& p, LAS unsigned char* lds, int gw, int ngw, int wave, int lane) {
    LAS float* scr = (LAS float*)(lds + wave * 16384);
    for (int it = gw; it < CI_TOTAL; it += ngw) {
        int r = it;
        if (r < CI_WIN) { const int kb = r & 15, g8 = (r >> 4) & 7, pn = r >> 7, bj = g8 >> 2, wc = g8 & 3;
            const bool zero = pn == 24 && g8 != 0; const int L0 = pn == 24 ? C_G : inproj_src_col(pn) + 64 * wc + 32 * bj;
            conv_item(p.w_in, DIN, L0, zero, pn >= 4 && pn != 24, (bf16*)(p.ws + WS_WIN) + (size_t)(pn * 256 + 128 * bj + 32 * wc) * 1024, 1024, kb * 64, scr, lane); continue; }
        r -= CI_WIN;
        if (r < 3 * CI_SQ) { const int which = r / CI_SQ; r -= which * CI_SQ; const int kb = r & 15, g8 = (r >> 4) & 7, pn = r >> 7, bj = g8 >> 2, wc = g8 & 3;
            const float* W = which == 0 ? p.w_a : which == 1 ? p.w_b : p.w_o; bf16* D = (bf16*)(p.ws + (which == 0 ? WS_WA : which == 1 ? WS_WB : WS_WO));
            conv_item(W, 1024, 256 * pn + 64 * wc + 32 * bj, false, true, D + (size_t)(pn * 256 + 128 * bj + 32 * wc) * 1024, 1024, kb * 64, scr, lane); continue; }
        r -= 3 * CI_SQ;
        if (r < CI_GU) { const int kb = r & 15, g8 = (r >> 4) & 7, pn = r >> 7, bj = g8 >> 2, wc = g8 & 3;
            conv_item(bj ? p.w_fu : p.w_fg, DFF, 128 * pn + 32 * wc, false, true, (bf16*)(p.ws + WS_WGU) + (size_t)(pn * 256 + 128 * bj + 32 * wc) * 1024, 1024, kb * 64, scr, lane); continue; }
        r -= CI_GU;
        { const int kb = r % 44, g = r / 44, g8 = g & 7, pn = g >> 3, bj = g8 >> 2, wc = g8 & 3;
            conv_item(p.w_fd, 1024, 256 * pn + 64 * wc + 32 * bj, false, true, (bf16*)(p.ws + WS_WD) + (size_t)(pn * 256 + 128 * bj + 32 * wc) * DFF, DFF, kb * 64, scr, lane); }
    }
}
template <int R> DI void gemv_task(const float* W, int ldw, int col0, const LAS float* A, LAS float* red, float* out, int ldo, const float* bias, int tid) {
    const int col = tid & 31, kg = tid >> 5;
    float acc[R];
#pragma unroll
    for (int r = 0; r < R; ++r) acc[r] = 0.f;
#pragma unroll 4
    for (int i = 0; i < 64; ++i) { const int k = kg + 16 * i; const float w = W[(size_t)k * ldw + col0 + col];
#pragma unroll
        for (int r = 0; r < R; ++r) acc[r] += A[r * 1024 + k] * w; }
#pragma unroll
    for (int r = 0; r < R; ++r) red[(kg * R + r) * 32 + col] = acc[r];
    __syncthreads();
    if (tid < R * 32) { const int r = tid >> 5, c = tid & 31; float s = bias ? bias[col0 + c] : 0.f;
#pragma unroll
        for (int g = 0; g < 16; ++g) s += red[(g * R + r) * 32 + c];
        out[(size_t)r * ldo + col0 + c] = s; }
    __syncthreads();
}
DI void phase_bgu(const P& p, LAS unsigned char* lds, int blk, int nblk, int tid) {
    LAS float* A = (LAS float*)lds; LAS float* red = A + 4 * 1024;
    const float* modv = (const float*)(p.ws + WS_MODV);
    for (int i = tid; i < 4 * 1024; i += NTHR) A[i] = modv[(i >> 10) * 6144 + 3072 + (i & 1023)];
    __syncthreads();
    for (int t = blk; t < 176; t += nblk) { const int which = t / 88, col0 = (t % 88) * 32;
        gemv_task<4>(which ? p.w_fu : p.w_fg, DFF, col0, A, red, (float*)(p.ws + WS_BGU) + which * DFF, 2 * DFF, nullptr, tid); }
    __syncthreads();
}

enum { PH_CONV = 0, PH_INPROJ, PH_MERGE, PH_OUT, PH_FFN1, PH_FFN2, PH_COUNT };
__global__ void __launch_bounds__(NTHR, 2) mk_fwd(P p, int ph_lo, int ph_hi, int li, int dbg) {
    extern __shared__ __attribute__((aligned(16))) unsigned char lds_raw[];
    LAS unsigned char* lds = (LAS unsigned char*)lds_raw;
    const int tid = threadIdx.x, lane = tid & 63, wave = __builtin_amdgcn_readfirstlane(tid >> 6);
    const int G = gridDim.x, bx = blockIdx.x;
    const int vcu = (G % 8 == 0) ? (bx % 8) * (G / 8) + bx / 8 : bx;
    const int gw = vcu * NWAVES + wave, ngw = G * NWAVES;
    if (tid < 64) ((LAS unsigned*)(lds + LDSCTL_OFF))[tid] = 0u;
    __syncthreads();
    const XcdBarrier bar = xcd_barrier_post((unsigned*)(p.ws + WS_CTL) + 4096 * li, (volatile LAS unsigned*)(lds + LDSCTL_OFF));
#define IN(k) (ph_lo <= (k) && (k) < ph_hi)
#define SEAM(k) do { if (IN(k) && IN((k) + 1)) xcd_barrier(bar); } while (0)
    if (IN(PH_CONV)) { phase_convert(p, lds, gw, ngw, wave, lane); __syncthreads(); phase_bgu(p, lds, bx, G, tid); }
    SEAM(PH_CONV);
    if (IN(PH_INPROJ)) {
        pg8::Gemm g{(const bf16*)(p.ws + WS_HX), (const bf16*)(p.ws + WS_WIN), M_ALL, 33 * 256, DM}; pg8::StaticOrder S; S.init(M_ALL, 33 * 256, G, bx);
        EpiInproj E{p.ws, p.b_gates, p.qn_g, p.kn_g, (bf16*)p.out};
        pg8::gemm_phase<EpiInproj, pg8::StaticOrder, true, true>(lds, g, S, E);
    }
    SEAM(PH_INPROJ);
    if (IN(PH_MERGE)) {
        pg8::StaticOrder S; S.init(M_LAT, DM, G, bx);
        { pg8::Gemm g{(const bf16*)(p.ws + WS_VA), (const bf16*)(p.ws + WS_WA), M_LAT, DM, DM};
          EpiMerge<false> E{(const bf16*)p.out, (float*)(p.ws + WS_TMP), (bf16*)(p.ws + WS_T1)};
          pg8::gemm_phase<EpiMerge<false>, pg8::StaticOrder, true, true>(lds, g, S, E); }
        __syncthreads();
        { pg8::Gemm g{(const bf16*)(p.ws + WS_QB), (const bf16*)(p.ws + WS_WB), M_LAT, DM, DM};
          EpiMerge<true> E{(const bf16*)p.out, (float*)(p.ws + WS_TMP), (bf16*)(p.ws + WS_T1)};
          pg8::gemm_phase<EpiMerge<true>, pg8::StaticOrder, true, true>(lds, g, S, E); }
    }
    SEAM(PH_MERGE);
    if (IN(PH_OUT)) {
        pg8::Gemm g{(const bf16*)(p.ws + WS_T1), (const bf16*)(p.ws + WS_WO), M_LAT, DM, DM}; pg8::StaticOrder S; S.init(M_LAT, DM, G, bx);
        EpiOut E{p.x, p.out, (bf16*)(p.ws + WS_XS), (float*)(p.ws + WS_SUMSQ), (const float*)(p.ws + WS_MODV), p.norm2_g};
        pg8::gemm_phase<EpiOut, pg8::StaticOrder, true, true>(lds, g, S, E);
    }
    SEAM(PH_OUT);
    if (IN(PH_FFN1)) {
        pg8::Gemm g{(const bf16*)(p.ws + WS_XS), (const bf16*)(p.ws + WS_WGU), M_LAT, 2 * DFF, DM}; pg8::StaticOrder S; S.init(M_LAT, 2 * DFF, G, bx);
        EpiFfn1 E{(bf16*)(p.ws + WS_HFF), (const float*)(p.ws + WS_SUMSQ), (const float*)(p.ws + WS_BGU)};
        pg8::gemm_phase<EpiFfn1, pg8::StaticOrder, true, true>(lds, g, S, E);
    }
    SEAM(PH_FFN1);
    if (IN(PH_FFN2)) {
        pg8::Gemm g{(const bf16*)(p.ws + WS_HFF), (const bf16*)(p.ws + WS_WD), M_LAT, DM, DFF}; pg8::StaticOrder S; S.init(M_LAT, DM, G, bx);
        EpiFfn2 E{p.out, (const float*)(p.ws + WS_MODV)};
        pg8::gemm_phase<EpiFfn2, pg8::StaticOrder, true, true>(lds, g, S, E);
    }
#undef IN
#undef SEAM
}
__global__ void __launch_bounds__(256) nk_mod(P p) {
    const int col = blockIdx.x * 256 + threadIdx.x, r = blockIdx.y;
    const float* src = r < 4 ? p.c + r * DM : p.c_ctx;
    float acc = p.b_mod[col];
    for (int k = 0; k < DM; ++k) { const float v = src[k]; acc += (v / (1.f + expf(-v))) * p.w_mod[(size_t)k * 6144 + col]; }
    ((float*)(p.ws + WS_MODV))[r * 6144 + col] = acc;
}
__global__ void __launch_bounds__(256) nk_tables(P p) {
    const int i = blockIdx.x * 256 + threadIdx.x;
    if (i < 128 * 16) { const int pos = i / 16, f = i % 16; const float inv = powf(10000.f, -(float)f / 16.f); const float ang = (float)pos * inv;
        float* t = (float*)(p.ws + WS_ROPE); t[pos * 32 + f] = (float)cos((double)ang); t[pos * 32 + 16 + f] = (float)sin((double)ang); }
    if (i < M_LAT) ((float*)(p.ws + WS_SUMSQ))[i] = 0.f;
}
__global__ void __launch_bounds__(256) nk_norm1(P p) {
    const int row = blockIdx.x * 4 + (threadIdx.x >> 6), lane = threadIdx.x & 63;
    const float* xr = row < M_LAT ? p.x + (size_t)row * DM : p.ctx + (size_t)(row - M_LAT) * DM;
    const int mr = row < M_LAT ? row / SEQ : 4;
    const float* modv = (const float*)(p.ws + WS_MODV) + mr * 6144;
    float v[16]; float ss = 0.f;
#pragma unroll
    for (int j = 0; j < 16; ++j) { v[j] = xr[lane + 64 * j]; ss += v[j] * v[j]; }
    for (int o = 1; o < 64; o <<= 1) ss += __shfl_xor(ss, o);
    const float rstd = rsqrtf(ss * (1.f / DM) + EPS);
    bf16* o = (bf16*)(p.ws + WS_HX) + (size_t)row * DM;
#pragma unroll
    for (int j = 0; j < 16; ++j) { const int k = lane + 64 * j; o[k] = f2bf(v[j] * rstd * p.norm1_g[k] * (1.f + modv[1024 + k]) + modv[k]); }
}
__global__ void __launch_bounds__(256) nk_inproj(P p, int cb0) {
    __shared__ bf16 hx[8][DM];
    __shared__ float ot[8][256];
    const int tid = threadIdx.x, cb = blockIdx.x + cb0, row0 = blockIdx.y * 8;
    const int col0 = cb < 12 ? cb * 256 : (cb == 12 ? C_G : C_QB + (cb - 13) * 256);
    const bool valid = cb != 12 || tid < 32;
    const int col = col0 + tid;
    const bf16* HX = (const bf16*)(p.ws + WS_HX);
    for (int i = tid; i < 8 * DM; i += 256) hx[i / DM][i % DM] = HX[(size_t)(row0 + i / DM) * DM + i % DM];
    __syncthreads();
    float acc[8];
#pragma unroll
    for (int r = 0; r < 8; ++r) acc[r] = 0.f;
    if (valid) for (int k = 0; k < DM; ++k) { const float w = p.w_in[(size_t)k * DIN + col];
#pragma unroll
        for (int r = 0; r < 8; ++r) acc[r] += bf2f(hx[r][k]) * w; }
#pragma unroll
    for (int r = 0; r < 8; ++r) ot[r][tid] = acc[r];
    __syncthreads();
    if (!valid) return;
    const float* rope = (const float*)(p.ws + WS_ROPE);
#pragma unroll
    for (int r = 0; r < 8; ++r) {
        const int row = row0 + r; const bool lat = row < M_LAT; const float v = ot[r][tid];
        if (col < C_VA) {
            const bool isq = col < C_KA; const int cc = isq ? col : col - C_KA; const int d = cc & 63;
            float o = v;
            if (lat) { const int t = row % SEQ; const int pos = (d & 32) ? (t % GW) : (t / GW); const int f = d & 15; const bool first = (d & 16) == 0;
                const float cs = rope[pos * 32 + f], sn = rope[pos * 32 + 16 + f];
                const float other = ot[r][first ? tid + 16 : tid - 16];
                o = first ? v * cs - other * sn : v * cs + other * sn; }
            if (isq) o *= 0.125f;
            ((bf16*)(p.ws + (isq ? WS_QA : WS_KA)))[(size_t)row * 512 + cc] = f2bf(o);
        } else if (col < C_OA) { ((bf16*)(p.ws + WS_VA))[(size_t)row * 1024 + col - C_VA] = f2bf(v);
        } else if (col < C_G) { if (lat) ((bf16*)(p.ws + WS_OA))[(size_t)row * 1024 + col - C_OA] = f2bf(sigmoidf_(v));
        } else if (col < C_QB) { const int g = col - C_G; const float raw = v + p.b_gates[g]; const float cp = GCAP * tanhf(raw / GCAP);
            ((float*)(p.ws + WS_GATES))[(size_t)row * 32 + g] = ((g >> 3) & 1) ? logsigmoidf_(cp) : cp;
        } else if (col < C_VB) {
            const bool isq = col < C_KB; const int cc = isq ? col - C_QB : col - C_KB; const int d = cc & 63, hb = tid & ~63;
            float ss = 0.f; for (int i = 0; i < 64; ++i) { const float u = ot[r][hb + i]; ss += u * u; }
            const float y = v * rsqrtf(ss * (1.f / 64.f) + EPS);
            if (isq) { if (lat) ((bf16*)(p.ws + WS_QB))[(size_t)row * 1024 + cc] = f2bf(y * p.qn_g[d] * 0.125f); }
            else ((bf16*)(p.ws + WS_KB))[(size_t)row * 1024 + cc] = f2bf(y * p.kn_g[d]);
        } else if (col < C_MG) { ((bf16*)(p.ws + WS_VB))[(size_t)row * 1024 + col - C_VB] = f2bf(v);
        } else { if (lat) ((bf16*)p.out)[(size_t)row * 2048 + col - C_MG] = f2bf(sigmoidf_(v)); }
    }
}
__global__ void __launch_bounds__(64) nk_na(P p) {
    __shared__ float q[64]; __shared__ float sc[384]; __shared__ int tok[384];
    const int row = blockIdx.x, h = blockIdx.y, j = threadIdx.x;
    const int b = row / SEQ, t = row % SEQ, qr = t / GW, qc = t % GW;
    bf16* QB = (bf16*)(p.ws + WS_QB); const bf16* KB = (const bf16*)(p.ws + WS_KB); const bf16* VB = (const bf16*)(p.ws + WS_VB);
    q[j] = bf2f(QB[(size_t)row * 1024 + h * 64 + j]);
    __syncthreads();
    const int wr0 = min(max(qr - 4, 0), GROWS - 8), wc0 = min(max(qc - 8, 0), GW - 16);
    for (int kk = j; kk < 384; kk += 64) {
        int krow_; float bias = 0.f;
        if (kk < 128) { const int kr = wr0 + kk / 16, kc = wc0 + kk % 16; krow_ = b * SEQ + kr * GW + kc; bias = p.rpb[(h * 15 + (kr - qr + 7)) * 31 + (kc - qc + 15)]; }
        else krow_ = M_LAT + b * CTX + (kk - 128);
        const bf16* kp = KB + (size_t)krow_ * 1024 + h * 64; float s = 0.f;
        for (int d = 0; d < 64; ++d) s += q[d] * bf2f(kp[d]);
        sc[kk] = s + bias; tok[kk] = krow_;
    }
    __syncthreads();
    float mx = -1e30f; for (int kk = 0; kk < 384; ++kk) mx = fmaxf(mx, sc[kk]);
    float sum = 0.f, o = 0.f;
    for (int kk = 0; kk < 384; ++kk) { const float e = __expf(sc[kk] - mx); sum += e; o += e * bf2f(VB[(size_t)tok[kk] * 1024 + h * 64 + j]); }
    QB[(size_t)row * 1024 + h * 64 + j] = f2bf(o / sum);
}
DI int chunk_row0(int b, int c) { return c < 2 ? M_LAT + b * CTX + 128 * c : b * SEQ + 128 * (c - 2); }
__global__ void __launch_bounds__(256) nk_mA(P p) {
    __shared__ float wf[128], wb[128], st[4];
    const int c = blockIdx.x, h = blockIdx.y, b = blockIdx.z, tid = threadIdx.x;
    const int row0 = chunk_row0(b, c);
    const float* G = (const float*)(p.ws + WS_GATES);
    if (tid == 0) {
        float bl = 0.f; for (int i = 0; i < 128; ++i) bl += G[(size_t)(row0 + i) * 32 + 8 + h];
        float cs = 0.f, mx = -1e30f;
        for (int i = 0; i < 128; ++i) { cs += G[(size_t)(row0 + i) * 32 + 8 + h]; const float ge = bl - cs + G[(size_t)(row0 + i) * 32 + h]; wf[i] = ge; mx = fmaxf(mx, ge); }
        for (int i = 0; i < 128; ++i) wf[i] = __expf(wf[i] - mx);
        st[0] = bl; st[1] = mx;
        float ex = 0.f, mxb = -1e30f;
        for (int i = 0; i < 128; ++i) { const float ge = ex + G[(size_t)(row0 + i) * 32 + 16 + h]; wb[i] = ge; mxb = fmaxf(mxb, ge); ex += G[(size_t)(row0 + i) * 32 + 24 + h]; }
        for (int i = 0; i < 128; ++i) wb[i] = __expf(wb[i] - mxb);
        st[2] = ex; st[3] = mxb;
    }
    __syncthreads();
    const bf16* KA = (const bf16*)(p.ws + WS_KA); const bf16* VA = (const bf16*)(p.ws + WS_VA);
    bf16* UC = (bf16*)(p.ws + WS_UC);
    for (int e = tid; e < 2 * 128 * 64; e += 256) {
        const int dir = e >> 13, dv = (e >> 6) & 127, dk = e & 63; const float* w = dir ? wb : wf;
        float s = 0.f;
        for (int i = 0; i < 128; ++i) s += bf2f(VA[(size_t)(row0 + i) * 1024 + h * 128 + dv]) * bf2f(f2bf(bf2f(KA[(size_t)(row0 + i) * 512 + h * 64 + dk]) * w[i]));
        UC[((((size_t)dir * NB + b) * NHA + h) * NCH + c) * 8192 + dv * 64 + dk] = f2bf(s);
    }
    if (tid < 128) { const int dir = tid >> 6, dk = tid & 63; const float* w = dir ? wb : wf; float s = 0.f;
        for (int i = 0; i < 128; ++i) s += bf2f(f2bf(bf2f(KA[(size_t)(row0 + i) * 512 + h * 64 + dk]) * w[i]));
        ((float*)(p.ws + WS_NU))[((((size_t)b * NHA + h) * 2 + dir) * NCH + c) * 64 + dk] = s; }
    if (tid < 4) ((float*)(p.ws + WS_CH))[((((size_t)b * NHA + h) * 2 + (tid >> 1)) * NCH + c) * 2 + (tid & 1)] = st[tid];
}
__global__ void __launch_bounds__(256) nk_mB(P p) {
    const int bhd = blockIdx.y, e = blockIdx.x * 256 + threadIdx.x;
    const int dir = bhd & 1, bh = bhd >> 1, b = bh / NHA, h = bh % NHA;
    const float* CH = (const float*)(p.ws + WS_CH) + (size_t)bhd * NCH * 2;
    bf16* UC = (bf16*)(p.ws + WS_UC) + (((size_t)dir * NB + b) * NHA + h) * NCH * 8192;
    float* NU = (float*)(p.ws + WS_NU) + (size_t)bhd * NCH * 64;
    float* MIN = (float*)(p.ws + WS_MIN) + (size_t)bhd * NCH;
    float m = 0.f, s = 0.f;
    for (int i = 0; i < NCH; ++i) {
        const int c = dir == 0 ? i : (i < 2 ? 1 - i : NCH + 1 - i);
        const float bl = CH[c * 2], ml = CH[c * 2 + 1];
        const float mn = fmaxf(bl + m, ml), dec = __expf(bl + m - mn), scl = __expf(ml - mn);
        if (e < 8192) { const float u = bf2f(UC[(size_t)c * 8192 + e]); UC[(size_t)c * 8192 + e] = f2bf(s); s = dec * s + scl * u; }
        else if (e < 8256) { const float u = NU[c * 64 + e - 8192]; NU[c * 64 + e - 8192] = s; s = dec * s + scl * u; }
        if (e == 0) MIN[c] = m;
        m = mn;
    }
}
__global__ void __launch_bounds__(256) nk_mC(P p) {
    extern __shared__ float sm[];
    float* S = sm;
    float* ef = S + 128 * 129; float* Mf = ef + 128; float* af = Mf + 128; float* ff = af + 128;
    float* eb = ff + 128; float* Mb = eb + 128; float* ab = Mb + 128; float* fb = ab + 128; float* invf = fb + 128; float* invb = invf + 128;
    float* H = invb + 128;
    const int j = blockIdx.x, h = blockIdx.y, b = blockIdx.z, tid = threadIdx.x, c = j + 2;
    const int row0 = b * SEQ + 128 * j;
    const float* G = (const float*)(p.ws + WS_GATES);
    const bf16* QA = (const bf16*)(p.ws + WS_QA); const bf16* KA = (const bf16*)(p.ws + WS_KA); bf16* VA = (bf16*)(p.ws + WS_VA);
    const size_t bhd_f = ((size_t)b * NHA + h) * 2, bhd_b = bhd_f + 1;
    const float m_f = ((const float*)(p.ws + WS_MIN))[bhd_f * NCH + c], m_b = ((const float*)(p.ws + WS_MIN))[bhd_b * NCH + c];
    const float* n_f = (const float*)(p.ws + WS_NU) + (bhd_f * NCH + c) * 64; const float* n_b = (const float*)(p.ws + WS_NU) + (bhd_b * NCH + c) * 64;
    const bf16* C_f = (const bf16*)(p.ws + WS_UC) + ((((size_t)0 * NB + b) * NHA + h) * NCH + c) * 8192; const bf16* C_b = (const bf16*)(p.ws + WS_UC) + ((((size_t)1 * NB + b) * NHA + h) * NCH + c) * 8192;
    if (tid == 0) {
        float cs = 0.f, pm = m_f;
        for (int i = 0; i < 128; ++i) { cs += G[(size_t)(row0 + i) * 32 + 8 + h]; const float e = G[(size_t)(row0 + i) * 32 + h] - cs; ef[i] = e; pm = fmaxf(pm, e); Mf[i] = pm; af[i] = __expf(m_f - pm); ff[i] = __expf(-(cs + pm)); }
    }
    if (tid == 64) {
        float ss = 0.f, pm = m_b;
        for (int i = 127; i >= 0; --i) { ss += G[(size_t)(row0 + i) * 32 + 24 + h]; const float e = G[(size_t)(row0 + i) * 32 + 16 + h] - ss; eb[i] = e; pm = fmaxf(pm, e); Mb[i] = pm; ab[i] = __expf(m_b - pm); fb[i] = __expf(-(ss + pm)); }
    }
    for (int e = tid; e < 128 * 128; e += 256) { const int t = e >> 7, s = e & 127; float acc = 0.f;
        for (int d = 0; d < 64; ++d) acc += bf2f(QA[(size_t)(row0 + t) * 512 + h * 64 + d]) * bf2f(KA[(size_t)(row0 + s) * 512 + h * 64 + d]);
        S[t * 129 + s] = acc; }
    __syncthreads();
    { const int t = tid & 127; const bool fw = tid < 128; float den = 0.f, qn = 0.f;
        const float* nn = fw ? n_f : n_b;
        for (int d = 0; d < 64; ++d) qn += bf2f(QA[(size_t)(row0 + t) * 512 + h * 64 + d]) * nn[d];
        if (fw) { for (int s = 0; s <= t; ++s) den += S[t * 129 + s] * __expf(ef[s] - Mf[t]); den += af[t] * qn; invf[t] = 1.f / fmaxf(fabsf(den), ff[t]); }
        else { for (int s = t; s < 128; ++s) den += S[t * 129 + s] * __expf(eb[s] - Mb[t]); den += ab[t] * qn; invb[t] = 1.f / fmaxf(fabsf(den), fb[t]); } }
    __syncthreads();
    for (int e = tid; e < 128 * 128; e += 256) { const int t = e >> 7, s = e & 127;
        const float wf_ = s <= t ? __expf(ef[s] - Mf[t]) * invf[t] : 0.f, wb_ = s >= t ? __expf(eb[s] - Mb[t]) * invb[t] : 0.f;
        S[t * 129 + s] *= (wf_ + wb_); }
    __syncthreads();
    for (int e = tid; e < 128 * 128; e += 256) { const int t = e >> 7, dv = e & 127; float acc = 0.f;
        for (int s = 0; s < 128; ++s) acc += S[t * 129 + s] * bf2f(VA[(size_t)(row0 + s) * 1024 + h * 128 + dv]);
        float qc1 = 0.f, qc2 = 0.f;
        for (int d = 0; d < 64; ++d) { const float qv = bf2f(QA[(size_t)(row0 + t) * 512 + h * 64 + d]); qc1 += qv * bf2f(C_f[dv * 64 + d]); qc2 += qv * bf2f(C_b[dv * 64 + d]); }
        H[t * 128 + dv] = acc + af[t] * invf[t] * qc1 + ab[t] * invb[t] * qc2; }
    __syncthreads();
    for (int e = tid; e < 128 * 128; e += 256) { const int t = e >> 7, dv = e & 127;
        float ss = 0.f; for (int i = 0; i < 128; ++i) { const float u = H[t * 128 + ((i + dv) & 127)]; ss += u * u; }
        const float rn = rsqrtf(ss * (1.f / 128.f) + EPS);
        VA[(size_t)(row0 + t) * 1024 + h * 128 + dv] = f2bf(H[t * 128 + dv] * rn * p.mlstm_g[h * 128 + dv] * bf2f(((const bf16*)(p.ws + WS_OA))[(size_t)(row0 + t) * 1024 + h * 128 + dv])); }
}
template <int K> DI void load_a(bf16 (*a)[K], const bf16* A, int row0, int tid) { for (int i = tid; i < 8 * K; i += 256) a[i / K][i % K] = A[(size_t)(row0 + i / K) * K + i % K]; }
__global__ void __launch_bounds__(256) nk_merge(P p) {
    __shared__ bf16 a1[8][DM]; __shared__ bf16 a2[8][DM];
    const int tid = threadIdx.x, col = blockIdx.x * 256 + tid, row0 = blockIdx.y * 8;
    load_a<DM>(a1, (const bf16*)(p.ws + WS_VA), row0, tid); load_a<DM>(a2, (const bf16*)(p.ws + WS_QB), row0, tid);
    __syncthreads();
    float s1[8], s2[8];
#pragma unroll
    for (int r = 0; r < 8; ++r) { s1[r] = 0.f; s2[r] = 0.f; }
    for (int k = 0; k < DM; ++k) { const float wa = p.w_a[(size_t)k * DM + col], wb = p.w_b[(size_t)k * DM + col];
#pragma unroll
        for (int r = 0; r < 8; ++r) { s1[r] += bf2f(a1[r][k]) * wa; s2[r] += bf2f(a2[r][k]) * wb; } }
    const bf16* MG = (const bf16*)p.out;
#pragma unroll
    for (int r = 0; r < 8; ++r) { const size_t row = row0 + r; ((bf16*)(p.ws + WS_T1))[row * DM + col] = f2bf(bf2f(MG[row * 2048 + col]) * s1[r] + bf2f(MG[row * 2048 + 1024 + col]) * s2[r]); }
}
__global__ void __launch_bounds__(256) nk_outproj(P p) {
    __shared__ bf16 a1[8][DM]; __shared__ float red[8][4];
    const int tid = threadIdx.x, col = blockIdx.x * 256 + tid, row0 = blockIdx.y * 8, b = row0 / SEQ;
    load_a<DM>(a1, (const bf16*)(p.ws + WS_T1), row0, tid);
    __syncthreads();
    float s1[8];
#pragma unroll
    for (int r = 0; r < 8; ++r) s1[r] = 0.f;
    for (int k = 0; k < DM; ++k) { const float w = p.w_o[(size_t)k * DM + col];
#pragma unroll
        for (int r = 0; r < 8; ++r) s1[r] += bf2f(a1[r][k]) * w; }
    const float* modv = (const float*)(p.ws + WS_MODV) + b * 6144;
    const float g1 = modv[2048 + col], s2 = p.norm2_g[col] * (1.f + modv[4096 + col]);
#pragma unroll
    for (int r = 0; r < 8; ++r) { const size_t row = row0 + r; const float xn = p.x[row * DM + col] + g1 * s1[r];
        p.out[row * DM + col] = xn; ((bf16*)(p.ws + WS_XS))[row * DM + col] = f2bf(xn * s2);
        float q = xn * xn; for (int o = 1; o < 64; o <<= 1) q += __shfl_xor(q, o);
        if ((tid & 63) == 0) red[r][tid >> 6] = q; }
    __syncthreads();
    if (tid < 8) atomicAdd((float*)(p.ws + WS_SUMSQ) + row0 + tid, red[tid][0] + red[tid][1] + red[tid][2] + red[tid][3]);
}
__global__ void __launch_bounds__(256) nk_ffn1(P p) {
    __shared__ bf16 a1[8][DM];
    const int tid = threadIdx.x, col = blockIdx.x * 256 + tid, row0 = blockIdx.y * 8, b = row0 / SEQ;
    load_a<DM>(a1, (const bf16*)(p.ws + WS_XS), row0, tid);
    __syncthreads();
    const float* sh2 = (const float*)(p.ws + WS_MODV) + b * 6144 + 3072;
    float sg[8], su[8], bg = 0.f, bu = 0.f;
#pragma unroll
    for (int r = 0; r < 8; ++r) { sg[r] = 0.f; su[r] = 0.f; }
    for (int k = 0; k < DM; ++k) { const float wg = p.w_fg[(size_t)k * DFF + col], wu = p.w_fu[(size_t)k * DFF + col]; const float sh = sh2[k]; bg += sh * wg; bu += sh * wu;
#pragma unroll
        for (int r = 0; r < 8; ++r) { const float a = bf2f(a1[r][k]); sg[r] += a * wg; su[r] += a * wu; } }
#pragma unroll
    for (int r = 0; r < 8; ++r) { const size_t row = row0 + r; const float rstd = rsqrtf(((const float*)(p.ws + WS_SUMSQ))[row] * (1.f / DM) + EPS);
        const float g = rstd * sg[r] + bg, u = rstd * su[r] + bu;
        ((bf16*)(p.ws + WS_HFF))[row * DFF + col] = f2bf(g * sigmoidf_(g) * u); }
}
__global__ void __launch_bounds__(256) nk_ffn2(P p) {
    __shared__ bf16 a1[8][DFF];
    const int tid = threadIdx.x, col = blockIdx.x * 256 + tid, row0 = blockIdx.y * 8, b = row0 / SEQ;
    load_a<DFF>(a1, (const bf16*)(p.ws + WS_HFF), row0, tid);
    __syncthreads();
    float s1[8];
#pragma unroll
    for (int r = 0; r < 8; ++r) s1[r] = 0.f;
    for (int k = 0; k < DFF; ++k) { const float w = p.w_fd[(size_t)k * DM + col];
#pragma unroll
        for (int r = 0; r < 8; ++r) s1[r] += bf2f(a1[r][k]) * w; }
    const float g2 = ((const float*)(p.ws + WS_MODV))[b * 6144 + 5120 + col];
#pragma unroll
    for (int r = 0; r < 8; ++r) { const size_t row = row0 + r; p.out[row * DM + col] += g2 * s1[r]; }
}

#ifndef DBGMASK
#define DBGMASK 0xff
#endif
#ifndef NAIVE_INPROJ
#define NAIVE_INPROJ 3
#endif

extern "C" void kernel_launch(void* const* d_in, const int* in_sizes, int n_in, void* d_out, int out_size, void* d_ws, size_t ws_size, hipStream_t stream) {
    if (n_in != 20 || ws_size < WS_END || out_size != M_LAT * DM) { fprintf(stderr, "kernel_launch: unexpected shapes (n_in %d, ws %zu, out %d)\n", n_in, ws_size, out_size); return; }
    P p{};
    const float** f = (const float**)&p;
    for (int i = 0; i < 20; ++i) f[i] = (const float*)d_in[i];
    p.out = (float*)d_out; p.ws = (unsigned char*)d_ws;
    static int grid = 0;
    if (!grid) {
        (void)hipFuncSetAttribute((const void*)nk_mC, hipFuncAttributeMaxDynamicSharedMemorySize, 140 * 1024);
        (void)hipFuncSetAttribute((const void*)mk_fwd, hipFuncAttributeMaxDynamicSharedMemorySize, LDS_BYTES);
        int dev = 0, cus = 0, per_cu = 0;
        (void)hipGetDevice(&dev); (void)hipDeviceGetAttribute(&cus, hipDeviceAttributeMultiprocessorCount, dev);
        (void)hipOccupancyMaxActiveBlocksPerMultiprocessor(&per_cu, (const void*)mk_fwd, NTHR, LDS_BYTES);
        if (per_cu < 1) { fprintf(stderr, "kernel_launch: occupancy query says %d blocks/CU\n", per_cu); per_cu = 1; }
        grid = cus;
    }
    int nli = 0;
    auto mk = [&](int lo, int hi, int dbg = 0xff) { int a = lo, b = hi, c = nli++, d = dbg; void* args[] = {&p, &a, &b, &c, &d};
        hipError_t e = hipLaunchCooperativeKernel((const void*)mk_fwd, dim3(grid), dim3(NTHR), args, LDS_BYTES, stream);
        if (e != hipSuccess) fprintf(stderr, "cooperative launch failed: %s (grid %d)\n", hipGetErrorString(e), grid); };
    (void)hipMemsetAsync(d_ws, 0, CTL_ZERO_BYTES, stream);
    nk_mod<<<dim3(24, 5), 256, 0, stream>>>(p);
    nk_tables<<<128, 256, 0, stream>>>(p);
    nk_norm1<<<M_ALL / 4, 256, 0, stream>>>(p);
    mk(PH_CONV, PH_MERGE);
    nk_na<<<dim3(M_LAT, NHB), 64, 0, stream>>>(p);
    nk_mA<<<dim3(NCH, NHA, NB), 256, 0, stream>>>(p);
    nk_mB<<<dim3(33, 64), 256, 0, stream>>>(p);
    nk_mC<<<dim3(64, NHA, NB), 256, (128 * 129 + 1280 + 128 * 128) * 4, stream>>>(p);
    mk(PH_MERGE, PH_COUNT);
}
```

```cpp
#include <hip/hip_runtime.h>
#include <hip/hip_cooperative_groups.h>
#include <cstdio>
#include <cstdint>
namespace cg = cooperative_groups;

typedef unsigned short bf16;
#define DI __device__ __forceinline__
#define LAS __attribute__((address_space(3)))
DI float bf2f(bf16 b) { return __uint_as_float(((unsigned)b) << 16); }
DI bf16 f2bf(float f) { unsigned u = __float_as_uint(f); return (bf16)((u + 0x7fffu + ((u >> 16) & 1u)) >> 16); }
DI float sigmoidf_(float x) { return 1.f / (1.f + __expf(-x)); }
DI float logsigmoidf_(float x) { return fminf(x, 0.f) - log1pf(__expf(-fabsf(x))); }

constexpr int NB = 4, SEQ = 8192, DM = 1024, CTX = 256, GW = 64, GROWS = 128;
constexpr int M_LAT = NB * SEQ, M_CTX = NB * CTX, M_ALL = M_LAT + M_CTX;
constexpr int NHA = 8, DKA = 64, DVA = 128, NHB = 16, DHB = 64;
constexpr int DIN = 8224, DFF = 2816, NCH = 66;
constexpr float EPS = 1e-6f, GCAP = 15.f;
constexpr int C_QA = 0, C_KA = 512, C_VA = 1024, C_OA = 2048, C_G = 3072, C_QB = 3104, C_KB = 4128, C_VB = 5152, C_MG = 6176;

constexpr size_t MiB = 1u << 20;
constexpr size_t WS_MODV = 1 * MiB;
constexpr size_t WS_ROPE = WS_MODV + 128 * 1024;
constexpr size_t WS_SUMSQ = WS_ROPE + 32 * 1024;
constexpr size_t WS_CH = WS_SUMSQ + 128 * 1024;
constexpr size_t WS_MIN = WS_CH + 64 * 1024;
constexpr size_t WS_BGU = WS_MIN + 32 * 1024;
constexpr size_t WS_NU = WS_BGU + 128 * 1024;
constexpr size_t WS_GATES = 3 * MiB;
constexpr size_t WS_W = 8 * MiB;
constexpr size_t WS_WIN = WS_W, WS_WA = 25 * MiB, WS_WB = 27 * MiB, WS_WO = 29 * MiB, WS_WGU = 31 * MiB, WS_WD = 42 * MiB;
constexpr size_t WS_HX = 48 * MiB, WS_QA = 114 * MiB, WS_KA = 147 * MiB, WS_VA = 180 * MiB, WS_OA = 246 * MiB, WS_QB = 310 * MiB, WS_KB = 374 * MiB, WS_VB = 440 * MiB, WS_END = 506 * MiB;
constexpr size_t WS_T1 = WS_QA, WS_XS = WS_HX, WS_HFF = WS_QB, WS_TMP = WS_KB;
constexpr size_t WS_UC = WS_HX;
static_assert(WS_NU + 4 * 8 * 2 * 66 * 64 * 4 <= WS_GATES && WS_GATES + (size_t)M_ALL * 32 * 4 <= WS_W, "misc map");
static_assert(WS_WIN + (size_t)33 * 256 * 1024 * 2 <= WS_WA && WS_WGU + (size_t)5632 * 1024 * 2 <= WS_WD && WS_WD + (size_t)1024 * 2816 * 2 <= WS_HX, "weight map");

struct P {
    const float *x, *c, *ctx, *c_ctx, *w_mod, *b_mod, *norm1_g, *w_in, *b_gates, *mlstm_g, *qn_g, *kn_g, *rpb, *w_a, *w_b, *w_o, *norm2_g, *w_fg, *w_fu, *w_fd;
    float* out; unsigned char* ws;
};
namespace pg8 {
#define PG8_LAS __attribute__((address_space(3)))
typedef unsigned short bf16_t;
typedef short bf16x8 __attribute__((ext_vector_type(8)));
typedef float f32x4 __attribute__((ext_vector_type(4)));
typedef unsigned u32x4 __attribute__((ext_vector_type(4)));
constexpr int BM = 256, BK = 64, HALF = 128, HTB = HALF * BK * 2  , STAGE_BYTES = 8 * HTB, NXCD = 8, WGM = 8;

__host__ __device__ __forceinline__ int lds_byte(int r, int c) { const int st = (r >> 4) * 2 + (c >> 5), rr = r & 15, cc = c & 31, ob = rr * 64 + cc * 2; return st * 1024 + (ob ^ (((ob >> 9) & 1) << 5)); }
__host__ __device__ __forceinline__ void stage_rc(int b, int& R, int& C) { const int st = b / 1024, sb = b % 1024, swz = sb ^ (((sb >> 9) & 1) << 5); R = (st >> 1) * 16 + swz / 64; C = (st & 1) * 32 + (swz % 64) / 2; }
__host__ __device__ __forceinline__ int perm32(int rho) { const int n = rho >> 4, i = rho & 15; return 8 * (i >> 2) + 4 * n + (i & 3); }

struct Unit { int pm, pn; };
struct Gemm { const bf16_t* A; const bf16_t* Bt; int M, N, K; };

struct StaticOrder {
    int nM, nN, nwg, G, c;
    __host__ __device__ void init(int M, int N, int G_, int c_) { nM = M / BM; nN = N / BM; nwg = nM * nN; G = G_; c = c_; }
    __host__ __device__ bool next(int i, Unit& u) const {
        const long L = (long)i * G + c; if (L >= nwg) return false;
        int wgid = (int)L; { const int q = nwg / NXCD, r = nwg % NXCD, xcd = wgid % NXCD, off = wgid / NXCD; wgid = (xcd < r ? xcd * (q + 1) : r * (q + 1) + (xcd - r) * q) + off; }
        const int nig = WGM * nN, gid = wgid / nig, fm = gid * WGM, gsz = (nM - fm) < WGM ? (nM - fm) : WGM;
        u.pm = fm + ((wgid % nig) % gsz); u.pn = (wgid % nig) / gsz; return true;
    }
    __device__ __forceinline__ void a_ready(const Unit&) const {}
    __device__ __forceinline__ void done(const Unit&) const {}
};
__device__ __forceinline__ unsigned cvt_pk_bf16(float lo, float hi) { unsigned r; asm volatile("v_cvt_pk_bf16_f32 %0, %1, %2" : "=v"(r) : "v"(lo), "v"(hi)); return r; }
typedef float f32x2 __attribute__((ext_vector_type(2)));
template <class Epi, class Sched, bool ALIGN_EPI = false, bool SP2 = false>
__device__ __forceinline__ void gemm_phase(PG8_LAS unsigned char* lds, const Gemm g, const Sched& S, const Epi& E) {
    const int tid = threadIdx.x, wid = __builtin_amdgcn_readfirstlane(tid >> 6), lane = tid & 63, wr = wid >> 2, wc = wid & 3, fr = lane & 15, fq = lane >> 4;
    const int K = g.K, nt = K / BK;
    unsigned voffA[2], voffB[2];
#pragma unroll
    for (int i = 0; i < 2; ++i) { int R, C; stage_rc(tid * 16 + i * 8192, R, C); const int Rb = Epi::PERM ? ((R & ~31) + perm32(R & 31)) : R;
        voffA[i] = (unsigned)(R * K + C) * 2u; voffB[i] = (unsigned)(Rb * K + C) * 2u; }
    const size_t kstep = (size_t)(BK * 2);
    const size_t hstep = (size_t)HALF * K * 2;
    const size_t tstep = 2 * hstep;
    const unsigned ldsw = (unsigned)wid * 1024u;
    const int aoff = lds_byte(wr * 64 + fr, fq * 8), boff = lds_byte(wc * 32 + fr, fq * 8);
#define PG8_SA(b, h) (((b) * 2 + (h)) * HTB)
#define PG8_SB(b, h) ((4 + (b) * 2 + (h)) * HTB)
#define PG8_STAGE(bufoff, gbase, voff) do { _Pragma("unroll") for (int _i = 0; _i < 2; ++_i) \
        __builtin_amdgcn_global_load_lds((const unsigned*)((const char*)(gbase) + (voff)[_i]), (PG8_LAS unsigned*)(lds + (bufoff) + ldsw + _i * 8192), 16, 0, 0); } while (0)
#define PG8_LDA(dst, b, h) do { _Pragma("unroll") for (int m = 0; m < 4; ++m) _Pragma("unroll") for (int k = 0; k < 2; ++k) dst[m][k] = *(const PG8_LAS bf16x8*)(lds + PG8_SA(b, h) + aoff + m * 2048 + k * 1024); } while (0)
#define PG8_LDB(dst, b, h) do { _Pragma("unroll") for (int n = 0; n < 2; ++n) _Pragma("unroll") for (int k = 0; k < 2; ++k) dst[n][k] = *(const PG8_LAS bf16x8*)(lds + PG8_SB(b, h) + boff + n * 2048 + k * 1024); } while (0)
#define PG8_MMA(ai, bj, At, Bt) do { __builtin_amdgcn_s_setprio(1); _Pragma("unroll") for (int m = 0; m < 4; ++m) _Pragma("unroll") for (int n = 0; n < 2; ++n) _Pragma("unroll") for (int k = 0; k < 2; ++k) \
        acc[ai][bj][m][n] = __builtin_amdgcn_mfma_f32_16x16x32_bf16(Bt[n][k], At[m][k], acc[ai][bj][m][n], 0, 0, 0); __builtin_amdgcn_s_setprio(0); } while (0)
#define PG8_WAIT_V(n) asm volatile("s_waitcnt vmcnt(" #n ")" ::: "memory")
#define PG8_WAIT_L(n) asm volatile("s_waitcnt lgkmcnt(" #n ")" ::: "memory")
#define PG8_BAR __builtin_amdgcn_s_barrier()
#define PG8_SCHED __builtin_amdgcn_sched_barrier(0)
    Unit cur, nxt; int ui = 0;
    if (!S.next(0, cur)) return;
    f32x4 acc[2][2][4][2];
#pragma unroll
    for (int a = 0; a < 2; ++a)
#pragma unroll
        for (int b = 0; b < 2; ++b)
#pragma unroll
            for (int m = 0; m < 4; ++m)
#pragma unroll
                for (int n = 0; n < 2; ++n) acc[a][b][m][n] = (f32x4){0.f, 0.f, 0.f, 0.f};
    bf16x8 At[4][2], B0[2][2], B1[2][2];
    const char* cA = (const char*)g.A + (size_t)cur.pm * tstep; const char* cB = (const char*)g.Bt + (size_t)cur.pn * tstep;
    S.a_ready(cur);
    if constexpr (SP2) {
        PG8_STAGE(PG8_SB(0, 0), cB, voffB); PG8_STAGE(PG8_SB(0, 1), cB + hstep, voffB); PG8_STAGE(PG8_SA(0, 0), cA, voffA); PG8_STAGE(PG8_SA(0, 1), cA + hstep, voffA);
        if (wr == 1) PG8_BAR;
        PG8_WAIT_V(2); PG8_BAR;
        PG8_STAGE(PG8_SB(1, 0), cB + kstep, voffB); PG8_STAGE(PG8_SA(1, 0), cA + kstep, voffA); PG8_STAGE(PG8_SB(1, 1), cB + hstep + kstep, voffB);
        PG8_WAIT_V(6); PG8_BAR;
    } else {
        PG8_STAGE(PG8_SB(0, 0), cB, voffB); PG8_STAGE(PG8_SA(0, 0), cA, voffA); PG8_STAGE(PG8_SB(0, 1), cB + hstep, voffB); PG8_STAGE(PG8_SA(0, 1), cA + hstep, voffA);
        if (wr == 1) PG8_BAR;
        PG8_WAIT_V(4); PG8_BAR;
        PG8_STAGE(PG8_SB(1, 0), cB + kstep, voffB); PG8_STAGE(PG8_SA(1, 0), cA + kstep, voffA); PG8_STAGE(PG8_SB(1, 1), cB + hstep + kstep, voffB);
        PG8_WAIT_V(6); PG8_BAR;
    }
    for (;;) {
        const bool has_next = S.next(ui + 1, nxt);
        const char* nA = has_next ? (const char*)g.A + (size_t)nxt.pm * tstep : cA; const char* nB = has_next ? (const char*)g.Bt + (size_t)nxt.pn * tstep : cB;
        for (int t = 0; t < nt; t += 2) {
            const bool last = (t == nt - 2);
            const char* a1 = cA + (size_t)(t + 1) * kstep;
            const char* a2 = last ? nA : cA + (size_t)(t + 2) * kstep; const char* b2 = last ? nB : cB + (size_t)(t + 2) * kstep;
            const char* a3 = a2 + kstep; const char* b3 = b2 + kstep;
            if (last && has_next) S.a_ready(nxt);
            if constexpr (SP2) {
            PG8_LDB(B0, 0, 0); PG8_LDB(B1, 0, 1); PG8_SCHED; PG8_LDA(At, 0, 0); PG8_STAGE(PG8_SA(1, 1), a1 + hstep, voffA);
            PG8_WAIT_V(8); PG8_WAIT_L(0); PG8_BAR; PG8_MMA(0, 0, At, B0); PG8_MMA(0, 1, At, B1); PG8_BAR; PG8_SCHED;
            PG8_LDA(At, 0, 1); PG8_STAGE(PG8_SB(0, 0), b2, voffB); PG8_STAGE(PG8_SB(0, 1), b2 + hstep, voffB); PG8_STAGE(PG8_SA(0, 0), a2, voffA);
            PG8_WAIT_V(8); PG8_WAIT_L(0); PG8_BAR; PG8_MMA(1, 0, At, B0); PG8_MMA(1, 1, At, B1); PG8_BAR; PG8_SCHED;
            PG8_LDB(B0, 1, 0); PG8_LDB(B1, 1, 1); PG8_SCHED; PG8_LDA(At, 1, 0); PG8_STAGE(PG8_SA(0, 1), a2 + hstep, voffA);
            PG8_WAIT_V(8); PG8_WAIT_L(0); PG8_BAR; PG8_MMA(0, 0, At, B0); PG8_MMA(0, 1, At, B1); PG8_BAR; PG8_SCHED;
            PG8_LDA(At, 1, 1); PG8_STAGE(PG8_SB(1, 0), b3, voffB); PG8_STAGE(PG8_SB(1, 1), b3 + hstep, voffB); PG8_STAGE(PG8_SA(1, 0), a3, voffA);
            PG8_WAIT_V(8); PG8_WAIT_L(0); PG8_BAR; PG8_MMA(1, 0, At, B0); PG8_MMA(1, 1, At, B1); PG8_BAR; PG8_SCHED;
            } else {
            PG8_LDB(B0, 0, 0); PG8_SCHED; PG8_LDA(At, 0, 0); PG8_STAGE(PG8_SA(1, 1), a1 + hstep, voffA);
            PG8_WAIT_L(8); PG8_BAR; PG8_WAIT_L(0); PG8_MMA(0, 0, At, B0); PG8_BAR; PG8_SCHED;
            PG8_LDB(B1, 0, 1); PG8_STAGE(PG8_SB(0, 0), b2, voffB);
            PG8_BAR; PG8_WAIT_L(0); PG8_MMA(0, 1, At, B1); PG8_BAR;
            PG8_LDA(At, 0, 1); PG8_STAGE(PG8_SA(0, 0), a2, voffA);
            PG8_BAR; PG8_WAIT_L(0); PG8_MMA(1, 0, At, B0); PG8_BAR; PG8_SCHED;
            PG8_STAGE(PG8_SB(0, 1), b2 + hstep, voffB);
            PG8_WAIT_V(6); PG8_BAR; PG8_MMA(1, 1, At, B1); PG8_BAR;
            PG8_LDB(B0, 1, 0); PG8_SCHED; PG8_LDA(At, 1, 0); PG8_STAGE(PG8_SA(0, 1), a2 + hstep, voffA);
            PG8_WAIT_L(8); PG8_BAR; PG8_WAIT_L(0); PG8_MMA(0, 0, At, B0); PG8_BAR; PG8_SCHED;
            PG8_LDB(B1, 1, 1); PG8_STAGE(PG8_SB(1, 0), b3, voffB);
            PG8_BAR; PG8_WAIT_L(0); PG8_MMA(0, 1, At, B1); PG8_BAR;
            PG8_LDA(At, 1, 1); PG8_STAGE(PG8_SA(1, 0), a3, voffA);
            PG8_BAR; PG8_WAIT_L(0); PG8_MMA(1, 0, At, B0); PG8_BAR; PG8_SCHED;
            PG8_STAGE(PG8_SB(1, 1), b3 + hstep, voffB);
            PG8_WAIT_V(6); PG8_BAR; PG8_MMA(1, 1, At, B1); PG8_BAR;
            }
        }
        if constexpr (ALIGN_EPI) { if (wr == 0) PG8_BAR; }
        if constexpr (!Epi::AFTER_DRAIN) { E(acc, cur, wr, wc, fr, fq); S.done(cur); }
        if (!has_next) break;
#pragma unroll
        for (int a = 0; a < 2; ++a)
#pragma unroll
            for (int b = 0; b < 2; ++b)
#pragma unroll
                for (int m = 0; m < 4; ++m)
#pragma unroll
                    for (int n = 0; n < 2; ++n) acc[a][b][m][n] = (f32x4){0.f, 0.f, 0.f, 0.f};
        cur = nxt; cA = nA; cB = nB; ++ui;
        if constexpr (ALIGN_EPI) { if (wr == 1) PG8_BAR; }
    }
    PG8_WAIT_V(0);
    if constexpr (!ALIGN_EPI) { if (wr == 0) PG8_BAR; }
    PG8_BAR;
    if constexpr (Epi::AFTER_DRAIN) { E.fused(acc, cur, wr, wc, fr, fq, lds, wid, lane); S.done(cur); }
#undef PG8_SA
#undef PG8_SB
#undef PG8_STAGE
#undef PG8_LDA
#undef PG8_LDB
#undef PG8_MMA
#undef PG8_WAIT_V
#undef PG8_WAIT_L
#undef PG8_BAR
#undef PG8_SCHED
}
}
#define XB_TMO      128
#define XB_XCNT(j)  (256  + 64 * (j))
#define XB_XSUB(j)  (1280 + 64 * (j))
#define XB_XGEN(j)  (2304 + 64 * (j))
#define XB_TOP      3328
#define XB_TOPGEN   3392
#define XCD_BAR_WORDS 3456
#define XB_SPIN_CAP (1u << 18)

__device__ __forceinline__ unsigned xb_ld(unsigned* p)              { return __hip_atomic_load(p, __ATOMIC_RELAXED, __HIP_MEMORY_SCOPE_AGENT); }
__device__ __forceinline__ unsigned xb_add(unsigned* p, unsigned v) { return __hip_atomic_fetch_add(p, v, __ATOMIC_RELAXED, __HIP_MEMORY_SCOPE_AGENT); }
__device__ __forceinline__ unsigned xb_xcc_id() { return (unsigned)__builtin_amdgcn_s_getreg((3 << 11) | 20) & 0xFu; }
#define XB_SPIN(cond, bar) do { unsigned _sp = 0; while (cond) { __builtin_amdgcn_s_sleep(1); \
    if ((++_sp & 255u) == 0u) { if (xb_ld(&(bar)[XB_TMO])) break; if (_sp > XB_SPIN_CAP) { atomicAdd(&(bar)[XB_TMO], 1u); break; } } } } while (0)

struct XcdBarrier {
    unsigned* bar; unsigned x;
    volatile LAS unsigned* st;
};

__device__ __forceinline__ XcdBarrier xcd_barrier_post(unsigned* bar, volatile LAS unsigned* st) {
    XcdBarrier b; b.bar = bar; b.x = xb_xcc_id(); b.st = st;
    if (threadIdx.x == 0) (void)xb_add(&bar[XB_XCNT(b.x)], 1u);
    return b;
}
__device__ __forceinline__ void xcd_barrier_complete(unsigned* bar, unsigned x, unsigned& nloc, unsigned& nx) {
    const unsigned G = gridDim.x * gridDim.y * gridDim.z;
    unsigned sum, cnt, mine, sp = 0u;
    for (;;) {
        sum = 0u; cnt = 0u; mine = 0u;
#pragma unroll
        for (unsigned j = 0; j < 16; ++j) { const unsigned c = xb_ld(&bar[XB_XCNT(j)]); sum += c; cnt += (c > 0u) ? 1u : 0u; mine = (j == x) ? c : mine; }
        if (sum == G) break;
        __builtin_amdgcn_s_sleep(1);
        if ((++sp & 255u) == 0u) { if (xb_ld(&bar[XB_TMO])) break; if (sp > XB_SPIN_CAP) { atomicAdd(&bar[XB_TMO], 1u); break; } }
    }
    nloc = mine > 0u ? mine : 1u; nx = cnt > 0u ? cnt : 1u;
}

__device__ __forceinline__ void xcd_barrier(const XcdBarrier& b) {
    asm volatile("s_waitcnt vmcnt(0)" ::: "memory");
    __syncthreads();
    if (threadIdx.x == 0) {
        unsigned* bar = b.bar;
        __builtin_amdgcn_s_waitcnt(0);
        unsigned nloc = b.st[0], nx = b.st[1];
        if (nloc == 0u) { xcd_barrier_complete(bar, b.x, nloc, nx); b.st[0] = nloc; b.st[1] = nx; }
        const unsigned old = xb_add(&bar[XB_XSUB(b.x)], 1u);
        const unsigned gen = old / nloc;
        if (old + 1u == (gen + 1u) * nloc) {
            __builtin_amdgcn_fence(__ATOMIC_RELEASE, "agent");
            asm volatile("s_waitcnt vmcnt(0)" ::: "memory");
            const unsigned og = xb_add(&bar[XB_TOP], 1u);
            const unsigned tg = og / nx;
            if (og + 1u == (tg + 1u) * nx) xb_add(&bar[XB_TOPGEN], 1u);
            else XB_SPIN(xb_ld(&bar[XB_TOPGEN]) == tg, bar);
            __builtin_amdgcn_fence(__ATOMIC_ACQUIRE, "agent");
            xb_add(&bar[XB_XGEN(b.x)], 1u);
            asm volatile("s_waitcnt vmcnt(0)" ::: "memory");
        } else {
            XB_SPIN(xb_ld(&bar[XB_XGEN(b.x)]) == gen, bar);
            __builtin_amdgcn_fence(__ATOMIC_ACQUIRE, "agent");
            asm volatile("s_waitcnt vmcnt(0)" ::: "memory");
        }
    }
    __syncthreads();
}
using pg8::f32x4; using pg8::Unit;
typedef unsigned u32x4 __attribute__((ext_vector_type(4)));
typedef unsigned u32x2 __attribute__((ext_vector_type(2)));
constexpr int NWAVES = 8, NTHR = 512;
constexpr int LDS_BYTES = 147456;
constexpr int LDSCTL_OFF = LDS_BYTES - 256;
constexpr size_t WS_CTL = 0, CTL_ZERO_BYTES = 64 * 1024;
#define LDS_WAIT() asm volatile("s_waitcnt lgkmcnt(0)" ::: "memory")
typedef float f32x2_t __attribute__((ext_vector_type(2))); typedef __bf16 bf16x2_t __attribute__((ext_vector_type(2)));
DI unsigned cvtpk(float lo, float hi) { f32x2_t v = {lo, hi}; bf16x2_t b = __builtin_convertvector(v, bf16x2_t); return __builtin_bit_cast(unsigned, b); }
DI float fsig(float x) { return __builtin_amdgcn_rcpf(1.f + __expf(-x)); }
DI u32x4 pack8(const f32x4& a, const f32x4& b) { u32x4 w; w.x = cvtpk(a[0], a[1]); w.y = cvtpk(a[2], a[3]); w.z = cvtpk(b[0], b[1]); w.w = cvtpk(b[2], b[3]); return w; }
DI u32x2 pack4(const f32x4& a) { u32x2 w; w.x = cvtpk(a[0], a[1]); w.y = cvtpk(a[2], a[3]); return w; }
DI void unpack8(const u32x4& w, f32x4& a, f32x4& b) {
    a[0] = __uint_as_float(w.x << 16); a[1] = __uint_as_float(w.x & 0xffff0000u); a[2] = __uint_as_float(w.y << 16); a[3] = __uint_as_float(w.y & 0xffff0000u);
    b[0] = __uint_as_float(w.z << 16); b[1] = __uint_as_float(w.z & 0xffff0000u); b[2] = __uint_as_float(w.w << 16); b[3] = __uint_as_float(w.w & 0xffff0000u); }


struct EpiInproj {
    static constexpr bool PERM = false, AFTER_DRAIN = false;
    unsigned char* ws; const float *b_gates, *qn_g, *kn_g; bf16* MG;
    DI void operator()(const f32x4 (&acc)[2][2][4][2], const Unit& u, int wr, int wc, int fr, int fq) const {
        const int pn = u.pn; const bool lat = u.pm < M_LAT / 256;
        const int row0 = u.pm * 256 + wr * 64 + fr;
        if (pn < 4) {
            const bool isq = pn < 2; bf16* T = (bf16*)(ws + (isq ? WS_QA : WS_KA)); const int tcol = 256 * (pn & 1) + 64 * wc + 4 * fq;
            const float* rope = (const float*)(ws + WS_ROPE); const float sc = isq ? 0.125f : 1.f;
#pragma unroll
            for (int ai = 0; ai < 2; ++ai)
#pragma unroll
                for (int m = 0; m < 4; ++m) { const int row = row0 + ai * 128 + m * 16; bf16* rp = T + (size_t)row * 512 + tcol;
                    const int t = row & (SEQ - 1);
#pragma unroll
                    for (int bj = 0; bj < 2; ++bj) { f32x4 cs = {1.f, 1.f, 1.f, 1.f}, sn = {0.f, 0.f, 0.f, 0.f};
                        if (lat) { const int pos = bj ? (t & 63) : (t >> 6); cs = *(const f32x4*)(rope + pos * 32 + 4 * fq); sn = *(const f32x4*)(rope + pos * 32 + 16 + 4 * fq); }
                        const f32x4 x1 = acc[ai][bj][m][0], x2 = acc[ai][bj][m][1];
                        const f32x4 o1 = (x1 * cs - x2 * sn) * sc, o2 = (x2 * cs + x1 * sn) * sc;
                        *(u32x2*)(rp + 32 * bj) = pack4(o1); *(u32x2*)(rp + 32 * bj + 16) = pack4(o2); } }
        } else if (pn < 8 || (pn >= 20 && pn < 24)) {
            bf16* T = (bf16*)(ws + (pn < 8 ? WS_VA : WS_VB)); const int tcol = 256 * (pn & 3) + 64 * wc + 8 * fq;
#pragma unroll
            for (int ai = 0; ai < 2; ++ai)
#pragma unroll
                for (int m = 0; m < 4; ++m) { bf16* rp = T + (size_t)(row0 + ai * 128 + m * 16) * 1024 + tcol;
#pragma unroll
                    for (int bj = 0; bj < 2; ++bj) *(u32x4*)(rp + 32 * bj) = pack8(acc[ai][bj][m][0], acc[ai][bj][m][1]); }
        } else if (pn < 12) {
            if (!lat) return;
            bf16* T = (bf16*)(ws + WS_OA); const int tcol = 256 * (pn & 3) + 64 * wc + 8 * fq;
#pragma unroll
            for (int ai = 0; ai < 2; ++ai)
#pragma unroll
                for (int m = 0; m < 4; ++m) { bf16* rp = T + (size_t)(row0 + ai * 128 + m * 16) * 1024 + tcol;
#pragma unroll
                    for (int bj = 0; bj < 2; ++bj) { f32x4 a = acc[ai][bj][m][0], b = acc[ai][bj][m][1];
#pragma unroll
                        for (int j = 0; j < 4; ++j) { a[j] = fsig(a[j]); b[j] = fsig(b[j]); }
                        *(u32x4*)(rp + 32 * bj) = pack8(a, b); } }
        } else if (pn < 20) {
            const bool isq = pn < 16; if (isq && !lat) return;
            bf16* T = (bf16*)(ws + (isq ? WS_QB : WS_KB)); const int tcol = 256 * (pn & 3) + 64 * wc + 8 * fq;
            const float* g = isq ? qn_g : kn_g; const float sc = isq ? 0.125f : 1.f;
            f32x4 gv[2][2];
#pragma unroll
            for (int bj = 0; bj < 2; ++bj)
#pragma unroll
                for (int n = 0; n < 2; ++n) gv[bj][n] = *(const f32x4*)(g + 32 * bj + 8 * fq + 4 * n) * sc;
#pragma unroll
            for (int ai = 0; ai < 2; ++ai)
#pragma unroll
                for (int m = 0; m < 4; ++m) { bf16* rp = T + (size_t)(row0 + ai * 128 + m * 16) * 1024 + tcol;
                    float ss = 0.f;
#pragma unroll
                    for (int bj = 0; bj < 2; ++bj)
#pragma unroll
                        for (int n = 0; n < 2; ++n) { const f32x4 v = acc[ai][bj][m][n]; ss += (v[0] * v[0] + v[1] * v[1]) + (v[2] * v[2] + v[3] * v[3]); }
                    ss += __shfl_xor(ss, 16); ss += __shfl_xor(ss, 32);
                    const float rs = rsqrtf(ss * (1.f / 64.f) + EPS);
#pragma unroll
                    for (int bj = 0; bj < 2; ++bj) *(u32x4*)(rp + 32 * bj) = pack8(acc[ai][bj][m][0] * rs * gv[bj][0], acc[ai][bj][m][1] * rs * gv[bj][1]); }
        } else if (pn >= 25) {
            if (!lat) return;
            const int tcol = 256 * (pn - 25) + 64 * wc + 8 * fq;
#pragma unroll
            for (int ai = 0; ai < 2; ++ai)
#pragma unroll
                for (int m = 0; m < 4; ++m) { bf16* rp = MG + (size_t)(row0 + ai * 128 + m * 16) * 2048 + tcol;
#pragma unroll
                    for (int bj = 0; bj < 2; ++bj) { f32x4 a = acc[ai][bj][m][0], b = acc[ai][bj][m][1];
#pragma unroll
                        for (int j = 0; j < 4; ++j) { a[j] = fsig(a[j]); b[j] = fsig(b[j]); }
                        *(u32x4*)(rp + 32 * bj) = pack8(a, b); } }
        } else {
            if (wc != 0) return;
            float* G = (float*)(ws + WS_GATES);
#pragma unroll
            for (int n = 0; n < 2; ++n) { int g0 = 16 * n + 4 * fq; asm volatile("" : "+v"(g0));
                const f32x4 bias = *(const f32x4*)(b_gates + g0); const bool lf = (g0 >> 3) & 1;
#pragma unroll
                for (int ai = 0; ai < 2; ++ai)
#pragma unroll
                    for (int m = 0; m < 4; ++m) { f32x4 v = acc[ai][0][m][n] + bias;
#pragma unroll
                        for (int j = 0; j < 4; ++j) { const float cp = GCAP * tanhf(v[j] * (1.f / GCAP)); v[j] = lf ? logsigmoidf_(cp) : cp; }
                        *(f32x4*)(G + (size_t)(row0 + ai * 128 + m * 16) * 32 + g0) = v; } }
        }
    }
};
struct EpiMG {
    static constexpr bool PERM = false, AFTER_DRAIN = false;
    bf16* MG; int mask;
    DI void operator()(const f32x4 (&acc)[2][2][4][2], const Unit& u, int wr, int wc, int fr, int fq) const {
        if (!((mask >> u.pn) & 1)) return;
        const int row0 = u.pm * 256 + wr * 64 + fr, tcol = 256 * u.pn + 64 * wc + 8 * fq;
#pragma unroll
        for (int ai = 0; ai < 2; ++ai)
#pragma unroll
            for (int m = 0; m < 4; ++m) { bf16* rp = MG + (size_t)(row0 + ai * 128 + m * 16) * 2048 + tcol;
#pragma unroll
                for (int bj = 0; bj < 2; ++bj) { f32x4 a = acc[ai][bj][m][0], b = acc[ai][bj][m][1];
#pragma unroll
                    for (int j = 0; j < 4; ++j) { a[j] = fsig(a[j]); b[j] = fsig(b[j]); }
                    *(u32x4*)(rp + 32 * bj) = pack8(a, b); } }
    }
};
template <bool SECOND> struct EpiMerge {
    static constexpr bool PERM = false, AFTER_DRAIN = false;
    const bf16* MG; float* TMP; bf16* T1;
    DI void operator()(const f32x4 (&acc)[2][2][4][2], const Unit& u, int wr, int wc, int fr, int fq) const {
        const int row0 = u.pm * 256 + wr * 64 + fr, tcol = 256 * u.pn + 64 * wc + 8 * fq;
#pragma unroll
        for (int ai = 0; ai < 2; ++ai)
#pragma unroll
            for (int m = 0; m < 4; ++m) { const size_t row = row0 + ai * 128 + m * 16;
#pragma unroll
                for (int bj = 0; bj < 2; ++bj) { const int col = tcol + 32 * bj;
                    f32x4 ga, gb; unpack8(*(const u32x4*)(MG + row * 2048 + (SECOND ? 1024 : 0) + col), ga, gb);
                    float* tp = TMP + row * 1024 + col;
                    if (!SECOND) { *(f32x4*)tp = ga * acc[ai][bj][m][0]; *(f32x4*)(tp + 4) = gb * acc[ai][bj][m][1]; }
                    else { const f32x4 t0 = *(const f32x4*)tp, t1 = *(const f32x4*)(tp + 4);
                        *(u32x4*)(T1 + row * 1024 + col) = pack8(t0 + ga * acc[ai][bj][m][0], t1 + gb * acc[ai][bj][m][1]); } } }
    }
};
struct EpiOut {
    static constexpr bool PERM = false, AFTER_DRAIN = false;
    const float* x; float* out; bf16* XS; float* sumsq; const float* modv; const float* norm2_g;
    DI void operator()(const f32x4 (&acc)[2][2][4][2], const Unit& u, int wr, int wc, int fr, int fq) const {
        const int row0 = u.pm * 256 + wr * 64 + fr, tcol = 256 * u.pn + 64 * wc + 8 * fq, b = u.pm >> 5;
        const float* mv = modv + b * 6144;
        f32x4 g1[2][2], s2[2][2];
#pragma unroll
        for (int bj = 0; bj < 2; ++bj)
#pragma unroll
            for (int n = 0; n < 2; ++n) { const int col = tcol + 32 * bj + 4 * n; g1[bj][n] = *(const f32x4*)(mv + 2048 + col); s2[bj][n] = *(const f32x4*)(norm2_g + col) * (*(const f32x4*)(mv + 4096 + col) + 1.f); }
#pragma unroll
        for (int ai = 0; ai < 2; ++ai)
#pragma unroll
            for (int m = 0; m < 4; ++m) { const size_t row = row0 + ai * 128 + m * 16; float ss = 0.f;
#pragma unroll
                for (int bj = 0; bj < 2; ++bj) { const size_t o = row * 1024 + tcol + 32 * bj;
                    const f32x4 x0 = *(const f32x4*)(x + o) + g1[bj][0] * acc[ai][bj][m][0], x1 = *(const f32x4*)(x + o + 4) + g1[bj][1] * acc[ai][bj][m][1];
                    *(f32x4*)(out + o) = x0; *(f32x4*)(out + o + 4) = x1;
                    *(u32x4*)(XS + o) = pack8(x0 * s2[bj][0], x1 * s2[bj][1]);
                    ss += (x0[0] * x0[0] + x0[1] * x0[1]) + (x0[2] * x0[2] + x0[3] * x0[3]) + (x1[0] * x1[0] + x1[1] * x1[1]) + (x1[2] * x1[2] + x1[3] * x1[3]); }
                ss += __shfl_xor(ss, 16); ss += __shfl_xor(ss, 32);
                if (fq == 0) atomicAdd(sumsq + row, ss); }
    }
};
struct EpiFfn1 {
    static constexpr bool PERM = false, AFTER_DRAIN = false;
    bf16* HFF; const float* sumsq; const float* bgu;
    DI void operator()(const f32x4 (&acc)[2][2][4][2], const Unit& u, int wr, int wc, int fr, int fq) const {
        const int row0 = u.pm * 256 + wr * 64 + fr, hcol = 128 * u.pn + 32 * wc + 8 * fq, b = u.pm >> 5;
        const float* bg = bgu + (size_t)b * 2 * DFF + hcol; const float* bu = bg + DFF;
        const f32x4 bg0 = *(const f32x4*)bg, bg1 = *(const f32x4*)(bg + 4), bu0 = *(const f32x4*)bu, bu1 = *(const f32x4*)(bu + 4);
#pragma unroll
        for (int ai = 0; ai < 2; ++ai)
#pragma unroll
            for (int m = 0; m < 4; ++m) { const size_t row = row0 + ai * 128 + m * 16;
                const float rs = rsqrtf(sumsq[row] * (1.f / DM) + EPS);
                f32x4 g0 = acc[ai][0][m][0] * rs + bg0, g1 = acc[ai][0][m][1] * rs + bg1; const f32x4 u0 = acc[ai][1][m][0] * rs + bu0, u1 = acc[ai][1][m][1] * rs + bu1;
#pragma unroll
                for (int j = 0; j < 4; ++j) { g0[j] = g0[j] * fsig(g0[j]) * u0[j]; g1[j] = g1[j] * fsig(g1[j]) * u1[j]; }
                *(u32x4*)(HFF + row * DFF + hcol) = pack8(g0, g1); }
    }
};
struct EpiFfn2 {
    static constexpr bool PERM = false, AFTER_DRAIN = false;
    float* out; const float* modv;
    DI void operator()(const f32x4 (&acc)[2][2][4][2], const Unit& u, int wr, int wc, int fr, int fq) const {
        const int row0 = u.pm * 256 + wr * 64 + fr, tcol = 256 * u.pn + 64 * wc + 8 * fq, b = u.pm >> 5;
        const float* mv = modv + b * 6144 + 5120;
        f32x4 g2[2][2];
#pragma unroll
        for (int bj = 0; bj < 2; ++bj)
#pragma unroll
            for (int n = 0; n < 2; ++n) g2[bj][n] = *(const f32x4*)(mv + tcol + 32 * bj + 4 * n);
#pragma unroll
        for (int ai = 0; ai < 2; ++ai)
#pragma unroll
            for (int m = 0; m < 4; ++m) { const size_t row = row0 + ai * 128 + m * 16;
#pragma unroll
                for (int bj = 0; bj < 2; ++bj) { float* o = out + row * 1024 + tcol + 32 * bj;
                    *(f32x4*)o = *(const f32x4*)o + g2[bj][0] * acc[ai][bj][m][0]; *(f32x4*)(o + 4) = *(const f32x4*)(o + 4) + g2[bj][1] * acc[ai][bj][m][1]; } }
    }
};

DI void conv_item(const float* W, int ldw, int L0, bool zero, bool perm8, bf16* dst, int K, int k0, LAS float* scr, int lane) {
#pragma unroll 8
    for (int i = 0; i < 32; ++i) { const int kk = 2 * i + (lane >> 5); scr[kk * 33 + (lane & 31)] = zero ? 0.f : W[(size_t)(k0 + kk) * ldw + L0 + (lane & 31)]; }
    LDS_WAIT(); asm volatile("" ::: "memory");
    const int c = lane & 7;
#pragma unroll
    for (int jj = 0; jj < 4; ++jj) { const int i = (lane >> 3) + 8 * jj; const int src = perm8 ? (8 * ((i >> 2) & 3) + 4 * (i >> 4) + (i & 3)) : i;
        const LAS float* s = scr + (8 * c) * 33 + src;
        u32x4 o; o.x = cvtpk(s[0], s[33]); o.y = cvtpk(s[2 * 33], s[3 * 33]); o.z = cvtpk(s[4 * 33], s[5 * 33]); o.w = cvtpk(s[6 * 33], s[7 * 33]);
        *(u32x4*)(dst + (size_t)i * K + k0 + 8 * c) = o; }
    LDS_WAIT(); asm volatile("" ::: "memory");
}
DI int inproj_src_col(int pn) {
    return pn < 2 ? C_QA + 256 * pn : pn < 4 ? C_KA + 256 * (pn - 2) : pn < 8 ? C_VA + 256 * (pn - 4) : pn < 12 ? C_OA + 256 * (pn - 8) : pn < 16 ? C_QB + 256 * (pn - 12)
         : pn < 20 ? C_KB + 256 * (pn - 16) : pn < 24 ? C_VB + 256 * (pn - 20) : pn == 24 ? C_G : C_MG + 256 * (pn - 25);
}
constexpr int CI_WIN = 33 * 8 * 16, CI_SQ = 4 * 8 * 16, CI_GU = 22 * 8 * 16, CI_WD = 4 * 8 * 44, CI_TOTAL = CI_WIN + 3 * CI_SQ + CI_GU + CI_WD;
DI void phase_convert(const P& p, LAS unsigned char* lds, int gw, int ngw, int wave, int lane) {
    LAS float* scr = (LAS float*)(lds + wave * 16384);
    for (int it = gw; it < CI_TOTAL; it += ngw) {
        int r = it;
        if (r < CI_WIN) { const int kb = r & 15, g8 = (r >> 4) & 7, pn = r >> 7, bj = g8 >> 2, wc = g8 & 3;
            const bool zero = pn == 24 && g8 != 0; const int L0 = pn == 24 ? C_G : inproj_src_col(pn) + 64 * wc + 32 * bj;
            conv_item(p.w_in, DIN, L0, zero, pn >= 4 && pn != 24, (bf16*)(p.ws + WS_WIN) + (size_t)(pn * 256 + 128 * bj + 32 * wc) * 1024, 1024, kb * 64, scr, lane); continue; }
        r -= CI_WIN;
        if (r < 3 * CI_SQ) { const int which = r / CI_SQ; r -= which * CI_SQ; const int kb = r & 15, g8 = (r >> 4) & 7, pn = r >> 7, bj = g8 >> 2, wc = g8 & 3;
            const float* W = which == 0 ? p.w_a : which == 1 ? p.w_b : p.w_o; bf16* D = (bf16*)(p.ws + (which == 0 ? WS_WA : which == 1 ? WS_WB : WS_WO));
            conv_item(W, 1024, 256 * pn + 64 * wc + 32 * bj, false, true, D + (size_t)(pn * 256 + 128 * bj + 32 * wc) * 1024, 1024, kb * 64, scr, lane); continue; }
        r -= 3 * CI_SQ;
        if (r < CI_GU) { const int kb = r & 15, g8 = (r >> 4) & 7, pn = r >> 7, bj = g8 >> 2, wc = g8 & 3;
            conv_item(bj ? p.w_fu : p.w_fg, DFF, 128 * pn + 32 * wc, false, true, (bf16*)(p.ws + WS_WGU) + (size_t)(pn * 256 + 128 * bj + 32 * wc) * 1024, 1024, kb * 64, scr, lane); continue; }
        r -= CI_GU;
        { const int kb = r % 44, g = r / 44, g8 = g & 7, pn = g >> 3, bj = g8 >> 2, wc = g8 & 3;
            conv_item(p.w_fd, 1024, 256 * pn + 64 * wc + 32 * bj, false, true, (bf16*)(p.ws + WS_WD) + (size_t)(pn * 256 + 128 * bj + 32 * wc) * DFF, DFF, kb * 64, scr, lane); }
    }
}
template <int R> DI void gemv_task(const float* W, int ldw, int col0, const LAS float* A, LAS float* red, float* out, int ldo, const float* bias, int tid) {
    const int col = tid & 31, kg = tid >> 5;
    float acc[R];
#pragma unroll
    for (int r = 0; r < R; ++r) acc[r] = 0.f;
#pragma unroll 4
    for (int i = 0; i < 64; ++i) { const int k = kg + 16 * i; const float w = W[(size_t)k * ldw + col0 + col];
#pragma unroll
        for (int r = 0; r < R; ++r) acc[r] += A[r * 1024 + k] * w; }
#pragma unroll
    for (int r = 0; r < R; ++r) red[(kg * R + r) * 32 + col] = acc[r];
    __syncthreads();
    if (tid < R * 32) { const int r = tid >> 5, c = tid & 31; float s = bias ? bias[col0 + c] : 0.f;
#pragma unroll
        for (int g = 0; g < 16; ++g) s += red[(g * R + r) * 32 + c];
        out[(size_t)r * ldo + col0 + c] = s; }
    __syncthreads();
}
DI void phase_bgu(const P& p, LAS unsigned char* lds, int blk, int nblk, int tid) {
    LAS float* A = (LAS float*)lds; LAS float* red = A + 4 * 1024;
    const float* modv = (const float*)(p.ws + WS_MODV);
    for (int i = tid; i < 4 * 1024; i += NTHR) A[i] = modv[(i >> 10) * 6144 + 3072 + (i & 1023)];
    __syncthreads();
    for (int t = blk; t < 176; t += nblk) { const int which = t / 88, col0 = (t % 88) * 32;
        gemv_task<4>(which ? p.w_fu : p.w_fg, DFF, col0, A, red, (float*)(p.ws + WS_BGU) + which * DFF, 2 * DFF, nullptr, tid); }
    __syncthreads();
}

typedef short bf16x8 __attribute__((ext_vector_type(8)));
typedef short s16x4 __attribute__((ext_vector_type(4)));
typedef short v4i16_t __attribute__((ext_vector_type(4)));
DI f32x4 mfma16(bf16x8 a, bf16x8 b, f32x4 c) { return __builtin_amdgcn_mfma_f32_16x16x32_bf16(a, b, c, 0, 0, 0); }
DI s16x4 tr4(const LAS unsigned char* p) { return __builtin_bit_cast(s16x4, __builtin_amdgcn_ds_read_tr16_b64_v4i16((LAS v4i16_t*)p)); }
DI bf16x8 cat8(s16x4 a, s16x4 b) { return __builtin_shufflevector(a, b, 0, 1, 2, 3, 4, 5, 6, 7); }
DI bf16x8 ldsb128(const LAS unsigned char* p) { return *(const LAS bf16x8*)p; }
DI bf16x8 packf8(const f32x4& a, const f32x4& b) { return __builtin_bit_cast(bf16x8, pack8(a, b)); }
DI bf16x8 tr_frag(const LAS unsigned char* img, int RS, int s, int c0, int lane) {
    const int g = lane >> 4, i = lane & 15;
    const LAS unsigned char* p = img + (32 * s + 4 * g + (i >> 2)) * RS + (c0 + 4 * (i & 3)) * 2;
    return cat8(tr4(p), tr4(p + 16 * RS));
}
DI float wave_incl_add(float v, int lane) {
#pragma unroll
    for (int o = 1; o < 64; o <<= 1) { const float t = __shfl_up(v, o); if (lane >= o) v += t; }
    return v; }
DI float wave_incl_max(float v, int lane) {
#pragma unroll
    for (int o = 1; o < 64; o <<= 1) { const float t = __shfl_up(v, o); if (lane >= o) v = fmaxf(v, t); }
    return v; }
DI float wave_incl_max_rev(float v, int lane) {
#pragma unroll
    for (int o = 1; o < 64; o <<= 1) { const float t = __shfl_down(v, o); if (lane + o < 64) v = fmaxf(v, t); }
    return v; }
DI float wave_max(float v) {
#pragma unroll
    for (int o = 1; o < 64; o <<= 1) v = fmaxf(v, __shfl_xor(v, o));
    return v; }
DI int chunk_row0(int b, int c) { return c < 2 ? M_LAT + b * CTX + 128 * c : b * SEQ + 128 * (c - 2); }

constexpr int NA_RS = 144, NA_KOFF = 0, NA_VOFF = 480 * NA_RS, NA_RPB = 2 * 480 * NA_RS;
DI void na_keys(const LAS unsigned char* lds, int kbase, int q, int g, const bf16x8& bq0, const bf16x8& bq1, f32x4& s0, f32x4& s1) {
    const LAS unsigned char* kp = lds + NA_KOFF + (kbase + q) * NA_RS + 16 * g;
    s0 = mfma16(ldsb128(kp), bq0, (f32x4){0.f, 0.f, 0.f, 0.f}); s0 = mfma16(ldsb128(kp + 64), bq1, s0);
    s1 = mfma16(ldsb128(kp + 16 * NA_RS), bq0, (f32x4){0.f, 0.f, 0.f, 0.f}); s1 = mfma16(ldsb128(kp + 16 * NA_RS + 64), bq1, s1);
}
DI void na_pv(const LAS unsigned char* lds, int kbase, int lane, const bf16x8& pf, f32x4 (&o)[4]) {
    const int g = lane >> 4, i = lane & 15;
    const LAS unsigned char* vp = lds + NA_VOFF + (kbase + 4 * g + (i >> 2)) * NA_RS + 8 * (i & 3);
#pragma unroll
    for (int dt = 0; dt < 4; ++dt) o[dt] = mfma16(cat8(tr4(vp + 32 * dt), tr4(vp + 32 * dt + 16 * NA_RS)), pf, o[dt]);
}
DI void na_unit(const P& p, LAS unsigned char* lds, int u, int tid, int wave, int lane) {
    const int cb = u & 3, rb = (u >> 2) & 15, h = (u >> 6) & 15, b = u >> 10;
    const int kr0 = min(max(8 * rb - 4, 0), GROWS - 15), kc0 = cb == 0 ? 0 : (cb == 1 ? 8 : (cb == 2 ? 24 : 32));
    bf16* QB = (bf16*)(p.ws + WS_QB); const bf16* KB = (const bf16*)(p.ws + WS_KB); const bf16* VB = (const bf16*)(p.ws + WS_VB);
    for (int c = tid; c < 480 * 8; c += NTHR) { const int kk = c >> 3, ch = c & 7; const int tok = (kr0 + (kk >> 5)) * GW + kc0 + (kk & 31);
        const size_t go = (size_t)(b * SEQ + tok) * 1024 + h * 64 + ch * 8;
        *(LAS u32x4*)(lds + NA_KOFF + kk * NA_RS + ch * 16) = *(const u32x4*)(KB + go); *(LAS u32x4*)(lds + NA_VOFF + kk * NA_RS + ch * 16) = *(const u32x4*)(VB + go); }
    LAS float* rpbl = (LAS float*)(lds + NA_RPB);
    for (int i = tid; i < 465; i += NTHR) rpbl[i] = p.rpb[h * 465 + i];
    const int r = 8 * rb + wave, q = lane & 15, g = lane >> 4, qc = 16 * cb + q;
    const size_t qoff = (size_t)(b * SEQ + r * GW + qc) * 1024 + h * 64;
    const bf16x8 bq0 = *(const bf16x8*)(QB + qoff + 8 * g), bq1 = *(const bf16x8*)(QB + qoff + 32 + 8 * g);
    __syncthreads();
    f32x4 o[4];
#pragma unroll
    for (int dt = 0; dt < 4; ++dt) o[dt] = (f32x4){0.f, 0.f, 0.f, 0.f};
    float lsum = 0.f;
    const int wr0 = min(max(r - 4, 0), GROWS - 8), rel0 = wr0 - kr0, wc0 = min(max(qc - 8, 0), GW - 16);
    for (int i = 0; i < 8; ++i) {
        const int rel = rel0 + i, kbase = rel * 32;
        f32x4 s0, s1; na_keys(lds, kbase, q, g, bq0, bq1, s0, s1);
        const int dr = (kr0 + rel) - r + 7;
        f32x4 p0, p1;
#pragma unroll
        for (int e = 0; e < 4; ++e) { const int kc_a = kc0 + 4 * g + e, kc_b = kc_a + 16;
            const bool va = kc_a >= wc0 && kc_a < wc0 + 16, vb = kc_b >= wc0 && kc_b < wc0 + 16;
            const int da = min(max(kc_a - qc + 15, 0), 30), db = min(max(kc_b - qc + 15, 0), 30);
            p0[e] = va ? __expf(s0[e] + rpbl[dr * 31 + da]) : 0.f; p1[e] = vb ? __expf(s1[e] + rpbl[dr * 31 + db]) : 0.f; }
        lsum += (p0[0] + p0[1]) + (p0[2] + p0[3]) + (p1[0] + p1[1]) + (p1[2] + p1[3]);
        na_pv(lds, kbase, lane, packf8(p0, p1), o);
    }
    __syncthreads();
    for (int c = tid; c < 256 * 8; c += NTHR) { const int kk = c >> 3, ch = c & 7; const size_t go = (size_t)(M_LAT + b * CTX + kk) * 1024 + h * 64 + ch * 8;
        *(LAS u32x4*)(lds + NA_KOFF + kk * NA_RS + ch * 16) = *(const u32x4*)(KB + go); *(LAS u32x4*)(lds + NA_VOFF + kk * NA_RS + ch * 16) = *(const u32x4*)(VB + go); }
    __syncthreads();
    for (int i = 0; i < 8; ++i) {
        f32x4 s0, s1; na_keys(lds, 32 * i, q, g, bq0, bq1, s0, s1);
        f32x4 p0, p1;
#pragma unroll
        for (int e = 0; e < 4; ++e) { p0[e] = __expf(s0[e]); p1[e] = __expf(s1[e]); }
        lsum += (p0[0] + p0[1]) + (p0[2] + p0[3]) + (p1[0] + p1[1]) + (p1[2] + p1[3]);
        na_pv(lds, 32 * i, lane, packf8(p0, p1), o);
    }
    lsum += __shfl_xor(lsum, 16); lsum += __shfl_xor(lsum, 32);
    const float inv = 1.f / lsum;
#pragma unroll
    for (int dt = 0; dt < 4; ++dt) *(u32x2*)(QB + qoff + 16 * dt + 4 * g) = pack4(o[dt] * inv);
    __syncthreads();
}

constexpr int MA_RS = 288, MA_V = 0, MA_KW = 128 * MA_RS, MA_G = 2 * 128 * MA_RS, MA_WF = MA_G + 2048, MA_WB = MA_WF + 512;
DI void mA_unit(const P& p, LAS unsigned char* lds, int u, int tid, int wave, int lane) {
    const int c = u % NCH, h = (u / NCH) & 7, b = u / (NCH * NHA);
    const int row0 = chunk_row0(b, c);
    const float* G = (const float*)(p.ws + WS_GATES); const bf16* KA = (const bf16*)(p.ws + WS_KA); const bf16* VA = (const bf16*)(p.ws + WS_VA);
    LAS float* gl = (LAS float*)(lds + MA_G); LAS float* wf = (LAS float*)(lds + MA_WF); LAS float* wb = (LAS float*)(lds + MA_WB);
    { const int tok = tid & 127, gt = tid >> 7; gl[gt * 128 + tok] = G[(size_t)(row0 + tok) * 32 + gt * 8 + h]; }
    for (int ci = tid; ci < 128 * 16; ci += NTHR) { const int tok = ci >> 4, ch = ci & 15;
        *(LAS u32x4*)(lds + MA_V + tok * MA_RS + ch * 16) = *(const u32x4*)(VA + (size_t)(row0 + tok) * 1024 + h * 128 + ch * 8); }
    __syncthreads();
    if (wave < 2) {
        const int dir = wave; const LAS float* ig = gl + (2 * dir) * 128; const LAS float* lf = gl + (2 * dir + 1) * 128;
        const float lf0 = lf[2 * lane], lf1 = lf[2 * lane + 1], ig0 = ig[2 * lane], ig1 = ig[2 * lane + 1];
        const float p1 = lf0 + lf1, incl = wave_incl_add(p1, lane), excl = incl - p1, total = __shfl(incl, 63);
        float ge0, ge1;
        if (dir == 0) { ge0 = total - (excl + lf0) + ig0; ge1 = total - incl + ig1; }
        else { ge0 = excl + ig0; ge1 = excl + lf0 + ig1; }
        const float mx = wave_max(fmaxf(ge0, ge1));
        LAS float* w = dir ? wb : wf; w[2 * lane] = __expf(ge0 - mx); w[2 * lane + 1] = __expf(ge1 - mx);
        if (lane == 0) { float* ch = (float*)(p.ws + WS_CH) + ((((size_t)b * NHA + h) * 2 + dir) * NCH + c) * 2; ch[0] = total; ch[1] = mx; }
    }
    __syncthreads();
    for (int ci = tid; ci < 128 * 8; ci += NTHR) { const int tok = ci >> 3, ch = ci & 7;
        const u32x4 kv = *(const u32x4*)(KA + (size_t)(row0 + tok) * 512 + h * 64 + ch * 8);
        f32x4 a, bb; unpack8(kv, a, bb); const float f = wf[tok], r = wb[tok];
        *(LAS u32x4*)(lds + MA_KW + tok * MA_RS + ch * 16) = pack8(a * f, bb * f); *(LAS u32x4*)(lds + MA_KW + tok * MA_RS + 128 + ch * 16) = pack8(a * r, bb * r); }
    __syncthreads();
    {
        bf16x8 a[4];
#pragma unroll
        for (int s = 0; s < 4; ++s) a[s] = tr_frag(lds + MA_KW, MA_RS, s, 16 * wave, lane);
        const int dir = wave >> 2, g = lane >> 4;
        bf16* UC = (bf16*)(p.ws + WS_UC) + ((((size_t)dir * NB + b) * NHA + h) * NCH + c) * 8192 + 16 * (wave & 3) + 4 * g;
#pragma unroll
        for (int nt = 0; nt < 8; ++nt) { f32x4 acc = {0.f, 0.f, 0.f, 0.f};
#pragma unroll
            for (int s = 0; s < 4; ++s) acc = mfma16(a[s], tr_frag(lds + MA_V, MA_RS, s, 16 * nt, lane), acc);
            *(u32x2*)(UC + (16 * nt + (lane & 15)) * 64) = pack4(acc); }
    }
    if (tid < 128) { float s = 0.f; const LAS unsigned char* kw = lds + MA_KW + tid * 2;
        for (int i = 0; i < 128; ++i) s += bf2f(*(const LAS bf16*)(kw + i * MA_RS));
        ((float*)(p.ws + WS_NU))[((((size_t)b * NHA + h) * 2 + (tid >> 6)) * NCH + c) * 64 + (tid & 63)] = s; }
    __syncthreads();
}

DI int scan_chunk(int dir, int i) { return dir == 0 ? i : (i < 2 ? 1 - i : NCH + 1 - i); }
DI void mB_unit(const P& p, int blk, int tid) {
    const int bhd = blk >> 2, dir = bhd & 1, bh = bhd >> 1, b = bh >> 3, h = bh & 7;
    const float* CH = (const float*)(p.ws + WS_CH) + (size_t)bhd * NCH * 2;
    bf16* UC = (bf16*)(p.ws + WS_UC) + (((size_t)dir * NB + b) * NHA + h) * NCH * 8192 + (blk & 3) * 2048 + tid * 4;
    float* NU = (float*)(p.ws + WS_NU) + (size_t)bhd * NCH * 64 + tid * 4; float* MIN = (float*)(p.ws + WS_MIN) + (size_t)bhd * NCH;
    const bool do_n = (blk & 3) == 0 && tid < 16, do_m = (blk & 3) == 0 && tid == 0;
    float m = 0.f; f32x4 s = {0.f, 0.f, 0.f, 0.f}, ns = {0.f, 0.f, 0.f, 0.f};
    for (int bt = 0; bt < 6; ++bt) {
        u32x2 uv[11]; f32x4 nv[11];
#pragma unroll
        for (int k = 0; k < 11; ++k) { const int c = scan_chunk(dir, bt * 11 + k); uv[k] = *(const u32x2*)(UC + (size_t)c * 8192); nv[k] = do_n ? *(const f32x4*)(NU + c * 64) : (f32x4){0.f, 0.f, 0.f, 0.f}; }
#pragma unroll
        for (int k = 0; k < 11; ++k) { const int c = scan_chunk(dir, bt * 11 + k);
            const float bl = CH[c * 2], ml = CH[c * 2 + 1], mn = fmaxf(bl + m, ml), dec = __expf(bl + m - mn), scl = __expf(ml - mn);
            f32x4 uf; uf[0] = __uint_as_float(uv[k].x << 16); uf[1] = __uint_as_float(uv[k].x & 0xffff0000u); uf[2] = __uint_as_float(uv[k].y << 16); uf[3] = __uint_as_float(uv[k].y & 0xffff0000u);
            *(u32x2*)(UC + (size_t)c * 8192) = pack4(s); s = s * dec + uf * scl;
            if (do_n) { *(f32x4*)(NU + c * 64) = ns; ns = ns * dec + nv[k] * scl; }
            if (do_m) MIN[c] = m;
            m = mn; }
    }
}

constexpr int MC_KS = 144, MC_VS = 288, MC_K = 0, MC_V = 128 * MC_KS, MC_CF = MC_V + 128 * MC_VS, MC_CB = MC_CF + 128 * MC_KS, MC_G = MC_CB + 128 * MC_KS,
              MC_EF = MC_G + 2048, MC_MF = MC_EF + 512, MC_AF = MC_MF + 512, MC_FF = MC_AF + 512, MC_EB = MC_FF + 512, MC_MB = MC_EB + 512, MC_AB = MC_MB + 512, MC_FB = MC_AB + 512, MC_NF = MC_FB + 512, MC_NB = MC_NF + 256, MC_END = MC_NB + 256;
static_assert(MC_END <= 131072, "step C LDS");
DI bf16x8 scale8(const bf16x8& v, float f) { f32x4 a, b; unpack8(__builtin_bit_cast(u32x4, v), a, b); return packf8(a * f, b * f); }
DI void mC_unit(const P& p, LAS unsigned char* lds, int u, int tid, int wave, int lane) {
    const int j = u & 63, h = (u >> 6) & 7, b = u >> 9, c = j + 2;
    const int row0 = b * SEQ + 128 * j;
    const float* G = (const float*)(p.ws + WS_GATES); const bf16* QA = (const bf16*)(p.ws + WS_QA); const bf16* KA = (const bf16*)(p.ws + WS_KA); bf16* VA = (bf16*)(p.ws + WS_VA);
    const size_t bhd_f = ((size_t)b * NHA + h) * 2, bhd_b = bhd_f + 1;
    LAS float* gl = (LAS float*)(lds + MC_G);
    { const int tok = tid & 127, gt = tid >> 7; gl[gt * 128 + tok] = G[(size_t)(row0 + tok) * 32 + gt * 8 + h]; }
    for (int ci = tid; ci < 128 * 8; ci += NTHR) { const int tok = ci >> 3, ch = ci & 7;
        *(LAS u32x4*)(lds + MC_K + tok * MC_KS + ch * 16) = *(const u32x4*)(KA + (size_t)(row0 + tok) * 512 + h * 64 + ch * 8);
        const bf16* cf = (const bf16*)(p.ws + WS_UC) + ((((size_t)0 * NB + b) * NHA + h) * NCH + c) * 8192; const bf16* cb = (const bf16*)(p.ws + WS_UC) + ((((size_t)1 * NB + b) * NHA + h) * NCH + c) * 8192;
        *(LAS u32x4*)(lds + MC_CF + tok * MC_KS + ch * 16) = *(const u32x4*)(cf + tok * 64 + ch * 8); *(LAS u32x4*)(lds + MC_CB + tok * MC_KS + ch * 16) = *(const u32x4*)(cb + tok * 64 + ch * 8); }
    for (int ci = tid; ci < 128 * 16; ci += NTHR) { const int tok = ci >> 4, ch = ci & 15;
        *(LAS u32x4*)(lds + MC_V + tok * MC_VS + ch * 16) = *(const u32x4*)(VA + (size_t)(row0 + tok) * 1024 + h * 128 + ch * 8); }
    if (tid < 128) ((LAS float*)(lds + MC_NF))[tid] = ((const float*)(p.ws + WS_NU))[((tid < 64 ? bhd_f : bhd_b) * NCH + c) * 64 + (tid & 63)];
    __syncthreads();
    if (wave < 2) {
        const int dir = wave; const LAS float* ig = gl + (2 * dir) * 128; const LAS float* lf = gl + (2 * dir + 1) * 128;
        const float m_in = ((const float*)(p.ws + WS_MIN))[(dir ? bhd_b : bhd_f) * NCH + c];
        const float lf0 = lf[2 * lane], lf1 = lf[2 * lane + 1], ig0 = ig[2 * lane], ig1 = ig[2 * lane + 1];
        const float p1 = lf0 + lf1, incl = wave_incl_add(p1, lane), excl = incl - p1, total = __shfl(incl, 63);
        float b0, b1, M0, M1;
        if (dir == 0) { b0 = excl + lf0; b1 = incl;
            const float e0 = ig0 - b0, e1 = ig1 - b1; const float pm = wave_incl_max(fmaxf(e0, e1), lane); float pv = __shfl_up(pm, 1); if (lane == 0) pv = -3.0e38f;
            M0 = fmaxf(m_in, fmaxf(pv, e0)); M1 = fmaxf(m_in, pm);
            LAS float* E = (LAS float*)(lds + MC_EF); E[2 * lane] = e0; E[2 * lane + 1] = e1;
        } else { b0 = total - excl; b1 = total - (excl + lf0);
            const float e0 = ig0 - b0, e1 = ig1 - b1; const float sm = wave_incl_max_rev(fmaxf(e0, e1), lane); float nx = __shfl_down(sm, 1); if (lane == 63) nx = -3.0e38f;
            M0 = fmaxf(m_in, sm); M1 = fmaxf(m_in, fmaxf(nx, e1));
            LAS float* E = (LAS float*)(lds + MC_EB); E[2 * lane] = e0; E[2 * lane + 1] = e1; }
        LAS float* Mv = (LAS float*)(lds + (dir ? MC_MB : MC_MF)); LAS float* Av = (LAS float*)(lds + (dir ? MC_AB : MC_AF)); LAS float* Fv = (LAS float*)(lds + (dir ? MC_FB : MC_FF));
        Mv[2 * lane] = M0; Mv[2 * lane + 1] = M1; Av[2 * lane] = __expf(m_in - M0); Av[2 * lane + 1] = __expf(m_in - M1); Fv[2 * lane] = __expf(-(b0 + M0)); Fv[2 * lane + 1] = __expf(-(b1 + M1));
    }
    __syncthreads();
    const int q = lane & 15, g = lane >> 4, t = 16 * wave + q;
    const bf16* qp = QA + (size_t)(row0 + t) * 512 + h * 64 + 8 * g;
    const bf16x8 bq0 = *(const bf16x8*)qp, bq1 = *(const bf16x8*)(qp + 32);
    f32x4 st[8];
#pragma unroll
    for (int kt = 0; kt < 8; ++kt) { const LAS unsigned char* kp = lds + MC_K + (16 * kt + q) * MC_KS + 16 * g;
        st[kt] = mfma16(ldsb128(kp), bq0, (f32x4){0.f, 0.f, 0.f, 0.f}); st[kt] = mfma16(ldsb128(kp + 64), bq1, st[kt]); }
    const float Mft = ((const LAS float*)(lds + MC_MF))[t], Mbt = ((const LAS float*)(lds + MC_MB))[t];
    const float aft = ((const LAS float*)(lds + MC_AF))[t], abt = ((const LAS float*)(lds + MC_AB))[t], fft = ((const LAS float*)(lds + MC_FF))[t], fbt = ((const LAS float*)(lds + MC_FB))[t];
    float den_f = 0.f, den_b = 0.f; f32x4 pdf = {0.f, 0.f, 0.f, 0.f}, pdb = {0.f, 0.f, 0.f, 0.f};
#pragma unroll
    for (int kt = 0; kt < 8; ++kt) {
        if (kt < wave) { const f32x4 ef = *(const LAS f32x4*)(lds + MC_EF + (16 * kt + 4 * g) * 4);
#pragma unroll
            for (int e = 0; e < 4; ++e) { st[kt][e] *= __expf(ef[e] - Mft); den_f += st[kt][e]; }
        } else if (kt > wave) { const f32x4 eb = *(const LAS f32x4*)(lds + MC_EB + (16 * kt + 4 * g) * 4);
#pragma unroll
            for (int e = 0; e < 4; ++e) { st[kt][e] *= __expf(eb[e] - Mbt); den_b += st[kt][e]; }
        } else { const f32x4 ef = *(const LAS f32x4*)(lds + MC_EF + (16 * kt + 4 * g) * 4), eb = *(const LAS f32x4*)(lds + MC_EB + (16 * kt + 4 * g) * 4);
#pragma unroll
            for (int e = 0; e < 4; ++e) { const int s = 4 * g + e; pdf[e] = s <= q ? st[kt][e] * __expf(ef[e] - Mft) : 0.f; pdb[e] = s >= q ? st[kt][e] * __expf(eb[e] - Mbt) : 0.f;
                den_f += pdf[e]; den_b += pdb[e]; }
        }
    }
    float qn_f = 0.f, qn_b = 0.f;
    { f32x4 a0, a1, c0, c1; unpack8(__builtin_bit_cast(u32x4, bq0), a0, a1); unpack8(__builtin_bit_cast(u32x4, bq1), c0, c1);
      const LAS float* nf = (const LAS float*)(lds + MC_NF) + 8 * g; const LAS float* nb = (const LAS float*)(lds + MC_NB) + 8 * g;
#pragma unroll
      for (int e = 0; e < 4; ++e) { qn_f += a0[e] * nf[e] + a1[e] * nf[4 + e] + c0[e] * nf[32 + e] + c1[e] * nf[36 + e]; qn_b += a0[e] * nb[e] + a1[e] * nb[4 + e] + c0[e] * nb[32 + e] + c1[e] * nb[36 + e]; } }
    den_f += __shfl_xor(den_f, 16); den_f += __shfl_xor(den_f, 32); den_b += __shfl_xor(den_b, 16); den_b += __shfl_xor(den_b, 32);
    qn_f += __shfl_xor(qn_f, 16); qn_f += __shfl_xor(qn_f, 32); qn_b += __shfl_xor(qn_b, 16); qn_b += __shfl_xor(qn_b, 32);
    const float inv_f = 1.f / fmaxf(fabsf(aft * qn_f + den_f), fft), inv_b = 1.f / fmaxf(fabsf(abt * qn_b + den_b), fbt);
    bf16x8 pf[4];
#pragma unroll
    for (int i = 0; i < 4; ++i) { f32x4 pp[2];
#pragma unroll
        for (int hh = 0; hh < 2; ++hh) { const int kt = 2 * i + hh;
            if (kt < wave) pp[hh] = st[kt] * inv_f; else if (kt > wave) pp[hh] = st[kt] * inv_b; else pp[hh] = pdf * inv_f + pdb * inv_b; }
        pf[i] = packf8(pp[0], pp[1]); }
    const bf16x8 qf0 = scale8(bq0, aft * inv_f), qf1 = scale8(bq1, aft * inv_f), qb0 = scale8(bq0, abt * inv_b), qb1 = scale8(bq1, abt * inv_b);
    f32x4 oacc[8]; float ss = 0.f;
#pragma unroll
    for (int dt = 0; dt < 8; ++dt) { f32x4 o = {0.f, 0.f, 0.f, 0.f};
#pragma unroll
        for (int i = 0; i < 4; ++i) o = mfma16(tr_frag(lds + MC_V, MC_VS, i, 16 * dt, lane), pf[i], o);
        const LAS unsigned char* cfp = lds + MC_CF + (16 * dt + q) * MC_KS + 16 * g; const LAS unsigned char* cbp = lds + MC_CB + (16 * dt + q) * MC_KS + 16 * g;
        o = mfma16(ldsb128(cfp), qf0, o); o = mfma16(ldsb128(cfp + 64), qf1, o); o = mfma16(ldsb128(cbp), qb0, o); o = mfma16(ldsb128(cbp + 64), qb1, o);
        oacc[dt] = o; ss += (o[0] * o[0] + o[1] * o[1]) + (o[2] * o[2] + o[3] * o[3]); }
    ss += __shfl_xor(ss, 16); ss += __shfl_xor(ss, 32);
    const float rn = rsqrtf(ss * (1.f / 128.f) + EPS);
    const bf16* OA = (const bf16*)(p.ws + WS_OA) + (size_t)(row0 + t) * 1024 + h * 128 + 4 * g; bf16* HA = VA + (size_t)(row0 + t) * 1024 + h * 128 + 4 * g;
    const float* gn = p.mlstm_g + h * 128 + 4 * g;
#pragma unroll
    for (int dt = 0; dt < 8; ++dt) { const u32x2 ov = *(const u32x2*)(OA + 16 * dt); f32x4 og;
        og[0] = __uint_as_float(ov.x << 16); og[1] = __uint_as_float(ov.x & 0xffff0000u); og[2] = __uint_as_float(ov.y << 16); og[3] = __uint_as_float(ov.y & 0xffff0000u);
        *(u32x2*)(HA + 16 * dt) = pack4(oacc[dt] * rn * *(const f32x4*)(gn + 16 * dt) * og); asm volatile("" ::: "memory"); }
    __syncthreads();
}

DI void phase_p0(const P& p, LAS unsigned char* lds, int bx, int G, int tid, int gw, int ngw, int wave, int lane) {
    for (int i = bx * NTHR + tid; i < 128 * 16; i += G * NTHR) { const int pos = i >> 4, f = i & 15; const float ang = (float)pos * powf(10000.f, -(float)f / 16.f);
        float* t = (float*)(p.ws + WS_ROPE); t[pos * 32 + f] = (float)cos((double)ang); t[pos * 32 + 16 + f] = (float)sin((double)ang); }
    for (int i = bx * NTHR + tid; i < M_LAT; i += G * NTHR) ((float*)(p.ws + WS_SUMSQ))[i] = 0.f;
    if (bx < 192) { LAS float* A = (LAS float*)lds; LAS float* red = A + 5 * 1024;
        for (int i = tid; i < 5 * 1024; i += NTHR) { const float v = i < 4096 ? p.c[i] : p.c_ctx[i - 4096]; A[i] = v / (1.f + expf(-v)); }
        __syncthreads();
        gemv_task<5>(p.w_mod, 6144, 32 * bx, A, red, (float*)(p.ws + WS_MODV), 6144, p.b_mod, tid); }
    __syncthreads();
    phase_convert(p, lds, gw, ngw, wave, lane);
}
DI void phase_p1(const P& p, LAS unsigned char* lds, int bx, int G, int tid, int gw, int ngw, int lane) {
    phase_bgu(p, lds, bx, G, tid);
    bf16* HX = (bf16*)(p.ws + WS_HX);
    for (int row = gw; row < M_ALL; row += ngw) {
        const float* xr = row < M_LAT ? p.x + (size_t)row * DM : p.ctx + (size_t)(row - M_LAT) * DM;
        const float* mv = (const float*)(p.ws + WS_MODV) + (row < M_LAT ? (row >> 13) : 4) * 6144;
        f32x4 v[4]; float ss = 0.f;
#pragma unroll
        for (int jj = 0; jj < 4; ++jj) { v[jj] = *(const f32x4*)(xr + 4 * lane + 256 * jj); ss += (v[jj][0] * v[jj][0] + v[jj][1] * v[jj][1]) + (v[jj][2] * v[jj][2] + v[jj][3] * v[jj][3]); }
#pragma unroll
        for (int o = 1; o < 64; o <<= 1) ss += __shfl_xor(ss, o);
        const float rstd = rsqrtf(ss * (1.f / DM) + EPS);
#pragma unroll
        for (int jj = 0; jj < 4; ++jj) { const int k = 4 * lane + 256 * jj;
            const f32x4 y = v[jj] * rstd * *(const f32x4*)(p.norm1_g + k) * (*(const f32x4*)(mv + 1024 + k) + 1.f) + *(const f32x4*)(mv + k);
            *(u32x2*)(HX + (size_t)row * DM + k) = pack4(y); }
    }
}
#ifndef SIMPLE_BAR
#define SIMPLE_BAR 0
#endif
enum { PH_P0 = 0, PH_P1, PH_INPROJ, PH_MA, PH_SCAN_NA, PH_MC, PH_MERGE, PH_OUT, PH_FFN1, PH_FFN2, PH_COUNT };
__global__ void __launch_bounds__(NTHR, 2) mk_fwd(P p, int ph_lo, int ph_hi, int li, int dbg) {
    extern __shared__ __attribute__((aligned(16))) unsigned char lds_raw[];
    LAS unsigned char* lds = (LAS unsigned char*)lds_raw;
    const int tid = threadIdx.x, lane = tid & 63, wave = __builtin_amdgcn_readfirstlane(tid >> 6);
    const int G = gridDim.x, bx = blockIdx.x;
    const int vcu = (G % 8 == 0) ? (bx % 8) * (G / 8) + bx / 8 : bx;
    const int gw = vcu * NWAVES + wave, ngw = G * NWAVES;
    if (tid < 64) ((LAS unsigned*)(lds + LDSCTL_OFF))[tid] = 0u;
    __syncthreads();
    const XcdBarrier bar = xcd_barrier_post((unsigned*)(p.ws + WS_CTL) + 4096 * li, (volatile LAS unsigned*)(lds + LDSCTL_OFF));
    unsigned epoch = 0;
#define IN(k) (ph_lo <= (k) && (k) < ph_hi)
#if SIMPLE_BAR
#define SEAM(k) do { if (IN(k) && IN((k) + 1)) { __threadfence(); __syncthreads(); \
        if (tid == 0) { unsigned* cw = (unsigned*)(p.ws + WS_CTL) + 4096 * li + 3500; ++epoch; xb_add(cw, 1u); while (xb_ld(cw) < epoch * (unsigned)G) __builtin_amdgcn_s_sleep(2); } \
        __syncthreads(); __threadfence(); } } while (0)
#else
#define SEAM(k) do { if (IN(k) && IN((k) + 1)) xcd_barrier(bar); } while (0)
#endif
    if (IN(PH_P0)) phase_p0(p, lds, bx, G, tid, gw, ngw, wave, lane);
    SEAM(PH_P0);
    if (IN(PH_P1)) phase_p1(p, lds, bx, G, tid, gw, ngw, lane);
    SEAM(PH_P1);
    if (IN(PH_INPROJ)) {
        pg8::Gemm g{(const bf16*)(p.ws + WS_HX), (const bf16*)(p.ws + WS_WIN), M_ALL, 33 * 256, DM}; pg8::StaticOrder S; S.init(M_ALL, 33 * 256, G, bx);
        EpiInproj E{p.ws, p.b_gates, p.qn_g, p.kn_g, (bf16*)p.out};
        pg8::gemm_phase<EpiInproj, pg8::StaticOrder, true, true>(lds, g, S, E);
    }
    SEAM(PH_INPROJ);
    if (IN(PH_MA)) { for (int u = bx; u < NB * NHA * NCH; u += G) mA_unit(p, lds, u, tid, wave, lane); }
    SEAM(PH_MA);
    if (IN(PH_SCAN_NA)) {
        for (int blk = bx; blk < 256; blk += G) mB_unit(p, blk, tid);
        for (int u0 = vcu * 16; u0 < 4096; u0 += G * 16) for (int i = 0; i < 16; ++i) na_unit(p, lds, u0 + i, tid, wave, lane);
    }
    SEAM(PH_SCAN_NA);
    if (IN(PH_MC)) { for (int u = bx; u < NB * NHA * 64; u += G) mC_unit(p, lds, u, tid, wave, lane); }
    SEAM(PH_MC);
    if (IN(PH_MERGE)) {
        pg8::StaticOrder S; S.init(M_LAT, DM, G, bx);
        { pg8::Gemm g{(const bf16*)(p.ws + WS_VA), (const bf16*)(p.ws + WS_WA), M_LAT, DM, DM};
          EpiMerge<false> E{(const bf16*)p.out, (float*)(p.ws + WS_TMP), (bf16*)(p.ws + WS_T1)};
          pg8::gemm_phase<EpiMerge<false>, pg8::StaticOrder, true, true>(lds, g, S, E); }
        __syncthreads();
        { pg8::Gemm g{(const bf16*)(p.ws + WS_QB), (const bf16*)(p.ws + WS_WB), M_LAT, DM, DM};
          EpiMerge<true> E{(const bf16*)p.out, (float*)(p.ws + WS_TMP), (bf16*)(p.ws + WS_T1)};
          pg8::gemm_phase<EpiMerge<true>, pg8::StaticOrder, true, true>(lds, g, S, E); }
    }
    SEAM(PH_MERGE);
    if (IN(PH_OUT)) {
        pg8::Gemm g{(const bf16*)(p.ws + WS_T1), (const bf16*)(p.ws + WS_WO), M_LAT, DM, DM}; pg8::StaticOrder S; S.init(M_LAT, DM, G, bx);
        EpiOut E{p.x, p.out, (bf16*)(p.ws + WS_XS), (float*)(p.ws + WS_SUMSQ), (const float*)(p.ws + WS_MODV), p.norm2_g};
        pg8::gemm_phase<EpiOut, pg8::StaticOrder, true, true>(lds, g, S, E);
    }
    SEAM(PH_OUT);
    if (IN(PH_FFN1)) {
        pg8::Gemm g{(const bf16*)(p.ws + WS_XS), (const bf16*)(p.ws + WS_WGU), M_LAT, 2 * DFF, DM}; pg8::StaticOrder S; S.init(M_LAT, 2 * DFF, G, bx);
        EpiFfn1 E{(bf16*)(p.ws + WS_HFF), (const float*)(p.ws + WS_SUMSQ), (const float*)(p.ws + WS_BGU)};
        pg8::gemm_phase<EpiFfn1, pg8::StaticOrder, true, true>(lds, g, S, E);
    }
    SEAM(PH_FFN1);
    if (IN(PH_FFN2)) {
        pg8::Gemm g{(const bf16*)(p.ws + WS_HFF), (const bf16*)(p.ws + WS_WD), M_LAT, DM, DFF}; pg8::StaticOrder S; S.init(M_LAT, DM, G, bx);
        EpiFfn2 E{p.out, (const float*)(p.ws + WS_MODV)};
        pg8::gemm_phase<EpiFfn2, pg8::StaticOrder, true, true>(lds, g, S, E);
    }
#undef IN
#undef SEAM
}
__global__ void __launch_bounds__(256) nk_mod(P p) {
    const int col = blockIdx.x * 256 + threadIdx.x, r = blockIdx.y;
    const float* src = r < 4 ? p.c + r * DM : p.c_ctx;
    float acc = p.b_mod[col];
    for (int k = 0; k < DM; ++k) { const float v = src[k]; acc += (v / (1.f + expf(-v))) * p.w_mod[(size_t)k * 6144 + col]; }
    ((float*)(p.ws + WS_MODV))[r * 6144 + col] = acc;
}
__global__ void __launch_bounds__(256) nk_tables(P p) {
    const int i = blockIdx.x * 256 + threadIdx.x;
    if (i < 128 * 16) { const int pos = i / 16, f = i % 16; const float inv = powf(10000.f, -(float)f / 16.f); const float ang = (float)pos * inv;
        float* t = (float*)(p.ws + WS_ROPE); t[pos * 32 + f] = (float)cos((double)ang); t[pos * 32 + 16 + f] = (float)sin((double)ang); }
    if (i < M_LAT) ((float*)(p.ws + WS_SUMSQ))[i] = 0.f;
}
__global__ void __launch_bounds__(256) nk_norm1(P p) {
    const int row = blockIdx.x * 4 + (threadIdx.x >> 6), lane = threadIdx.x & 63;
    const float* xr = row < M_LAT ? p.x + (size_t)row * DM : p.ctx + (size_t)(row - M_LAT) * DM;
    const int mr = row < M_LAT ? row / SEQ : 4;
    const float* modv = (const float*)(p.ws + WS_MODV) + mr * 6144;
    float v[16]; float ss = 0.f;
#pragma unroll
    for (int j = 0; j < 16; ++j) { v[j] = xr[lane + 64 * j]; ss += v[j] * v[j]; }
    for (int o = 1; o < 64; o <<= 1) ss += __shfl_xor(ss, o);
    const float rstd = rsqrtf(ss * (1.f / DM) + EPS);
    bf16* o = (bf16*)(p.ws + WS_HX) + (size_t)row * DM;
#pragma unroll
    for (int j = 0; j < 16; ++j) { const int k = lane + 64 * j; o[k] = f2bf(v[j] * rstd * p.norm1_g[k] * (1.f + modv[1024 + k]) + modv[k]); }
}
__global__ void __launch_bounds__(256) nk_inproj(P p, int cb0) {
    __shared__ bf16 hx[8][DM];
    __shared__ float ot[8][256];
    const int tid = threadIdx.x, cb = blockIdx.x + cb0, row0 = blockIdx.y * 8;
    const int col0 = cb < 12 ? cb * 256 : (cb == 12 ? C_G : C_QB + (cb - 13) * 256);
    const bool valid = cb != 12 || tid < 32;
    const int col = col0 + tid;
    const bf16* HX = (const bf16*)(p.ws + WS_HX);
    for (int i = tid; i < 8 * DM; i += 256) hx[i / DM][i % DM] = HX[(size_t)(row0 + i / DM) * DM + i % DM];
    __syncthreads();
    float acc[8];
#pragma unroll
    for (int r = 0; r < 8; ++r) acc[r] = 0.f;
    if (valid) for (int k = 0; k < DM; ++k) { const float w = p.w_in[(size_t)k * DIN + col];
#pragma unroll
        for (int r = 0; r < 8; ++r) acc[r] += bf2f(hx[r][k]) * w; }
#pragma unroll
    for (int r = 0; r < 8; ++r) ot[r][tid] = acc[r];
    __syncthreads();
    if (!valid) return;
    const float* rope = (const float*)(p.ws + WS_ROPE);
#pragma unroll
    for (int r = 0; r < 8; ++r) {
        const int row = row0 + r; const bool lat = row < M_LAT; const float v = ot[r][tid];
        if (col < C_VA) {
            const bool isq = col < C_KA; const int cc = isq ? col : col - C_KA; const int d = cc & 63;
            float o = v;
            if (lat) { const int t = row % SEQ; const int pos = (d & 32) ? (t % GW) : (t / GW); const int f = d & 15; const bool first = (d & 16) == 0;
                const float cs = rope[pos * 32 + f], sn = rope[pos * 32 + 16 + f];
                const float other = ot[r][first ? tid + 16 : tid - 16];
                o = first ? v * cs - other * sn : v * cs + other * sn; }
            if (isq) o *= 0.125f;
            ((bf16*)(p.ws + (isq ? WS_QA : WS_KA)))[(size_t)row * 512 + cc] = f2bf(o);
        } else if (col < C_OA) { ((bf16*)(p.ws + WS_VA))[(size_t)row * 1024 + col - C_VA] = f2bf(v);
        } else if (col < C_G) { if (lat) ((bf16*)(p.ws + WS_OA))[(size_t)row * 1024 + col - C_OA] = f2bf(sigmoidf_(v));
        } else if (col < C_QB) { const int g = col - C_G; const float raw = v + p.b_gates[g]; const float cp = GCAP * tanhf(raw / GCAP);
            ((float*)(p.ws + WS_GATES))[(size_t)row * 32 + g] = ((g >> 3) & 1) ? logsigmoidf_(cp) : cp;
        } else if (col < C_VB) {
            const bool isq = col < C_KB; const int cc = isq ? col - C_QB : col - C_KB; const int d = cc & 63, hb = tid & ~63;
            float ss = 0.f; for (int i = 0; i < 64; ++i) { const float u = ot[r][hb + i]; ss += u * u; }
            const float y = v * rsqrtf(ss * (1.f / 64.f) + EPS);
            if (isq) { if (lat) ((bf16*)(p.ws + WS_QB))[(size_t)row * 1024 + cc] = f2bf(y * p.qn_g[d] * 0.125f); }
            else ((bf16*)(p.ws + WS_KB))[(size_t)row * 1024 + cc] = f2bf(y * p.kn_g[d]);
        } else if (col < C_MG) { ((bf16*)(p.ws + WS_VB))[(size_t)row * 1024 + col - C_VB] = f2bf(v);
        } else { if (lat) ((bf16*)p.out)[(size_t)row * 2048 + col - C_MG] = f2bf(sigmoidf_(v)); }
    }
}
__global__ void __launch_bounds__(64) nk_na(P p) {
    __shared__ float q[64]; __shared__ float sc[384]; __shared__ int tok[384];
    const int row = blockIdx.x, h = blockIdx.y, j = threadIdx.x;
    const int b = row / SEQ, t = row % SEQ, qr = t / GW, qc = t % GW;
    bf16* QB = (bf16*)(p.ws + WS_QB); const bf16* KB = (const bf16*)(p.ws + WS_KB); const bf16* VB = (const bf16*)(p.ws + WS_VB);
    q[j] = bf2f(QB[(size_t)row * 1024 + h * 64 + j]);
    __syncthreads();
    const int wr0 = min(max(qr - 4, 0), GROWS - 8), wc0 = min(max(qc - 8, 0), GW - 16);
    for (int kk = j; kk < 384; kk += 64) {
        int krow_; float bias = 0.f;
        if (kk < 128) { const int kr = wr0 + kk / 16, kc = wc0 + kk % 16; krow_ = b * SEQ + kr * GW + kc; bias = p.rpb[(h * 15 + (kr - qr + 7)) * 31 + (kc - qc + 15)]; }
        else krow_ = M_LAT + b * CTX + (kk - 128);
        const bf16* kp = KB + (size_t)krow_ * 1024 + h * 64; float s = 0.f;
        for (int d = 0; d < 64; ++d) s += q[d] * bf2f(kp[d]);
        sc[kk] = s + bias; tok[kk] = krow_;
    }
    __syncthreads();
    float mx = -1e30f; for (int kk = 0; kk < 384; ++kk) mx = fmaxf(mx, sc[kk]);
    float sum = 0.f, o = 0.f;
    for (int kk = 0; kk < 384; ++kk) { const float e = __expf(sc[kk] - mx); sum += e; o += e * bf2f(VB[(size_t)tok[kk] * 1024 + h * 64 + j]); }
    QB[(size_t)row * 1024 + h * 64 + j] = f2bf(o / sum);
}
__global__ void __launch_bounds__(256) nk_mA(P p) {
    __shared__ float wf[128], wb[128], st[4];
    const int c = blockIdx.x, h = blockIdx.y, b = blockIdx.z, tid = threadIdx.x;
    const int row0 = chunk_row0(b, c);
    const float* G = (const float*)(p.ws + WS_GATES);
    if (tid == 0) {
        float bl = 0.f; for (int i = 0; i < 128; ++i) bl += G[(size_t)(row0 + i) * 32 + 8 + h];
        float cs = 0.f, mx = -1e30f;
        for (int i = 0; i < 128; ++i) { cs += G[(size_t)(row0 + i) * 32 + 8 + h]; const float ge = bl - cs + G[(size_t)(row0 + i) * 32 + h]; wf[i] = ge; mx = fmaxf(mx, ge); }
        for (int i = 0; i < 128; ++i) wf[i] = __expf(wf[i] - mx);
        st[0] = bl; st[1] = mx;
        float ex = 0.f, mxb = -1e30f;
        for (int i = 0; i < 128; ++i) { const float ge = ex + G[(size_t)(row0 + i) * 32 + 16 + h]; wb[i] = ge; mxb = fmaxf(mxb, ge); ex += G[(size_t)(row0 + i) * 32 + 24 + h]; }
        for (int i = 0; i < 128; ++i) wb[i] = __expf(wb[i] - mxb);
        st[2] = ex; st[3] = mxb;
    }
    __syncthreads();
    const bf16* KA = (const bf16*)(p.ws + WS_KA); const bf16* VA = (const bf16*)(p.ws + WS_VA);
    bf16* UC = (bf16*)(p.ws + WS_UC);
    for (int e = tid; e < 2 * 128 * 64; e += 256) {
        const int dir = e >> 13, dv = (e >> 6) & 127, dk = e & 63; const float* w = dir ? wb : wf;
        float s = 0.f;
        for (int i = 0; i < 128; ++i) s += bf2f(VA[(size_t)(row0 + i) * 1024 + h * 128 + dv]) * bf2f(f2bf(bf2f(KA[(size_t)(row0 + i) * 512 + h * 64 + dk]) * w[i]));
        UC[((((size_t)dir * NB + b) * NHA + h) * NCH + c) * 8192 + dv * 64 + dk] = f2bf(s);
    }
    if (tid < 128) { const int dir = tid >> 6, dk = tid & 63; const float* w = dir ? wb : wf; float s = 0.f;
        for (int i = 0; i < 128; ++i) s += bf2f(f2bf(bf2f(KA[(size_t)(row0 + i) * 512 + h * 64 + dk]) * w[i]));
        ((float*)(p.ws + WS_NU))[((((size_t)b * NHA + h) * 2 + dir) * NCH + c) * 64 + dk] = s; }
    if (tid < 4) ((float*)(p.ws + WS_CH))[((((size_t)b * NHA + h) * 2 + (tid >> 1)) * NCH + c) * 2 + (tid & 1)] = st[tid];
}
__global__ void __launch_bounds__(256) nk_mB(P p) {
    const int bhd = blockIdx.y, e = blockIdx.x * 256 + threadIdx.x;
    const int dir = bhd & 1, bh = bhd >> 1, b = bh / NHA, h = bh % NHA;
    const float* CH = (const float*)(p.ws + WS_CH) + (size_t)bhd * NCH * 2;
    bf16* UC = (bf16*)(p.ws + WS_UC) + (((size_t)dir * NB + b) * NHA + h) * NCH * 8192;
    float* NU = (float*)(p.ws + WS_NU) + (size_t)bhd * NCH * 64;
    float* MIN = (float*)(p.ws + WS_MIN) + (size_t)bhd * NCH;
    float m = 0.f, s = 0.f;
    for (int i = 0; i < NCH; ++i) {
        const int c = dir == 0 ? i : (i < 2 ? 1 - i : NCH + 1 - i);
        const float bl = CH[c * 2], ml = CH[c * 2 + 1];
        const float mn = fmaxf(bl + m, ml), dec = __expf(bl + m - mn), scl = __expf(ml - mn);
        if (e < 8192) { const float u = bf2f(UC[(size_t)c * 8192 + e]); UC[(size_t)c * 8192 + e] = f2bf(s); s = dec * s + scl * u; }
        else if (e < 8256) { const float u = NU[c * 64 + e - 8192]; NU[c * 64 + e - 8192] = s; s = dec * s + scl * u; }
        if (e == 0) MIN[c] = m;
        m = mn;
    }
}
__global__ void __launch_bounds__(256) nk_mC(P p) {
    extern __shared__ float sm[];
    float* S = sm;
    float* ef = S + 128 * 129; float* Mf = ef + 128; float* af = Mf + 128; float* ff = af + 128;
    float* eb = ff + 128; float* Mb = eb + 128; float* ab = Mb + 128; float* fb = ab + 128; float* invf = fb + 128; float* invb = invf + 128;
    float* H = invb + 128;
    const int j = blockIdx.x, h = blockIdx.y, b = blockIdx.z, tid = threadIdx.x, c = j + 2;
    const int row0 = b * SEQ + 128 * j;
    const float* G = (const float*)(p.ws + WS_GATES);
    const bf16* QA = (const bf16*)(p.ws + WS_QA); const bf16* KA = (const bf16*)(p.ws + WS_KA); bf16* VA = (bf16*)(p.ws + WS_VA);
    const size_t bhd_f = ((size_t)b * NHA + h) * 2, bhd_b = bhd_f + 1;
    const float m_f = ((const float*)(p.ws + WS_MIN))[bhd_f * NCH + c], m_b = ((const float*)(p.ws + WS_MIN))[bhd_b * NCH + c];
    const float* n_f = (const float*)(p.ws + WS_NU) + (bhd_f * NCH + c) * 64; const float* n_b = (const float*)(p.ws + WS_NU) + (bhd_b * NCH + c) * 64;
    const bf16* C_f = (const bf16*)(p.ws + WS_UC) + ((((size_t)0 * NB + b) * NHA + h) * NCH + c) * 8192; const bf16* C_b = (const bf16*)(p.ws + WS_UC) + ((((size_t)1 * NB + b) * NHA + h) * NCH + c) * 8192;
    if (tid == 0) {
        float cs = 0.f, pm = m_f;
        for (int i = 0; i < 128; ++i) { cs += G[(size_t)(row0 + i) * 32 + 8 + h]; const float e = G[(size_t)(row0 + i) * 32 + h] - cs; ef[i] = e; pm = fmaxf(pm, e); Mf[i] = pm; af[i] = __expf(m_f - pm); ff[i] = __expf(-(cs + pm)); }
    }
    if (tid == 64) {
        float ss = 0.f, pm = m_b;
        for (int i = 127; i >= 0; --i) { ss += G[(size_t)(row0 + i) * 32 + 24 + h]; const float e = G[(size_t)(row0 + i) * 32 + 16 + h] - ss; eb[i] = e; pm = fmaxf(pm, e); Mb[i] = pm; ab[i] = __expf(m_b - pm); fb[i] = __expf(-(ss + pm)); }
    }
    for (int e = tid; e < 128 * 128; e += 256) { const int t = e >> 7, s = e & 127; float acc = 0.f;
        for (int d = 0; d < 64; ++d) acc += bf2f(QA[(size_t)(row0 + t) * 512 + h * 64 + d]) * bf2f(KA[(size_t)(row0 + s) * 512 + h * 64 + d]);
        S[t * 129 + s] = acc; }
    __syncthreads();
    { const int t = tid & 127; const bool fw = tid < 128; float den = 0.f, qn = 0.f;
        const float* nn = fw ? n_f : n_b;
        for (int d = 0; d < 64; ++d) qn += bf2f(QA[(size_t)(row0 + t) * 512 + h * 64 + d]) * nn[d];
        if (fw) { for (int s = 0; s <= t; ++s) den += S[t * 129 + s] * __expf(ef[s] - Mf[t]); den += af[t] * qn; invf[t] = 1.f / fmaxf(fabsf(den), ff[t]); }
        else { for (int s = t; s < 128; ++s) den += S[t * 129 + s] * __expf(eb[s] - Mb[t]); den += ab[t] * qn; invb[t] = 1.f / fmaxf(fabsf(den), fb[t]); } }
    __syncthreads();
    for (int e = tid; e < 128 * 128; e += 256) { const int t = e >> 7, s = e & 127;
        const float wf_ = s <= t ? __expf(ef[s] - Mf[t]) * invf[t] : 0.f, wb_ = s >= t ? __expf(eb[s] - Mb[t]) * invb[t] : 0.f;
        S[t * 129 + s] *= (wf_ + wb_); }
    __syncthreads();
    for (int e = tid; e < 128 * 128; e += 256) { const int t = e >> 7, dv = e & 127; float acc = 0.f;
        for (int s = 0; s < 128; ++s) acc += S[t * 129 + s] * bf2f(VA[(size_t)(row0 + s) * 1024 + h * 128 + dv]);
        float qc1 = 0.f, qc2 = 0.f;
        for (int d = 0; d < 64; ++d) { const float qv = bf2f(QA[(size_t)(row0 + t) * 512 + h * 64 + d]); qc1 += qv * bf2f(C_f[dv * 64 + d]); qc2 += qv * bf2f(C_b[dv * 64 + d]); }
        H[t * 128 + dv] = acc + af[t] * invf[t] * qc1 + ab[t] * invb[t] * qc2; }
    __syncthreads();
    for (int e = tid; e < 128 * 128; e += 256) { const int t = e >> 7, dv = e & 127;
        float ss = 0.f; for (int i = 0; i < 128; ++i) { const float u = H[t * 128 + ((i + dv) & 127)]; ss += u * u; }
        const float rn = rsqrtf(ss * (1.f / 128.f) + EPS);
        VA[(size_t)(row0 + t) * 1024 + h * 128 + dv] = f2bf(H[t * 128 + dv] * rn * p.mlstm_g[h * 128 + dv] * bf2f(((const bf16*)(p.ws + WS_OA))[(size_t)(row0 + t) * 1024 + h * 128 + dv])); }
}
template <int K> DI void load_a(bf16 (*a)[K], const bf16* A, int row0, int tid) { for (int i = tid; i < 8 * K; i += 256) a[i / K][i % K] = A[(size_t)(row0 + i / K) * K + i % K]; }
__global__ void __launch_bounds__(256) nk_merge(P p) {
    __shared__ bf16 a1[8][DM]; __shared__ bf16 a2[8][DM];
    const int tid = threadIdx.x, col = blockIdx.x * 256 + tid, row0 = blockIdx.y * 8;
    load_a<DM>(a1, (const bf16*)(p.ws + WS_VA), row0, tid); load_a<DM>(a2, (const bf16*)(p.ws + WS_QB), row0, tid);
    __syncthreads();
    float s1[8], s2[8];
#pragma unroll
    for (int r = 0; r < 8; ++r) { s1[r] = 0.f; s2[r] = 0.f; }
    for (int k = 0; k < DM; ++k) { const float wa = p.w_a[(size_t)k * DM + col], wb = p.w_b[(size_t)k * DM + col];
#pragma unroll
        for (int r = 0; r < 8; ++r) { s1[r] += bf2f(a1[r][k]) * wa; s2[r] += bf2f(a2[r][k]) * wb; } }
    const bf16* MG = (const bf16*)p.out;
#pragma unroll
    for (int r = 0; r < 8; ++r) { const size_t row = row0 + r; ((bf16*)(p.ws + WS_T1))[row * DM + col] = f2bf(bf2f(MG[row * 2048 + col]) * s1[r] + bf2f(MG[row * 2048 + 1024 + col]) * s2[r]); }
}
__global__ void __launch_bounds__(256) nk_outproj(P p) {
    __shared__ bf16 a1[8][DM]; __shared__ float red[8][4];
    const int tid = threadIdx.x, col = blockIdx.x * 256 + tid, row0 = blockIdx.y * 8, b = row0 / SEQ;
    load_a<DM>(a1, (const bf16*)(p.ws + WS_T1), row0, tid);
    __syncthreads();
    float s1[8];
#pragma unroll
    for (int r = 0; r < 8; ++r) s1[r] = 0.f;
    for (int k = 0; k < DM; ++k) { const float w = p.w_o[(size_t)k * DM + col];
#pragma unroll
        for (int r = 0; r < 8; ++r) s1[r] += bf2f(a1[r][k]) * w; }
    const float* modv = (const float*)(p.ws + WS_MODV) + b * 6144;
    const float g1 = modv[2048 + col], s2 = p.norm2_g[col] * (1.f + modv[4096 + col]);
#pragma unroll
    for (int r = 0; r < 8; ++r) { const size_t row = row0 + r; const float xn = p.x[row * DM + col] + g1 * s1[r];
        p.out[row * DM + col] = xn; ((bf16*)(p.ws + WS_XS))[row * DM + col] = f2bf(xn * s2);
        float q = xn * xn; for (int o = 1; o < 64; o <<= 1) q += __shfl_xor(q, o);
        if ((tid & 63) == 0) red[r][tid >> 6] = q; }
    __syncthreads();
    if (tid < 8) atomicAdd((float*)(p.ws + WS_SUMSQ) + row0 + tid, red[tid][0] + red[tid][1] + red[tid][2] + red[tid][3]);
}
__global__ void __launch_bounds__(256) nk_ffn1(P p) {
    __shared__ bf16 a1[8][DM];
    const int tid = threadIdx.x, col = blockIdx.x * 256 + tid, row0 = blockIdx.y * 8, b = row0 / SEQ;
    load_a<DM>(a1, (const bf16*)(p.ws + WS_XS), row0, tid);
    __syncthreads();
    const float* sh2 = (const float*)(p.ws + WS_MODV) + b * 6144 + 3072;
    float sg[8], su[8], bg = 0.f, bu = 0.f;
#pragma unroll
    for (int r = 0; r < 8; ++r) { sg[r] = 0.f; su[r] = 0.f; }
    for (int k = 0; k < DM; ++k) { const float wg = p.w_fg[(size_t)k * DFF + col], wu = p.w_fu[(size_t)k * DFF + col]; const float sh = sh2[k]; bg += sh * wg; bu += sh * wu;
#pragma unroll
        for (int r = 0; r < 8; ++r) { const float a = bf2f(a1[r][k]); sg[r] += a * wg; su[r] += a * wu; } }
#pragma unroll
    for (int r = 0; r < 8; ++r) { const size_t row = row0 + r; const float rstd = rsqrtf(((const float*)(p.ws + WS_SUMSQ))[row] * (1.f / DM) + EPS);
        const float g = rstd * sg[r] + bg, u = rstd * su[r] + bu;
        ((bf16*)(p.ws + WS_HFF))[row * DFF + col] = f2bf(g * sigmoidf_(g) * u); }
}
__global__ void __launch_bounds__(256) nk_ffn2(P p) {
    __shared__ bf16 a1[8][DFF];
    const int tid = threadIdx.x, col = blockIdx.x * 256 + tid, row0 = blockIdx.y * 8, b = row0 / SEQ;
    load_a<DFF>(a1, (const bf16*)(p.ws + WS_HFF), row0, tid);
    __syncthreads();
    float s1[8];
#pragma unroll
    for (int r = 0; r < 8; ++r) s1[r] = 0.f;
    for (int k = 0; k < DFF; ++k) { const float w = p.w_fd[(size_t)k * DM + col];
#pragma unroll
        for (int r = 0; r < 8; ++r) s1[r] += bf2f(a1[r][k]) * w; }
    const float g2 = ((const float*)(p.ws + WS_MODV))[b * 6144 + 5120 + col];
#pragma unroll
    for (int r = 0; r < 8; ++r) { const size_t row = row0 + r; p.out[row * DM + col] += g2 * s1[r]; }
}


#ifndef VARIANT
#define VARIANT 0
#endif
extern "C" void kernel_launch(void* const* d_in, const int* in_sizes, int n_in, void* d_out, int out_size, void* d_ws, size_t ws_size, hipStream_t stream) {
    if (n_in != 20 || ws_size < WS_END || out_size != M_LAT * DM) { fprintf(stderr, "kernel_launch: unexpected shapes (n_in %d, ws %zu, out %d)\n", n_in, ws_size, out_size); return; }
    P p{};
    const float** f = (const float**)&p;
    for (int i = 0; i < 20; ++i) f[i] = (const float*)d_in[i];
    p.out = (float*)d_out; p.ws = (unsigned char*)d_ws;
    static int grid = 0;
    if (!grid) {
        (void)hipFuncSetAttribute((const void*)nk_mC, hipFuncAttributeMaxDynamicSharedMemorySize, 140 * 1024);
        (void)hipFuncSetAttribute((const void*)mk_fwd, hipFuncAttributeMaxDynamicSharedMemorySize, LDS_BYTES);
        int dev = 0, cus = 0, per_cu = 0;
        (void)hipGetDevice(&dev); (void)hipDeviceGetAttribute(&cus, hipDeviceAttributeMultiprocessorCount, dev);
        (void)hipOccupancyMaxActiveBlocksPerMultiprocessor(&per_cu, (const void*)mk_fwd, NTHR, LDS_BYTES);
        if (per_cu < 1) { fprintf(stderr, "kernel_launch: occupancy query says %d blocks/CU\n", per_cu); per_cu = 1; }
        grid = cus;
    }
    int nli = 0;
    auto mk = [&](int lo, int hi, int dbg = 0xff) { int a = lo, b = hi, c = nli++, d = dbg; void* args[] = {&p, &a, &b, &c, &d};
        hipError_t e = hipLaunchCooperativeKernel((const void*)mk_fwd, dim3(grid), dim3(NTHR), args, LDS_BYTES, stream);
        if (e != hipSuccess) fprintf(stderr, "cooperative launch failed: %s (grid %d)\n", hipGetErrorString(e), grid); };
    (void)hipMemsetAsync(d_ws, 0, CTL_ZERO_BYTES, stream);
#if VARIANT == 0
    mk(PH_P0, PH_COUNT);
#elif VARIANT == 1
    mk(PH_P0, PH_INPROJ);
    nk_mod<<<dim3(24, 5), 256, 0, stream>>>(p); nk_tables<<<128, 256, 0, stream>>>(p); nk_norm1<<<M_ALL / 4, 256, 0, stream>>>(p);
    mk(PH_INPROJ, PH_COUNT);
#elif VARIANT == 2
    mk(PH_P0, PH_MA);
    nk_na<<<dim3(M_LAT, NHB), 64, 0, stream>>>(p); nk_mA<<<dim3(NCH, NHA, NB), 256, 0, stream>>>(p); nk_mB<<<dim3(33, 64), 256, 0, stream>>>(p);
    nk_mC<<<dim3(64, NHA, NB), 256, (128 * 129 + 1280 + 128 * 128) * 4, stream>>>(p);
    mk(PH_MERGE, PH_COUNT);
#elif VARIANT == 3
    mk(PH_P0, PH_MC);
    nk_mC<<<dim3(64, NHA, NB), 256, (128 * 129 + 1280 + 128 * 128) * 4, stream>>>(p);
    mk(PH_MERGE, PH_COUNT);
#elif VARIANT == 4
    mk(PH_P0, PH_MA); nk_mA<<<dim3(NCH, NHA, NB), 256, 0, stream>>>(p); mk(PH_MA, PH_SCAN_NA);
    nk_na<<<dim3(M_LAT, NHB), 64, 0, stream>>>(p); nk_mB<<<dim3(33, 64), 256, 0, stream>>>(p);
    nk_mC<<<dim3(64, NHA, NB), 256, (128 * 129 + 1280 + 128 * 128) * 4, stream>>>(p);
    mk(PH_MERGE, PH_COUNT);
#endif
}
```

```cpp
#include <hip/hip_runtime.h>
#include <hip/hip_cooperative_groups.h>
#include <cstdio>
#include <cstdint>
namespace cg = cooperative_groups;

typedef unsigned short bf16;
#define DI __device__ __forceinline__
#define LAS __attribute__((address_space(3)))
DI float bf2f(bf16 b) { return __uint_as_float(((unsigned)b) << 16); }
DI bf16 f2bf(float f) { unsigned u = __float_as_uint(f); return (bf16)((u + 0x7fffu + ((u >> 16) & 1u)) >> 16); }
DI float sigmoidf_(float x) { return 1.f / (1.f + __expf(-x)); }
DI float logsigmoidf_(float x) { return fminf(x, 0.f) - log1pf(__expf(-fabsf(x))); }

constexpr int NB = 4, SEQ = 8192, DM = 1024, CTX = 256, GW = 64, GROWS = 128;
constexpr int M_LAT = NB * SEQ, M_CTX = NB * CTX, M_ALL = M_LAT + M_CTX;
constexpr int NHA = 8, DKA = 64, DVA = 128, NHB = 16, DHB = 64;
constexpr int DIN = 8224, DFF = 2816, NCH = 66;
constexpr float EPS = 1e-6f, GCAP = 15.f;
constexpr int C_QA = 0, C_KA = 512, C_VA = 1024, C_OA = 2048, C_G = 3072, C_QB = 3104, C_KB = 4128, C_VB = 5152, C_MG = 6176;

constexpr size_t MiB = 1u << 20;
constexpr size_t WS_MODV = 1 * MiB;
constexpr size_t WS_ROPE = WS_MODV + 128 * 1024;
constexpr size_t WS_SUMSQ = WS_ROPE + 32 * 1024;
constexpr size_t WS_CH = WS_SUMSQ + 128 * 1024;
constexpr size_t WS_MIN = WS_CH + 64 * 1024;
constexpr size_t WS_BGU = WS_MIN + 32 * 1024;
constexpr size_t WS_NU = WS_BGU + 128 * 1024;
constexpr size_t WS_GATES = 3 * MiB;
constexpr size_t WS_W = 8 * MiB;
constexpr size_t WS_WIN = WS_W, WS_WA = 25 * MiB, WS_WB = 27 * MiB, WS_WO = 29 * MiB, WS_WGU = 31 * MiB, WS_WD = 42 * MiB;
constexpr size_t WS_HX = 48 * MiB, WS_QA = 114 * MiB, WS_KA = 147 * MiB, WS_VA = 180 * MiB, WS_OA = 246 * MiB, WS_QB = 310 * MiB, WS_KB = 374 * MiB, WS_VB = 440 * MiB, WS_DUMMY = 506 * MiB  , WS_END = 507 * MiB;
constexpr size_t WS_T1 = WS_QA, WS_XS = WS_HX, WS_HFF = WS_QB, WS_TMP = WS_KB;
constexpr size_t WS_XN = WS_VA;
constexpr size_t WS_SC = WS_WIN;
constexpr size_t WS_UC = WS_HX;
static_assert(WS_NU + 4 * 8 * 2 * 66 * 64 * 4 <= WS_GATES && WS_GATES + (size_t)M_ALL * 32 * 4 <= WS_W, "misc map");
static_assert(WS_WIN + (size_t)33 * 256 * 1024 * 2 <= WS_WA && WS_WGU + (size_t)5632 * 1024 * 2 <= WS_WD && WS_WD + (size_t)1024 * 2816 * 2 <= WS_HX, "weight map");

struct P {
    const float *x, *c, *ctx, *c_ctx, *w_mod, *b_mod, *norm1_g, *w_in, *b_gates, *mlstm_g, *qn_g, *kn_g, *rpb, *w_a, *w_b, *w_o, *norm2_g, *w_fg, *w_fu, *w_fd;
    float* out; unsigned char* ws;
};
#ifndef PG8_EARLY
#define PG8_EARLY 2
#endif
#ifndef PG8_WGM
#define PG8_WGM 4
#endif
namespace pg8 {
#define PG8_LAS __attribute__((address_space(3)))
typedef unsigned short bf16_t;
typedef short bf16x8 __attribute__((ext_vector_type(8)));
typedef float f32x4 __attribute__((ext_vector_type(4)));
typedef unsigned u32x4 __attribute__((ext_vector_type(4)));
constexpr int BM = 256, BK = 64, HALF = 128, HTB = HALF * BK * 2  , STAGE_BYTES = 8 * HTB, NXCD = 8, WGM = PG8_WGM;

__host__ __device__ __forceinline__ int lds_byte(int r, int c) { const int st = (r >> 4) * 2 + (c >> 5), rr = r & 15, cc = c & 31, ob = rr * 64 + cc * 2; return st * 1024 + (ob ^ (((ob >> 9) & 1) << 5)); }
__host__ __device__ __forceinline__ void stage_rc(int b, int& R, int& C) { const int st = b / 1024, sb = b % 1024, swz = sb ^ (((sb >> 9) & 1) << 5); R = (st >> 1) * 16 + swz / 64; C = (st & 1) * 32 + (swz % 64) / 2; }
__host__ __device__ __forceinline__ int perm32(int rho) { const int n = rho >> 4, i = rho & 15; return 8 * (i >> 2) + 4 * n + (i & 3); }

struct Unit { int pm, pn; };
struct Gemm { const bf16_t* A; const bf16_t* Bt; int M, N, K; unsigned* dz; };
template <int N> __device__ __forceinline__ void dummy_stores(unsigned* dz) {
    unsigned t = threadIdx.x; asm volatile("" : "+v"(t));
    unsigned* q = dz + blockIdx.x * 512 + t;
#pragma unroll
    for (int i = 0; i < N; ++i) asm volatile("global_store_dword %0, %1, off" :: "v"(q), "v"(0u) : "memory");
}

struct StaticOrder {
    int nM, nN, nwg, G, c;
    __host__ __device__ void init(int M, int N, int G_, int c_) { nM = M / BM; nN = N / BM; nwg = nM * nN; G = G_; c = c_; }
    __host__ __device__ bool next(int i, Unit& u) const {
        const long L = (long)i * G + c; if (L >= nwg) return false;
        int wgid = (int)L; { const int q = nwg / NXCD, r = nwg % NXCD, xcd = wgid % NXCD, off = wgid / NXCD; wgid = (xcd < r ? xcd * (q + 1) : r * (q + 1) + (xcd - r) * q) + off; }
        const int nig = WGM * nN, gid = wgid / nig, fm = gid * WGM, gsz = (nM - fm) < WGM ? (nM - fm) : WGM;
        u.pm = fm + ((wgid % nig) % gsz); u.pn = (wgid % nig) / gsz; return true;
    }
    __device__ __forceinline__ void a_ready(const Unit&) const {}
    __device__ __forceinline__ void done(const Unit&) const {}
};
__device__ __forceinline__ unsigned cvt_pk_bf16(float lo, float hi) { unsigned r; asm volatile("v_cvt_pk_bf16_f32 %0, %1, %2" : "=v"(r) : "v"(lo), "v"(hi)); return r; }
typedef float f32x2 __attribute__((ext_vector_type(2)));
template <class Epi, class Sched, bool ALIGN_EPI = false, bool SP2 = false>
__device__ __forceinline__ void gemm_phase(PG8_LAS unsigned char* lds, const Gemm g, const Sched& S, const Epi& E) {
    const int tid = threadIdx.x, wid = __builtin_amdgcn_readfirstlane(tid >> 6), lane = tid & 63, wr = wid >> 2, wc = wid & 3, fr = lane & 15, fq = lane >> 4;
    const int K = g.K, nt = K / BK;
    unsigned voffA[2], voffB[2];
#pragma unroll
    for (int i = 0; i < 2; ++i) { int R, C; stage_rc(tid * 16 + i * 8192, R, C); const int Rb = Epi::PERM ? ((R & ~31) + perm32(R & 31)) : R;
        voffA[i] = (unsigned)(R * K + C) * 2u; voffB[i] = (unsigned)(Rb * K + C) * 2u; }
    const size_t kstep = (size_t)(BK * 2);
    const size_t hstep = (size_t)HALF * K * 2;
    const size_t tstep = 2 * hstep;
    const unsigned ldsw = (unsigned)wid * 1024u;
    const int aoff = lds_byte(wr * 64 + fr, fq * 8), boff = lds_byte(wc * 32 + fr, fq * 8);
#define PG8_SA(b, h) (((b) * 2 + (h)) * HTB)
#define PG8_SB(b, h) ((4 + (b) * 2 + (h)) * HTB)
#define PG8_STAGE(bufoff, gbase, voff) do { _Pragma("unroll") for (int _i = 0; _i < 2; ++_i) \
        __builtin_amdgcn_global_load_lds((const unsigned*)((const char*)(gbase) + (voff)[_i]), (PG8_LAS unsigned*)(lds + (bufoff) + ldsw + _i * 8192), 16, 0, 0); } while (0)
#define PG8_LDA(dst, b, h) do { _Pragma("unroll") for (int m = 0; m < 4; ++m) _Pragma("unroll") for (int k = 0; k < 2; ++k) dst[m][k] = *(const PG8_LAS bf16x8*)(lds + PG8_SA(b, h) + aoff + m * 2048 + k * 1024); } while (0)
#define PG8_LDB(dst, b, h) do { _Pragma("unroll") for (int n = 0; n < 2; ++n) _Pragma("unroll") for (int k = 0; k < 2; ++k) dst[n][k] = *(const PG8_LAS bf16x8*)(lds + PG8_SB(b, h) + boff + n * 2048 + k * 1024); } while (0)
#define PG8_MMA(ai, bj, At, Bt) do { __builtin_amdgcn_s_setprio(1); _Pragma("unroll") for (int m = 0; m < 4; ++m) _Pragma("unroll") for (int n = 0; n < 2; ++n) _Pragma("unroll") for (int k = 0; k < 2; ++k) \
        acc[ai][bj][m][n] = __builtin_amdgcn_mfma_f32_16x16x32_bf16(Bt[n][k], At[m][k], acc[ai][bj][m][n], 0, 0, 0); __builtin_amdgcn_s_setprio(0); } while (0)
#define PG8_WAIT_V(n) asm volatile("s_waitcnt vmcnt(" #n ")" ::: "memory")
#define PG8_WAIT_L(n) asm volatile("s_waitcnt lgkmcnt(" #n ")" ::: "memory")
#define PG8_BAR __builtin_amdgcn_s_barrier()
#define PG8_SCHED __builtin_amdgcn_sched_barrier(0)
    constexpr bool EARLY = SP2 && ALIGN_EPI && (PG8_EARLY != 0);
    constexpr int RX = EARLY ? Epi::TRAIL * (PG8_EARLY >> 1) : 0;
    Unit cur, nxt; int ui = 0;
    if (!S.next(0, cur)) return;
    f32x4 acc[2][2][4][2];
#pragma unroll
    for (int a = 0; a < 2; ++a)
#pragma unroll
        for (int b = 0; b < 2; ++b)
#pragma unroll
            for (int m = 0; m < 4; ++m)
#pragma unroll
                for (int n = 0; n < 2; ++n) acc[a][b][m][n] = (f32x4){0.f, 0.f, 0.f, 0.f};
    bf16x8 At[4][2], B0[2][2], B1[2][2];
    const char* cA = (const char*)g.A + (size_t)cur.pm * tstep; const char* cB = (const char*)g.Bt + (size_t)cur.pn * tstep;
    S.a_ready(cur);
    if constexpr (SP2) {
        PG8_STAGE(PG8_SB(0, 0), cB, voffB); PG8_STAGE(PG8_SB(0, 1), cB + hstep, voffB); PG8_STAGE(PG8_SA(0, 0), cA, voffA); PG8_STAGE(PG8_SA(0, 1), cA + hstep, voffA);
        if (wr == 1) PG8_BAR;
        PG8_WAIT_V(2); PG8_BAR;
        PG8_STAGE(PG8_SB(1, 0), cB + kstep, voffB); PG8_STAGE(PG8_SA(1, 0), cA + kstep, voffA); PG8_STAGE(PG8_SB(1, 1), cB + hstep + kstep, voffB);
        PG8_WAIT_V(6); PG8_BAR;
        if constexpr (EARLY) PG8_STAGE(PG8_SA(1, 1), cA + kstep + hstep, voffA);
        if constexpr (RX > 0) dummy_stores<RX>(g.dz);
    } else {
        PG8_STAGE(PG8_SB(0, 0), cB, voffB); PG8_STAGE(PG8_SA(0, 0), cA, voffA); PG8_STAGE(PG8_SB(0, 1), cB + hstep, voffB); PG8_STAGE(PG8_SA(0, 1), cA + hstep, voffA);
        if (wr == 1) PG8_BAR;
        PG8_WAIT_V(4); PG8_BAR;
        PG8_STAGE(PG8_SB(1, 0), cB + kstep, voffB); PG8_STAGE(PG8_SA(1, 0), cA + kstep, voffA); PG8_STAGE(PG8_SB(1, 1), cB + hstep + kstep, voffB);
        PG8_WAIT_V(6); PG8_BAR;
    }
    for (;;) {
        const bool has_next = S.next(ui + 1, nxt);
        const char* nA = has_next ? (const char*)g.A + (size_t)nxt.pm * tstep : cA; const char* nB = has_next ? (const char*)g.Bt + (size_t)nxt.pn * tstep : cB;
#define PG8_KITER(WX) do { \
            const bool last = (t == nt - 2); \
            const char* a1 = cA + (size_t)(t + 1) * kstep; \
            const char* a2 = last ? nA : cA + (size_t)(t + 2) * kstep; const char* b2 = last ? nB : cB + (size_t)(t + 2) * kstep; \
            const char* a3 = a2 + kstep; const char* b3 = b2 + kstep; \
            if (last && has_next) S.a_ready(nxt); \
              \
            PG8_LDB(B0, 0, 0); PG8_LDB(B1, 0, 1); PG8_SCHED; PG8_LDA(At, 0, 0); if constexpr (!EARLY) PG8_STAGE(PG8_SA(1, 1), a1 + hstep, voffA); \
            WX; PG8_WAIT_L(0); PG8_BAR; PG8_MMA(0, 0, At, B0); PG8_MMA(0, 1, At, B1); PG8_BAR; PG8_SCHED; \
              \
            PG8_LDA(At, 0, 1); PG8_STAGE(PG8_SB(0, 0), b2, voffB); PG8_STAGE(PG8_SB(0, 1), b2 + hstep, voffB); PG8_STAGE(PG8_SA(0, 0), a2, voffA); \
            WX; PG8_WAIT_L(0); PG8_BAR; PG8_MMA(1, 0, At, B0); PG8_MMA(1, 1, At, B1); PG8_BAR; PG8_SCHED; \
              \
            PG8_LDB(B0, 1, 0); PG8_LDB(B1, 1, 1); PG8_SCHED; PG8_LDA(At, 1, 0); PG8_STAGE(PG8_SA(0, 1), a2 + hstep, voffA); \
            WX; PG8_WAIT_L(0); PG8_BAR; PG8_MMA(0, 0, At, B0); PG8_MMA(0, 1, At, B1); PG8_BAR; PG8_SCHED; \
              \
            PG8_LDA(At, 1, 1); PG8_STAGE(PG8_SB(1, 0), b3, voffB); PG8_STAGE(PG8_SB(1, 1), b3 + hstep, voffB); PG8_STAGE(PG8_SA(1, 0), a3, voffA); \
            PG8_WAIT_V(8); PG8_WAIT_L(0); PG8_BAR; PG8_MMA(1, 0, At, B0); PG8_MMA(1, 1, At, B1); PG8_BAR; PG8_SCHED; \
              \
            if constexpr (EARLY) PG8_STAGE(PG8_SA(1, 1), a3 + hstep, voffA); } while (0)
#define PG8_WAIT_RX do { if constexpr (RX == 32) PG8_WAIT_V(40); else if constexpr (RX == 16) PG8_WAIT_V(24); else PG8_WAIT_V(8); } while (0)
        if constexpr (SP2) {
            int t = 0;
            if constexpr (RX > 0) { PG8_KITER(PG8_WAIT_RX); t = 2; }
            for (; t < nt; t += 2) PG8_KITER(PG8_WAIT_V(8));
        } else
        for (int t = 0; t < nt; t += 2) {
            const bool last = (t == nt - 2);
            const char* a1 = cA + (size_t)(t + 1) * kstep;
            const char* a2 = last ? nA : cA + (size_t)(t + 2) * kstep; const char* b2 = last ? nB : cB + (size_t)(t + 2) * kstep;
            const char* a3 = a2 + kstep; const char* b3 = b2 + kstep;
            if (last && has_next) S.a_ready(nxt);
            {
            PG8_LDB(B0, 0, 0); PG8_SCHED; PG8_LDA(At, 0, 0); PG8_STAGE(PG8_SA(1, 1), a1 + hstep, voffA);
            PG8_WAIT_L(8); PG8_BAR; PG8_WAIT_L(0); PG8_MMA(0, 0, At, B0); PG8_BAR; PG8_SCHED;
            PG8_LDB(B1, 0, 1); PG8_STAGE(PG8_SB(0, 0), b2, voffB);
            PG8_BAR; PG8_WAIT_L(0); PG8_MMA(0, 1, At, B1); PG8_BAR;
            PG8_LDA(At, 0, 1); PG8_STAGE(PG8_SA(0, 0), a2, voffA);
            PG8_BAR; PG8_WAIT_L(0); PG8_MMA(1, 0, At, B0); PG8_BAR; PG8_SCHED;
            PG8_STAGE(PG8_SB(0, 1), b2 + hstep, voffB);
            PG8_WAIT_V(6); PG8_BAR; PG8_MMA(1, 1, At, B1); PG8_BAR;
            PG8_LDB(B0, 1, 0); PG8_SCHED; PG8_LDA(At, 1, 0); PG8_STAGE(PG8_SA(0, 1), a2 + hstep, voffA);
            PG8_WAIT_L(8); PG8_BAR; PG8_WAIT_L(0); PG8_MMA(0, 0, At, B0); PG8_BAR; PG8_SCHED;
            PG8_LDB(B1, 1, 1); PG8_STAGE(PG8_SB(1, 0), b3, voffB);
            PG8_BAR; PG8_WAIT_L(0); PG8_MMA(0, 1, At, B1); PG8_BAR;
            PG8_LDA(At, 1, 1); PG8_STAGE(PG8_SA(1, 0), a3, voffA);
            PG8_BAR; PG8_WAIT_L(0); PG8_MMA(1, 0, At, B0); PG8_BAR; PG8_SCHED;
            PG8_STAGE(PG8_SB(1, 1), b3 + hstep, voffB);
            PG8_WAIT_V(6); PG8_BAR; PG8_MMA(1, 1, At, B1); PG8_BAR;
            }
        }
        if constexpr (ALIGN_EPI) { if (wr == 0) PG8_BAR; }
        if constexpr (!Epi::AFTER_DRAIN) { Unit eu = cur; int fr_ = fr, fq_ = fq; if constexpr (RX > 0) asm volatile("" : "+s"(eu.pm), "+s"(eu.pn), "+v"(fr_), "+v"(fq_));
            E(acc, eu, wr, wc, fr_, fq_); S.done(cur); }
        if (!has_next) break;
#pragma unroll
        for (int a = 0; a < 2; ++a)
#pragma unroll
            for (int b = 0; b < 2; ++b)
#pragma unroll
                for (int m = 0; m < 4; ++m)
#pragma unroll
                    for (int n = 0; n < 2; ++n) acc[a][b][m][n] = (f32x4){0.f, 0.f, 0.f, 0.f};
        cur = nxt; cA = nA; cB = nB; ++ui;
        if constexpr (ALIGN_EPI) { if (wr == 1) PG8_BAR; }
    }
    PG8_WAIT_V(0);
    if constexpr (!ALIGN_EPI) { if (wr == 0) PG8_BAR; }
    PG8_BAR;
    if constexpr (Epi::AFTER_DRAIN) { E.fused(acc, cur, wr, wc, fr, fq, lds, wid, lane); S.done(cur); }
#undef PG8_SA
#undef PG8_SB
#undef PG8_STAGE
#undef PG8_LDA
#undef PG8_LDB
#undef PG8_MMA
#undef PG8_WAIT_V
#undef PG8_KITER
#undef PG8_WAIT_RX
#undef PG8_WAIT_L
#undef PG8_BAR
#undef PG8_SCHED
}
struct Unit2 { int pm, pn, sub; };
struct Gemm2 { const bf16_t* A1; const bf16_t* Bt1; const bf16_t* A2; const bf16_t* Bt2; int M, N, K; };
template <class Epi, class Sched, bool ALIGN_EPI = false, bool SP2 = false>
__device__ __forceinline__ void gemm_phase2(PG8_LAS unsigned char* lds, const Gemm2 g, const Sched& S, const Epi& E) {
    const int tid = threadIdx.x, wid = __builtin_amdgcn_readfirstlane(tid >> 6), lane = tid & 63, wr = wid >> 2, wc = wid & 3, fr = lane & 15, fq = lane >> 4;
    const int K = g.K, nt = K / BK;
    unsigned voffA[2], voffB[2];
#pragma unroll
    for (int i = 0; i < 2; ++i) { int R, C; stage_rc(tid * 16 + i * 8192, R, C); const int Rb = Epi::PERM ? ((R & ~31) + perm32(R & 31)) : R;
        voffA[i] = (unsigned)(R * K + C) * 2u; voffB[i] = (unsigned)(Rb * K + C) * 2u; }
    const size_t kstep = (size_t)(BK * 2);
    const size_t hstep = (size_t)HALF * K * 2;
    const size_t tstep = 2 * hstep;
    const unsigned ldsw = (unsigned)wid * 1024u;
    const int aoff = lds_byte(wr * 64 + fr, fq * 8), boff = lds_byte(wc * 32 + fr, fq * 8);
#define PG8_SA(b, h) (((b) * 2 + (h)) * HTB)
#define PG8_SB(b, h) ((4 + (b) * 2 + (h)) * HTB)
#define PG8_STAGE(bufoff, gbase, voff) do { _Pragma("unroll") for (int _i = 0; _i < 2; ++_i) \
        __builtin_amdgcn_global_load_lds((const unsigned*)((const char*)(gbase) + (voff)[_i]), (PG8_LAS unsigned*)(lds + (bufoff) + ldsw + _i * 8192), 16, 0, 0); } while (0)
#define PG8_LDA(dst, b, h) do { _Pragma("unroll") for (int m = 0; m < 4; ++m) _Pragma("unroll") for (int k = 0; k < 2; ++k) dst[m][k] = *(const PG8_LAS bf16x8*)(lds + PG8_SA(b, h) + aoff + m * 2048 + k * 1024); } while (0)
#define PG8_LDB(dst, b, h) do { _Pragma("unroll") for (int n = 0; n < 2; ++n) _Pragma("unroll") for (int k = 0; k < 2; ++k) dst[n][k] = *(const PG8_LAS bf16x8*)(lds + PG8_SB(b, h) + boff + n * 2048 + k * 1024); } while (0)
#define PG8_MMA(ai, bj, At, Bt) do { __builtin_amdgcn_s_setprio(1); _Pragma("unroll") for (int m = 0; m < 4; ++m) _Pragma("unroll") for (int n = 0; n < 2; ++n) _Pragma("unroll") for (int k = 0; k < 2; ++k) \
        acc[ai][bj][m][n] = __builtin_amdgcn_mfma_f32_16x16x32_bf16(Bt[n][k], At[m][k], acc[ai][bj][m][n], 0, 0, 0); __builtin_amdgcn_s_setprio(0); } while (0)
#define PG8_WAIT_V(n) asm volatile("s_waitcnt vmcnt(" #n ")" ::: "memory")
#define PG8_WAIT_L(n) asm volatile("s_waitcnt lgkmcnt(" #n ")" ::: "memory")
#define PG8_BAR __builtin_amdgcn_s_barrier()
#define PG8_SCHED __builtin_amdgcn_sched_barrier(0)
    Unit2 cur, nxt; int ui = 0;
    if (!S.next(0, cur)) return;
    f32x4 acc[2][2][4][2];
#pragma unroll
    for (int a = 0; a < 2; ++a)
#pragma unroll
        for (int b = 0; b < 2; ++b)
#pragma unroll
            for (int m = 0; m < 4; ++m)
#pragma unroll
                for (int n = 0; n < 2; ++n) acc[a][b][m][n] = (f32x4){0.f, 0.f, 0.f, 0.f};
    bf16x8 At[4][2], B0[2][2], B1[2][2];
    const char* cA = (const char*)(cur.sub ? g.A2 : g.A1) + (size_t)cur.pm * tstep; const char* cB = (const char*)(cur.sub ? g.Bt2 : g.Bt1) + (size_t)cur.pn * tstep;
    S.a_ready(cur);
    if constexpr (SP2) {
        PG8_STAGE(PG8_SB(0, 0), cB, voffB); PG8_STAGE(PG8_SB(0, 1), cB + hstep, voffB); PG8_STAGE(PG8_SA(0, 0), cA, voffA); PG8_STAGE(PG8_SA(0, 1), cA + hstep, voffA);
        if (wr == 1) PG8_BAR;
        PG8_WAIT_V(2); PG8_BAR;
        PG8_STAGE(PG8_SB(1, 0), cB + kstep, voffB); PG8_STAGE(PG8_SA(1, 0), cA + kstep, voffA); PG8_STAGE(PG8_SB(1, 1), cB + hstep + kstep, voffB);
        PG8_WAIT_V(6); PG8_BAR;
    } else {
        PG8_STAGE(PG8_SB(0, 0), cB, voffB); PG8_STAGE(PG8_SA(0, 0), cA, voffA); PG8_STAGE(PG8_SB(0, 1), cB + hstep, voffB); PG8_STAGE(PG8_SA(0, 1), cA + hstep, voffA);
        if (wr == 1) PG8_BAR;
        PG8_WAIT_V(4); PG8_BAR;
        PG8_STAGE(PG8_SB(1, 0), cB + kstep, voffB); PG8_STAGE(PG8_SA(1, 0), cA + kstep, voffA); PG8_STAGE(PG8_SB(1, 1), cB + hstep + kstep, voffB);
        PG8_WAIT_V(6); PG8_BAR;
    }
    for (;;) {
        const bool has_next = S.next(ui + 1, nxt);
        const char* nA = has_next ? (const char*)(nxt.sub ? g.A2 : g.A1) + (size_t)nxt.pm * tstep : cA; const char* nB = has_next ? (const char*)(nxt.sub ? g.Bt2 : g.Bt1) + (size_t)nxt.pn * tstep : cB;
        for (int t = 0; t < nt; t += 2) {
            const bool last = (t == nt - 2);
            const char* a1 = cA + (size_t)(t + 1) * kstep;
            const char* a2 = last ? nA : cA + (size_t)(t + 2) * kstep; const char* b2 = last ? nB : cB + (size_t)(t + 2) * kstep;
            const char* a3 = a2 + kstep; const char* b3 = b2 + kstep;
            if (last && has_next) S.a_ready(nxt);
            if constexpr (SP2) {
            PG8_LDB(B0, 0, 0); PG8_LDB(B1, 0, 1); PG8_SCHED; PG8_LDA(At, 0, 0); PG8_STAGE(PG8_SA(1, 1), a1 + hstep, voffA);
            PG8_WAIT_V(8); PG8_WAIT_L(0); PG8_BAR; PG8_MMA(0, 0, At, B0); PG8_MMA(0, 1, At, B1); PG8_BAR; PG8_SCHED;
            PG8_LDA(At, 0, 1); PG8_STAGE(PG8_SB(0, 0), b2, voffB); PG8_STAGE(PG8_SB(0, 1), b2 + hstep, voffB); PG8_STAGE(PG8_SA(0, 0), a2, voffA);
            PG8_WAIT_V(8); PG8_WAIT_L(0); PG8_BAR; PG8_MMA(1, 0, At, B0); PG8_MMA(1, 1, At, B1); PG8_BAR; PG8_SCHED;
            PG8_LDB(B0, 1, 0); PG8_LDB(B1, 1, 1); PG8_SCHED; PG8_LDA(At, 1, 0); PG8_STAGE(PG8_SA(0, 1), a2 + hstep, voffA);
            PG8_WAIT_V(8); PG8_WAIT_L(0); PG8_BAR; PG8_MMA(0, 0, At, B0); PG8_MMA(0, 1, At, B1); PG8_BAR; PG8_SCHED;
            PG8_LDA(At, 1, 1); PG8_STAGE(PG8_SB(1, 0), b3, voffB); PG8_STAGE(PG8_SB(1, 1), b3 + hstep, voffB); PG8_STAGE(PG8_SA(1, 0), a3, voffA);
            PG8_WAIT_V(8); PG8_WAIT_L(0); PG8_BAR; PG8_MMA(1, 0, At, B0); PG8_MMA(1, 1, At, B1); PG8_BAR; PG8_SCHED;
            } else {
            PG8_LDB(B0, 0, 0); PG8_SCHED; PG8_LDA(At, 0, 0); PG8_STAGE(PG8_SA(1, 1), a1 + hstep, voffA);
            PG8_WAIT_L(8); PG8_BAR; PG8_WAIT_L(0); PG8_MMA(0, 0, At, B0); PG8_BAR; PG8_SCHED;
            PG8_LDB(B1, 0, 1); PG8_STAGE(PG8_SB(0, 0), b2, voffB);
            PG8_BAR; PG8_WAIT_L(0); PG8_MMA(0, 1, At, B1); PG8_BAR;
            PG8_LDA(At, 0, 1); PG8_STAGE(PG8_SA(0, 0), a2, voffA);
            PG8_BAR; PG8_WAIT_L(0); PG8_MMA(1, 0, At, B0); PG8_BAR; PG8_SCHED;
            PG8_STAGE(PG8_SB(0, 1), b2 + hstep, voffB);
            PG8_WAIT_V(6); PG8_BAR; PG8_MMA(1, 1, At, B1); PG8_BAR;
            PG8_LDB(B0, 1, 0); PG8_SCHED; PG8_LDA(At, 1, 0); PG8_STAGE(PG8_SA(0, 1), a2 + hstep, voffA);
            PG8_WAIT_L(8); PG8_BAR; PG8_WAIT_L(0); PG8_MMA(0, 0, At, B0); PG8_BAR; PG8_SCHED;
            PG8_LDB(B1, 1, 1); PG8_STAGE(PG8_SB(1, 0), b3, voffB);
            PG8_BAR; PG8_WAIT_L(0); PG8_MMA(0, 1, At, B1); PG8_BAR;
            PG8_LDA(At, 1, 1); PG8_STAGE(PG8_SA(1, 0), a3, voffA);
            PG8_BAR; PG8_WAIT_L(0); PG8_MMA(1, 0, At, B0); PG8_BAR; PG8_SCHED;
            PG8_STAGE(PG8_SB(1, 1), b3 + hstep, voffB);
            PG8_WAIT_V(6); PG8_BAR; PG8_MMA(1, 1, At, B1); PG8_BAR;
            }
        }
        if constexpr (ALIGN_EPI) { if (wr == 0) PG8_BAR; }
        if constexpr (!Epi::AFTER_DRAIN) { E(acc, cur, wr, wc, fr, fq); S.done(cur); }
        if (!has_next) break;
        if (cur.sub) {
#pragma unroll
        for (int a = 0; a < 2; ++a)
#pragma unroll
            for (int b = 0; b < 2; ++b)
#pragma unroll
                for (int m = 0; m < 4; ++m)
#pragma unroll
                    for (int n = 0; n < 2; ++n) acc[a][b][m][n] = (f32x4){0.f, 0.f, 0.f, 0.f};
        }
        cur = nxt; cA = nA; cB = nB; ++ui;
        if constexpr (ALIGN_EPI) { if (wr == 1) PG8_BAR; }
    }
    PG8_WAIT_V(0);
    if constexpr (!ALIGN_EPI) { if (wr == 0) PG8_BAR; }
    PG8_BAR;
    if constexpr (Epi::AFTER_DRAIN) { E.fused(acc, cur, wr, wc, fr, fq, lds, wid, lane); S.done(cur); }
#undef PG8_SA
#undef PG8_SB
#undef PG8_STAGE
#undef PG8_LDA
#undef PG8_LDB
#undef PG8_MMA
#undef PG8_WAIT_V
#undef PG8_WAIT_L
#undef PG8_BAR
#undef PG8_SCHED
}
}
#define XB_TMO      128
#define XB_XCNT(j)  (256  + 64 * (j))
#define XB_XSUB(j)  (1280 + 64 * (j))
#define XB_XGEN(j)  (2304 + 64 * (j))
#define XB_TOP      3328
#define XB_TOPGEN   3392
#define XCD_BAR_WORDS 3456
#define XB_SPIN_CAP (1u << 18)

__device__ __forceinline__ unsigned xb_ld(unsigned* p)              { return __hip_atomic_load(p, __ATOMIC_RELAXED, __HIP_MEMORY_SCOPE_AGENT); }
__device__ __forceinline__ unsigned xb_add(unsigned* p, unsigned v) { return __hip_atomic_fetch_add(p, v, __ATOMIC_RELAXED, __HIP_MEMORY_SCOPE_AGENT); }
__device__ __forceinline__ unsigned xb_xcc_id() { return (unsigned)__builtin_amdgcn_s_getreg((3 << 11) | 20) & 0xFu; }
#define XB_SPIN(cond, bar) do { unsigned _sp = 0; while (cond) { __builtin_amdgcn_s_sleep(1); \
    if ((++_sp & 255u) == 0u) { if (xb_ld(&(bar)[XB_TMO])) break; if (_sp > XB_SPIN_CAP) { atomicAdd(&(bar)[XB_TMO], 1u); break; } } } } while (0)

struct XcdBarrier {
    unsigned* bar; unsigned x;
    volatile LAS unsigned* st;
};

__device__ __forceinline__ XcdBarrier xcd_barrier_post(unsigned* bar, volatile LAS unsigned* st) {
    XcdBarrier b; b.bar = bar; b.x = xb_xcc_id(); b.st = st;
    if (threadIdx.x == 0) (void)xb_add(&bar[XB_XCNT(b.x)], 1u);
    return b;
}
__device__ __forceinline__ void xcd_barrier_complete(unsigned* bar, unsigned x, unsigned& nloc, unsigned& nx) {
    const unsigned G = gridDim.x * gridDim.y * gridDim.z;
    unsigned sum, cnt, mine, sp = 0u;
    for (;;) {
        sum = 0u; cnt = 0u; mine = 0u;
#pragma unroll
        for (unsigned j = 0; j < 16; ++j) { const unsigned c = xb_ld(&bar[XB_XCNT(j)]); sum += c; cnt += (c > 0u) ? 1u : 0u; mine = (j == x) ? c : mine; }
        if (sum == G) break;
        __builtin_amdgcn_s_sleep(1);
        if ((++sp & 255u) == 0u) { if (xb_ld(&bar[XB_TMO])) break; if (sp > XB_SPIN_CAP) { atomicAdd(&bar[XB_TMO], 1u); break; } }
    }
    nloc = mine > 0u ? mine : 1u; nx = cnt > 0u ? cnt : 1u;
}

__device__ __forceinline__ void xcd_barrier(const XcdBarrier& b) {
    asm volatile("s_waitcnt vmcnt(0)" ::: "memory");
    __syncthreads();
    if (threadIdx.x == 0) {
        unsigned* bar = b.bar;
        __builtin_amdgcn_s_waitcnt(0);
        unsigned nloc = b.st[0], nx = b.st[1];
        if (nloc == 0u) { xcd_barrier_complete(bar, b.x, nloc, nx); b.st[0] = nloc; b.st[1] = nx; }
        const unsigned old = xb_add(&bar[XB_XSUB(b.x)], 1u);
        const unsigned gen = old / nloc;
        if (old + 1u == (gen + 1u) * nloc) {
            __builtin_amdgcn_fence(__ATOMIC_RELEASE, "agent");
            asm volatile("s_waitcnt vmcnt(0)" ::: "memory");
            const unsigned og = xb_add(&bar[XB_TOP], 1u);
            const unsigned tg = og / nx;
            if (og + 1u == (tg + 1u) * nx) xb_add(&bar[XB_TOPGEN], 1u);
            else XB_SPIN(xb_ld(&bar[XB_TOPGEN]) == tg, bar);
            __builtin_amdgcn_fence(__ATOMIC_ACQUIRE, "agent");
            xb_add(&bar[XB_XGEN(b.x)], 1u);
            asm volatile("s_waitcnt vmcnt(0)" ::: "memory");
        } else {
            XB_SPIN(xb_ld(&bar[XB_XGEN(b.x)]) == gen, bar);
            __builtin_amdgcn_fence(__ATOMIC_ACQUIRE, "agent");
            asm volatile("s_waitcnt vmcnt(0)" ::: "memory");
        }
    }
    __syncthreads();
}
using pg8::f32x4; using pg8::Unit;
typedef unsigned u32x4 __attribute__((ext_vector_type(4)));
typedef unsigned u32x2 __attribute__((ext_vector_type(2)));
constexpr int NWAVES = 8, NTHR = 512;
constexpr int LDS_BYTES = 147456;
constexpr int LDSCTL_OFF = LDS_BYTES - 256;
constexpr size_t WS_CTL = 0, CTL_ZERO_BYTES = 64 * 1024;
#define LDS_WAIT() asm volatile("s_waitcnt lgkmcnt(0)" ::: "memory")
typedef float f32x2_t __attribute__((ext_vector_type(2))); typedef __bf16 bf16x2_t __attribute__((ext_vector_type(2)));
DI unsigned cvtpk(float lo, float hi) { f32x2_t v = {lo, hi}; bf16x2_t b = __builtin_convertvector(v, bf16x2_t); return __builtin_bit_cast(unsigned, b); }
#ifndef NT_STORES
#define NT_STORES 0
#endif
DI void st16(void* p, const u32x4& v) { if (NT_STORES) __builtin_nontemporal_store(v, (u32x4*)p); else *(u32x4*)p = v; }
DI void st16f(void* p, const f32x4& v) { if (NT_STORES) __builtin_nontemporal_store(v, (f32x4*)p); else *(f32x4*)p = v; }
DI void st8(void* p, const u32x2& v) { if (NT_STORES) __builtin_nontemporal_store(v, (u32x2*)p); else *(u32x2*)p = v; }
DI float fsig(float x) { return __builtin_amdgcn_rcpf(1.f + __expf(-x)); }
DI u32x4 pack8(const f32x4& a, const f32x4& b) { u32x4 w; w.x = cvtpk(a[0], a[1]); w.y = cvtpk(a[2], a[3]); w.z = cvtpk(b[0], b[1]); w.w = cvtpk(b[2], b[3]); return w; }
DI u32x2 pack4(const f32x4& a) { u32x2 w; w.x = cvtpk(a[0], a[1]); w.y = cvtpk(a[2], a[3]); return w; }
DI void unpack8(const u32x4& w, f32x4& a, f32x4& b) {
    a[0] = __uint_as_float(w.x << 16); a[1] = __uint_as_float(w.x & 0xffff0000u); a[2] = __uint_as_float(w.y << 16); a[3] = __uint_as_float(w.y & 0xffff0000u);
    b[0] = __uint_as_float(w.z << 16); b[1] = __uint_as_float(w.z & 0xffff0000u); b[2] = __uint_as_float(w.w << 16); b[3] = __uint_as_float(w.w & 0xffff0000u); }


DI float shx(float v, int m, int lane) { return __builtin_bit_cast(float, __builtin_amdgcn_ds_bpermute((lane ^ m) << 2, __builtin_bit_cast(int, v))); }
struct EpiInproj {
    static constexpr bool PERM = false, AFTER_DRAIN = false;
    unsigned char* ws; const float *b_gates, *qn_g, *kn_g; bf16* MG;
    static constexpr int TRAIL = 16;
    DI void pad() const { pg8::dummy_stores<16>((unsigned*)(ws + WS_DUMMY)); }
    DI void operator()(const f32x4 (&acc)[2][2][4][2], const Unit& u, int wr, int wc, int fr, int fq) const {
        const int pn = u.pn; const bool lat = u.pm < M_LAT / 256;
        const int row0 = u.pm * 256 + wr * 64 + fr;
        if (pn < 4) {
            const bool isq = pn < 2; bf16* __restrict__ T = (bf16*)(ws + (isq ? WS_QA : WS_KA)); const int tcol = 256 * (pn & 1) + 64 * wc + 4 * fq;
            const float* __restrict__ rope = (const float*)(ws + WS_ROPE);     const float sc = isq ? 0.125f : 1.f;
#pragma unroll
            for (int ai = 0; ai < 2; ++ai)
#pragma unroll
                for (int m = 0; m < 4; ++m) { const int row = row0 + ai * 128 + m * 16; bf16* rp = T + (size_t)row * 512 + tcol;
                    const int t = row & (SEQ - 1);
#pragma unroll
                    for (int bj = 0; bj < 2; ++bj) { f32x4 cs = {1.f, 1.f, 1.f, 1.f}, sn = {0.f, 0.f, 0.f, 0.f};
                        if (lat) { const int pos = bj ? (t & 63) : (t >> 6); cs = *(const f32x4*)(rope + pos * 32 + 4 * fq); sn = *(const f32x4*)(rope + pos * 32 + 16 + 4 * fq); }
                        const f32x4 x1 = acc[ai][bj][m][0], x2 = acc[ai][bj][m][1];
                        const f32x4 o1 = (x1 * cs - x2 * sn) * sc, o2 = (x2 * cs + x1 * sn) * sc;
                        st8(rp + 32 * bj, pack4(o1)); st8(rp + 32 * bj + 16, pack4(o2)); } }
        } else if (pn < 8 || (pn >= 20 && pn < 24)) {
            bf16* T = (bf16*)(ws + (pn < 8 ? WS_VA : WS_VB)); const int tcol = 256 * (pn & 3) + 64 * wc + 8 * fq;
#pragma unroll
            for (int ai = 0; ai < 2; ++ai)
#pragma unroll
                for (int m = 0; m < 4; ++m) { bf16* rp = T + (size_t)(row0 + ai * 128 + m * 16) * 1024 + tcol;
#pragma unroll
                    for (int bj = 0; bj < 2; ++bj) st16(rp + 32 * bj, pack8(acc[ai][bj][m][0], acc[ai][bj][m][1])); }
        } else if (pn < 12) {
            if (!lat) { pad(); return; }
            bf16* T = (bf16*)(ws + WS_OA); const int tcol = 256 * (pn & 3) + 64 * wc + 8 * fq;
#pragma unroll
            for (int ai = 0; ai < 2; ++ai)
#pragma unroll
                for (int m = 0; m < 4; ++m) { bf16* rp = T + (size_t)(row0 + ai * 128 + m * 16) * 1024 + tcol;
#pragma unroll
                    for (int bj = 0; bj < 2; ++bj) { f32x4 a = acc[ai][bj][m][0], b = acc[ai][bj][m][1];
#pragma unroll
                        for (int j = 0; j < 4; ++j) { a[j] = fsig(a[j]); b[j] = fsig(b[j]); }
                        st16(rp + 32 * bj, pack8(a, b)); } }
        } else if (pn < 20) {
            const bool isq = pn < 16; if (isq && !lat) { pad(); return; }
            bf16* T = (bf16*)(ws + (isq ? WS_QB : WS_KB)); const int tcol = 256 * (pn & 3) + 64 * wc + 8 * fq;
            const float* g = isq ? qn_g : kn_g; const float sc = isq ? 0.125f : 1.f;
            f32x4 gv[2][2];
#pragma unroll
            for (int bj = 0; bj < 2; ++bj)
#pragma unroll
                for (int n = 0; n < 2; ++n) gv[bj][n] = *(const f32x4*)(g + 32 * bj + 8 * fq + 4 * n) * sc;
#pragma unroll
            for (int ai = 0; ai < 2; ++ai)
#pragma unroll
                for (int m = 0; m < 4; ++m) { bf16* rp = T + (size_t)(row0 + ai * 128 + m * 16) * 1024 + tcol;
                    float ss = 0.f;
#pragma unroll
                    for (int bj = 0; bj < 2; ++bj)
#pragma unroll
                        for (int n = 0; n < 2; ++n) { const f32x4 v = acc[ai][bj][m][n]; ss += (v[0] * v[0] + v[1] * v[1]) + (v[2] * v[2] + v[3] * v[3]); }
                    ss += shx(ss, 16, 16 * fq + fr); ss += shx(ss, 32, 16 * fq + fr);
                    const float rs = rsqrtf(ss * (1.f / 64.f) + EPS);
#pragma unroll
                    for (int bj = 0; bj < 2; ++bj) st16(rp + 32 * bj, pack8(acc[ai][bj][m][0] * rs * gv[bj][0], acc[ai][bj][m][1] * rs * gv[bj][1])); }
        } else if (pn >= 25) {
            if (!lat) { pad(); return; }
            const int tcol = 256 * (pn - 25) + 64 * wc + 8 * fq;
#pragma unroll
            for (int ai = 0; ai < 2; ++ai)
#pragma unroll
                for (int m = 0; m < 4; ++m) { bf16* rp = MG + (size_t)(row0 + ai * 128 + m * 16) * 2048 + tcol;
#pragma unroll
                    for (int bj = 0; bj < 2; ++bj) { f32x4 a = acc[ai][bj][m][0], b = acc[ai][bj][m][1];
#pragma unroll
                        for (int j = 0; j < 4; ++j) { a[j] = fsig(a[j]); b[j] = fsig(b[j]); }
                        st16(rp + 32 * bj, pack8(a, b)); } }
        } else {
            if (wc != 0) { pad(); return; }
            float* G = (float*)(ws + WS_GATES);
#pragma unroll
            for (int n = 0; n < 2; ++n) { int g0 = 16 * n + 4 * fq; asm volatile("" : "+v"(g0));
                const f32x4 bias = *(const f32x4*)(b_gates + g0); const bool lf = (g0 >> 3) & 1;
#pragma unroll
                for (int ai = 0; ai < 2; ++ai)
#pragma unroll
                    for (int m = 0; m < 4; ++m) { f32x4 v = acc[ai][0][m][n] + bias;
#pragma unroll
                        for (int j = 0; j < 4; ++j) { const float cp = GCAP * tanhf(v[j] * (1.f / GCAP)); v[j] = lf ? logsigmoidf_(cp) : cp; }
                        *(f32x4*)(G + (size_t)(row0 + ai * 128 + m * 16) * 32 + g0) = v; } }
        }
    }
};
struct EpiMG {
    static constexpr bool PERM = false, AFTER_DRAIN = false;
    bf16* MG; int mask;
    DI void operator()(const f32x4 (&acc)[2][2][4][2], const Unit& u, int wr, int wc, int fr, int fq) const {
        if (!((mask >> u.pn) & 1)) return;
        const int row0 = u.pm * 256 + wr * 64 + fr, tcol = 256 * u.pn + 64 * wc + 8 * fq;
#pragma unroll
        for (int ai = 0; ai < 2; ++ai)
#pragma unroll
            for (int m = 0; m < 4; ++m) { bf16* rp = MG + (size_t)(row0 + ai * 128 + m * 16) * 2048 + tcol;
#pragma unroll
                for (int bj = 0; bj < 2; ++bj) { f32x4 a = acc[ai][bj][m][0], b = acc[ai][bj][m][1];
#pragma unroll
                    for (int j = 0; j < 4; ++j) { a[j] = fsig(a[j]); b[j] = fsig(b[j]); }
                    st16(rp + 32 * bj, pack8(a, b)); } }
    }
};
template <bool SECOND> struct EpiMerge {
    static constexpr bool PERM = false, AFTER_DRAIN = false;
    const bf16* MG; bf16* TMP; bf16* T1;
    DI void operator()(const f32x4 (&acc)[2][2][4][2], const Unit& u, int wr, int wc, int fr, int fq) const {
        const int row0 = u.pm * 256 + wr * 64 + fr, tcol = 256 * u.pn + 64 * wc + 8 * fq;
#pragma unroll
        for (int ai = 0; ai < 2; ++ai)
#pragma unroll
            for (int m = 0; m < 4; ++m) { const size_t row = row0 + ai * 128 + m * 16;
#pragma unroll
                for (int bj = 0; bj < 2; ++bj) { const int col = tcol + 32 * bj;
                    f32x4 ga, gb; unpack8(*(const u32x4*)(MG + row * 2048 + (SECOND ? 1024 : 0) + col), ga, gb);
                    bf16* tp = TMP + row * 1024 + col;
                    if (!SECOND) { *(u32x4*)tp = pack8(ga * acc[ai][bj][m][0], gb * acc[ai][bj][m][1]); }
                    else { f32x4 t0, t1; unpack8(*(const u32x4*)tp, t0, t1);
                        st16(T1 + row * 1024 + col, pack8(t0 + ga * acc[ai][bj][m][0], t1 + gb * acc[ai][bj][m][1])); } } }
    }
};
struct MergeOrder {
    pg8::StaticOrder so;
    __device__ __forceinline__ bool next(int i, pg8::Unit2& u) const { Unit t; if (!so.next(i >> 1, t)) return false; u.pm = t.pm; u.pn = t.pn; u.sub = i & 1; return true; }
    __device__ __forceinline__ void a_ready(const pg8::Unit2&) const {}
    __device__ __forceinline__ void done(const pg8::Unit2&) const {}
};
struct EpiMerge2 {
    static constexpr bool PERM = false, AFTER_DRAIN = false;
    const bf16* MG; bf16* T1;
    DI void operator()(f32x4 (&acc)[2][2][4][2], const pg8::Unit2& u, int wr, int wc, int fr, int fq) const {
        const int row0 = u.pm * 256 + wr * 64 + fr, tcol = 256 * u.pn + 64 * wc + 8 * fq;
        const bf16* __restrict__ MG = this->MG; bf16* __restrict__ T1 = this->T1;
#pragma unroll
        for (int ai = 0; ai < 2; ++ai)
#pragma unroll
            for (int m = 0; m < 4; ++m) { const size_t row = row0 + ai * 128 + m * 16;
#pragma unroll
                for (int bj = 0; bj < 2; ++bj) { const int col = tcol + 32 * bj;
                    f32x4 b0, b1; unpack8(*(const u32x4*)(MG + row * 2048 + 1024 + col), b0, b1);
                    if (u.sub == 0) { f32x4 a0, a1; unpack8(*(const u32x4*)(MG + row * 2048 + col), a0, a1);
#pragma unroll
                        for (int j = 0; j < 4; ++j) { acc[ai][bj][m][0][j] *= a0[j] * __builtin_amdgcn_rcpf(b0[j]); acc[ai][bj][m][1][j] *= a1[j] * __builtin_amdgcn_rcpf(b1[j]); }
                    } else st16(T1 + row * 1024 + col, pack8(acc[ai][bj][m][0] * b0, acc[ai][bj][m][1] * b1)); } }
    }
};
struct EpiOut {
    static constexpr bool PERM = false, AFTER_DRAIN = false;
    const float* x; bf16* XN; bf16* XS; float* sumsq; const float* modv; const float* norm2_g;
    static constexpr int TRAIL = 32;
    DI void operator()(const f32x4 (&acc)[2][2][4][2], const Unit& u, int wr, int wc, int fr, int fq) const {
        const int row0 = u.pm * 256 + wr * 64 + fr, tcol = 256 * u.pn + 64 * wc + 8 * fq, b = u.pm >> 5;
        const float* mv = modv + b * 6144;
        f32x4 g1[2][2], s2[2][2];
#pragma unroll
        for (int bj = 0; bj < 2; ++bj)
#pragma unroll
            for (int n = 0; n < 2; ++n) { const int col = tcol + 32 * bj + 4 * n; g1[bj][n] = *(const f32x4*)(mv + 2048 + col); s2[bj][n] = *(const f32x4*)(norm2_g + col) * (*(const f32x4*)(mv + 4096 + col) + 1.f); }
        f32x4 xv[8][4];
#define EPIOUT_LOAD(gi) do { const size_t r_ = row0 + ((gi) >> 2) * 128 + ((gi) & 3) * 16; _Pragma("unroll") for (int bj = 0; bj < 2; ++bj) { const size_t o_ = r_ * 1024 + tcol + 32 * bj; xv[gi][2 * bj] = *(const f32x4*)(x + o_); xv[gi][2 * bj + 1] = *(const f32x4*)(x + o_ + 4); } } while (0)
        EPIOUT_LOAD(0); EPIOUT_LOAD(1);
#pragma unroll
        for (int gi = 0; gi < 8; ++gi) { const int ai = gi >> 2, m = gi & 3; const size_t row = row0 + ai * 128 + m * 16; float ss = 0.f;
            if (gi + 2 < 8) EPIOUT_LOAD(gi + 2);
#pragma unroll
            for (int bj = 0; bj < 2; ++bj) { const size_t o = row * 1024 + tcol + 32 * bj;
                const f32x4 x0 = xv[gi][2 * bj] + g1[bj][0] * acc[ai][bj][m][0], x1 = xv[gi][2 * bj + 1] + g1[bj][1] * acc[ai][bj][m][1];
                st16(XN + o, pack8(x0, x1));
                st16(XS + o, pack8(x0 * s2[bj][0], x1 * s2[bj][1]));
                ss += (x0[0] * x0[0] + x0[1] * x0[1]) + (x0[2] * x0[2] + x0[3] * x0[3]) + (x1[0] * x1[0] + x1[1] * x1[1]) + (x1[2] * x1[2] + x1[3] * x1[3]); }
            ss += shx(ss, 16, 16 * fq + fr); ss += shx(ss, 32, 16 * fq + fr);
            if (fq == 0) atomicAdd(sumsq + row, ss); }
#undef EPIOUT_LOAD
    }
};
struct EpiFfn1 {
    static constexpr bool PERM = false, AFTER_DRAIN = false;
    bf16* HFF; const float* sumsq; const float* bgu;
    static constexpr int TRAIL = 16;
    DI void operator()(const f32x4 (&acc)[2][2][4][2], const Unit& u, int wr, int wc, int fr, int fq) const {
        const int row0 = u.pm * 256 + wr * 64 + fr, hcol = 128 * u.pn + 32 * wc + 8 * fq, b = u.pm >> 5;
        const float* bg = bgu + (size_t)b * 2 * DFF + hcol; const float* bu = bg + DFF;
        const f32x4 bg0 = *(const f32x4*)bg, bg1 = *(const f32x4*)(bg + 4), bu0 = *(const f32x4*)bu, bu1 = *(const f32x4*)(bu + 4);
        float rsv[8];
#pragma unroll
        for (int gi = 0; gi < 8; ++gi) rsv[gi] = rsqrtf(sumsq[row0 + (gi >> 2) * 128 + (gi & 3) * 16] * (1.f / DM) + EPS);
#pragma unroll
        for (int ai = 0; ai < 2; ++ai)
#pragma unroll
            for (int m = 0; m < 4; ++m) { const size_t row = row0 + ai * 128 + m * 16;
                const float rs = rsv[ai * 4 + m];
                f32x4 g0 = acc[ai][0][m][0] * rs + bg0, g1 = acc[ai][0][m][1] * rs + bg1; const f32x4 u0 = acc[ai][1][m][0] * rs + bu0, u1 = acc[ai][1][m][1] * rs + bu1;
#pragma unroll
                for (int j = 0; j < 4; ++j) { g0[j] = g0[j] * fsig(g0[j]) * u0[j]; g1[j] = g1[j] * fsig(g1[j]) * u1[j]; }
                st16(HFF + row * DFF + hcol, pack8(g0, g1)); }
    }
};
struct EpiFfn2 {
    static constexpr bool PERM = false, AFTER_DRAIN = false;
    float* out; const bf16* XN; const float* modv;
    static constexpr int TRAIL = 32;
    DI void operator()(const f32x4 (&acc)[2][2][4][2], const Unit& u, int wr, int wc, int fr, int fq) const {
        const int row0 = u.pm * 256 + wr * 64 + fr, tcol = 256 * u.pn + 64 * wc + 8 * fq, b = u.pm >> 5;
        const float* mv = modv + b * 6144 + 5120;
        f32x4 g2[2][2];
#pragma unroll
        for (int bj = 0; bj < 2; ++bj)
#pragma unroll
            for (int n = 0; n < 2; ++n) g2[bj][n] = *(const f32x4*)(mv + tcol + 32 * bj + 4 * n);
        u32x4 xv[8][2];
#pragma unroll
        for (int gi = 0; gi < 8; ++gi)
#pragma unroll
            for (int bj = 0; bj < 2; ++bj) xv[gi][bj] = *(const u32x4*)(XN + (size_t)(row0 + (gi >> 2) * 128 + (gi & 3) * 16) * 1024 + tcol + 32 * bj);
#pragma unroll
        for (int gi = 0; gi < 8; ++gi) { const int ai = gi >> 2, m = gi & 3; const size_t row = row0 + ai * 128 + m * 16;
#pragma unroll
            for (int bj = 0; bj < 2; ++bj) { float* o = out + row * 1024 + tcol + 32 * bj; f32x4 x0, x1; unpack8(xv[gi][bj], x0, x1);
                st16f(o, x0 + g2[bj][0] * acc[ai][bj][m][0]); st16f(o + 4, x1 + g2[bj][1] * acc[ai][bj][m][1]); } }
    }
};

#ifndef INPROJ_WGM
#define INPROJ_WGM 4
#endif
struct InprojOrder {
    int G, c;
    __device__ __forceinline__ bool next(int i, Unit& u) const {
        const int L = i * G + c; constexpr int nM = M_LAT / 256, nN = 33, nwg = nM * nN;
        if (L < nwg) { int wgid = L; { const int q = nwg / pg8::NXCD, r = nwg % pg8::NXCD, xcd = wgid % pg8::NXCD, off = wgid / pg8::NXCD; wgid = (xcd < r ? xcd * (q + 1) : r * (q + 1) + (xcd - r) * q) + off; }
            const int nig = INPROJ_WGM * nN, gid = wgid / nig, fm = gid * INPROJ_WGM; u.pm = fm + ((wgid % nig) % INPROJ_WGM); u.pn = (wgid % nig) / INPROJ_WGM; return true; }
        const int r = L - nwg; if (r >= 4 * 17) return false;
        const int t = r % 17; u.pm = nM + r / 17; u.pn = t < 8 ? t : t + 8; return true;
    }
    __device__ __forceinline__ void a_ready(const Unit&) const {}
    __device__ __forceinline__ void done(const Unit&) const {}
};

DI void conv_item(const float* W, int ldw, int L0, bool zero, bool perm8, bf16* dst, int K, int k0, LAS float* scr, int lane) {
    float wv[32];
#pragma unroll
    for (int i = 0; i < 32; ++i) { const int kk = 2 * i + (lane >> 5); wv[i] = zero ? 0.f : W[(size_t)(k0 + kk) * ldw + L0 + (lane & 31)]; }
#pragma unroll
    for (int i = 0; i < 32; ++i) { const int kk = 2 * i + (lane >> 5); scr[kk * 33 + (lane & 31)] = wv[i]; }
    LDS_WAIT(); asm volatile("" ::: "memory");
    const int c = lane & 7;
#pragma unroll
    for (int jj = 0; jj < 4; ++jj) { const int i = (lane >> 3) + 8 * jj; const int src = perm8 ? (8 * ((i >> 2) & 3) + 4 * (i >> 4) + (i & 3)) : i;
        const LAS float* s = scr + (8 * c) * 33 + src;
        u32x4 o; o.x = cvtpk(s[0], s[33]); o.y = cvtpk(s[2 * 33], s[3 * 33]); o.z = cvtpk(s[4 * 33], s[5 * 33]); o.w = cvtpk(s[6 * 33], s[7 * 33]);
        *(u32x4*)(dst + (size_t)i * K + k0 + 8 * c) = o; }
    LDS_WAIT(); asm volatile("" ::: "memory");
}
DI int inproj_src_col(int pn) {
    return pn < 2 ? C_QA + 256 * pn : pn < 4 ? C_KA + 256 * (pn - 2) : pn < 8 ? C_VA + 256 * (pn - 4) : pn < 12 ? C_OA + 256 * (pn - 8) : pn < 16 ? C_QB + 256 * (pn - 12)
         : pn < 20 ? C_KB + 256 * (pn - 16) : pn < 24 ? C_VB + 256 * (pn - 20) : pn == 24 ? C_G : C_MG + 256 * (pn - 25);
}
#ifndef TAIL_CONV_LATE
#define TAIL_CONV_LATE 1
#endif
constexpr int INPROJ_UNITS = (M_LAT / 256) * 33 + 4 * 17;
constexpr int CI_WIN = 33 * 8 * 16, CI_SQ = 4 * 8 * 16, CI_GU = 22 * 8 * 16, CI_WD = 4 * 8 * 44, CI_TOTAL = CI_WIN + 3 * CI_SQ + CI_GU + CI_WD;
DI void phase_convert(const P& p, LAS unsigned char* lds, int gw, int ngw, int wave, int lane, int it_lo, int it_hi) {
    LAS float* scr = (LAS float*)(lds + wave * 16384);
    for (int it = it_lo + gw; it < it_hi; it += ngw) {
        int r = it;
        if (r < CI_WIN) { const int kb = r / 264, rem = r % 264, g8 = rem & 7, pn = rem >> 3, bj = g8 >> 2, wc = g8 & 3;
            const bool zero = pn == 24 && g8 != 0; const int L0 = pn == 24 ? C_G : inproj_src_col(pn) + 64 * wc + 32 * bj;
            conv_item(p.w_in, DIN, L0, zero, pn >= 4 && pn != 24, (bf16*)(p.ws + WS_WIN) + (size_t)(pn * 256 + 128 * bj + 32 * wc) * 1024, 1024, kb * 64, scr, lane); continue; }
        r -= CI_WIN;
        if (r < 3 * CI_SQ) { const int which = r / CI_SQ; r -= which * CI_SQ; const int kb = r >> 5, g8 = r & 7, pn = (r >> 3) & 3, bj = g8 >> 2, wc = g8 & 3;
            const float* W = which == 0 ? p.w_a : which == 1 ? p.w_b : p.w_o; bf16* D = (bf16*)(p.ws + (which == 0 ? WS_WA : which == 1 ? WS_WB : WS_WO));
            conv_item(W, 1024, 256 * pn + 64 * wc + 32 * bj, false, true, D + (size_t)(pn * 256 + 128 * bj + 32 * wc) * 1024, 1024, kb * 64, scr, lane); continue; }
        r -= 3 * CI_SQ;
        if (r < CI_GU) { const int kb = r / 176, rem = r % 176, g8 = rem & 7, pn = rem >> 3, bj = g8 >> 2, wc = g8 & 3;
            conv_item(bj ? p.w_fu : p.w_fg, DFF, 128 * pn + 32 * wc, false, true, (bf16*)(p.ws + WS_WGU) + (size_t)(pn * 256 + 128 * bj + 32 * wc) * 1024, 1024, kb * 64, scr, lane); continue; }
        r -= CI_GU;
        { const int kb = r >> 5, g = r & 31, g8 = g & 7, pn = g >> 3, bj = g8 >> 2, wc = g8 & 3;
            conv_item(p.w_fd, 1024, 256 * pn + 64 * wc + 32 * bj, false, true, (bf16*)(p.ws + WS_WD) + (size_t)(pn * 256 + 128 * bj + 32 * wc) * DFF, DFF, kb * 64, scr, lane); }
    }
}
template <int R> DI void gemv_task(const float* W, int ldw, int col0, const LAS float* A, LAS float* red, float* out, int ldo, const float* bias, int tid) {
    const int col = tid & 31, kg = tid >> 5;
    float acc[R];
#pragma unroll
    for (int r = 0; r < R; ++r) acc[r] = 0.f;
#pragma unroll 32
    for (int i = 0; i < 64; ++i) { const int k = kg + 16 * i; const float w = W[(size_t)k * ldw + col0 + col];
#pragma unroll
        for (int r = 0; r < R; ++r) acc[r] += A[r * 1024 + k] * w; }
#pragma unroll
    for (int r = 0; r < R; ++r) red[(kg * R + r) * 32 + col] = acc[r];
    __syncthreads();
    if (tid < R * 32) { const int r = tid >> 5, c = tid & 31; float s = bias ? bias[col0 + c] : 0.f;
#pragma unroll
        for (int g = 0; g < 16; ++g) s += red[(g * R + r) * 32 + c];
        out[(size_t)r * ldo + col0 + c] = s; }
    __syncthreads();
}
DI void phase_bgu(const P& p, int gw, int ngw, int lane) {
    const float* modv = (const float*)(p.ws + WS_MODV); const bf16* W = (const bf16*)(p.ws + WS_WGU);
    for (int np = gw; np < 2 * DFF; np += ngw) {
        const int pn = np >> 8, bj = (np >> 7) & 1, wc = (np >> 5) & 3, i = np & 31, hid = 128 * pn + 32 * wc + 8 * ((i >> 2) & 3) + 4 * (i >> 4) + (i & 3);
        const u32x4 w0 = *(const u32x4*)(W + (size_t)np * 1024 + 8 * lane), w1 = *(const u32x4*)(W + (size_t)np * 1024 + 512 + 8 * lane);
        f32x4 a0, a1, c0, c1; unpack8(w0, a0, a1); unpack8(w1, c0, c1);
#pragma unroll
        for (int b = 0; b < 4; ++b) { const float* sh = modv + b * 6144 + 3072;
            const f32x4 s0 = *(const f32x4*)(sh + 8 * lane), s1 = *(const f32x4*)(sh + 8 * lane + 4), s2 = *(const f32x4*)(sh + 512 + 8 * lane), s3 = *(const f32x4*)(sh + 516 + 8 * lane);
            const f32x4 pr = a0 * s0 + a1 * s1 + c0 * s2 + c1 * s3; float d = (pr[0] + pr[1]) + (pr[2] + pr[3]);
#pragma unroll
            for (int o = 1; o < 64; o <<= 1) d += __shfl_xor(d, o);
            if (lane == 0) ((float*)(p.ws + WS_BGU))[(size_t)(b * 2 + bj) * DFF + hid] = d; }
    }
}

typedef short bf16x8 __attribute__((ext_vector_type(8)));
typedef short s16x4 __attribute__((ext_vector_type(4)));
typedef short v4i16_t __attribute__((ext_vector_type(4)));
DI f32x4 mfma16(bf16x8 a, bf16x8 b, f32x4 c) { return __builtin_amdgcn_mfma_f32_16x16x32_bf16(a, b, c, 0, 0, 0); }
DI s16x4 tr4(const LAS unsigned char* p) { return __builtin_bit_cast(s16x4, __builtin_amdgcn_ds_read_tr16_b64_v4i16((LAS v4i16_t*)p)); }
DI bf16x8 cat8(s16x4 a, s16x4 b) { return __builtin_shufflevector(a, b, 0, 1, 2, 3, 4, 5, 6, 7); }
DI bf16x8 ldsb128(const LAS unsigned char* p) { return *(const LAS bf16x8*)p; }
DI bf16x8 packf8(const f32x4& a, const f32x4& b) { return __builtin_bit_cast(bf16x8, pack8(a, b)); }
DI bf16x8 tr_frag(const LAS unsigned char* img, int RS, int s, int c0, int lane) {
    const int g = lane >> 4, i = lane & 15;
    const LAS unsigned char* p = img + (32 * s + 4 * g + (i >> 2)) * RS + (c0 + 4 * (i & 3)) * 2;
    return cat8(tr4(p), tr4(p + 16 * RS));
}
DI float wave_incl_add(float v, int lane) {
#pragma unroll
    for (int o = 1; o < 64; o <<= 1) { const float t = __shfl_up(v, o); if (lane >= o) v += t; }
    return v; }
DI float wave_incl_max(float v, int lane) {
#pragma unroll
    for (int o = 1; o < 64; o <<= 1) { const float t = __shfl_up(v, o); if (lane >= o) v = fmaxf(v, t); }
    return v; }
DI float wave_incl_max_rev(float v, int lane) {
#pragma unroll
    for (int o = 1; o < 64; o <<= 1) { const float t = __shfl_down(v, o); if (lane + o < 64) v = fmaxf(v, t); }
    return v; }
DI float wave_max(float v) {
#pragma unroll
    for (int o = 1; o < 64; o <<= 1) v = fmaxf(v, __shfl_xor(v, o));
    return v; }
DI int chunk_row0(int b, int c) { return c < 2 ? M_LAT + b * CTX + 128 * c : b * SEQ + 128 * (c - 2); }

#ifndef NA_BATCH
#define NA_BATCH 8
#endif
constexpr int NA_RS = 144, NA_KOFF = 0, NA_VOFF = 480 * NA_RS, NA_RPB = 2 * 480 * NA_RS;
DI void na_keys(const LAS unsigned char* lds, int kbase, int q, int g, const bf16x8& bq0, const bf16x8& bq1, f32x4& s0, f32x4& s1) {
    const LAS unsigned char* kp = lds + NA_KOFF + (kbase + q) * NA_RS + 16 * g;
    s0 = mfma16(ldsb128(kp), bq0, (f32x4){0.f, 0.f, 0.f, 0.f}); s0 = mfma16(ldsb128(kp + 64), bq1, s0);
    s1 = mfma16(ldsb128(kp + 16 * NA_RS), bq0, (f32x4){0.f, 0.f, 0.f, 0.f}); s1 = mfma16(ldsb128(kp + 16 * NA_RS + 64), bq1, s1);
}
DI void na_pv(const LAS unsigned char* lds, int kbase, int lane, const bf16x8& pf, f32x4 (&o)[4]) {
    const int g = lane >> 4, i = lane & 15;
    const LAS unsigned char* vp = lds + NA_VOFF + (kbase + 4 * g + (i >> 2)) * NA_RS + 8 * (i & 3);
#pragma unroll
    for (int dt = 0; dt < 4; ++dt) o[dt] = mfma16(cat8(tr4(vp + 32 * dt), tr4(vp + 32 * dt + 16 * NA_RS)), pf, o[dt]);
}
struct NaWin { u32x4 k[8], v[8]; };
struct NaCtx { u32x4 k[4], v[4]; };
DI void na_issue_win(const P& p, NaWin& r, int u, int tid) {
    asm volatile("" : "+v"(tid));
    const int cb = u & 3, rb = (u >> 2) & 15, h = (u >> 6) & 15, b = u >> 10;
    const int kr0 = min(max(8 * rb - 4, 0), GROWS - 15), kc0 = cb == 0 ? 0 : (cb == 1 ? 8 : (cb == 2 ? 24 : 32));
    const bf16* KB = (const bf16*)(p.ws + WS_KB); const bf16* VB = (const bf16*)(p.ws + WS_VB);
#pragma unroll
    for (int it = 0; it < 8; ++it) { const int c = tid + it * NTHR;
        if (c < 480 * 8) { const int kk = c >> 3, ch = c & 7; const int tok = (kr0 + (kk >> 5)) * GW + kc0 + (kk & 31);
            const size_t go = (size_t)(b * SEQ + tok) * 1024 + h * 64 + ch * 8; r.k[it] = *(const u32x4*)(KB + go); r.v[it] = *(const u32x4*)(VB + go); } }
}
DI void na_commit_win(const NaWin& r, LAS unsigned char* lds, int tid) {
    asm volatile("" : "+v"(tid));
#pragma unroll
    for (int it = 0; it < 8; ++it) { const int c = tid + it * NTHR;
        if (c < 480 * 8) { const int kk = c >> 3, ch = c & 7; *(LAS u32x4*)(lds + NA_KOFF + kk * NA_RS + ch * 16) = r.k[it]; *(LAS u32x4*)(lds + NA_VOFF + kk * NA_RS + ch * 16) = r.v[it]; } }
}
DI void na_commit_ctx(const NaCtx& r, LAS unsigned char* lds, int tid) {
    asm volatile("" : "+v"(tid));
#pragma unroll
    for (int it = 0; it < 4; ++it) { const int c = tid + it * NTHR; const int kk = c >> 3, ch = c & 7;
        *(LAS u32x4*)(lds + NA_KOFF + kk * NA_RS + ch * 16) = r.k[it]; *(LAS u32x4*)(lds + NA_VOFF + kk * NA_RS + ch * 16) = r.v[it]; }
}
DI void na_phase(const P& p, LAS unsigned char* lds, int u0, int tid, int wave, int lane) {
    const int h = (u0 >> 6) & 15, b = u0 >> 10;
#define NA_UNIT(iu_) ((u0 & ~63) + (iu_) * 4 + ((u0 >> 4) & 3))
    bf16* QB = (bf16*)(p.ws + WS_QB); const bf16* KB = (const bf16*)(p.ws + WS_KB); const bf16* VB = (const bf16*)(p.ws + WS_VB);
    LAS float* rpbl = (LAS float*)(lds + NA_RPB);
    for (int i = tid; i < 465; i += NTHR) rpbl[i] = p.rpb[h * 465 + i] * 1.44269504f;
    NaCtx cx;
    const int q = lane & 15, g = lane >> 4;
    NaWin win; na_issue_win(p, win, NA_UNIT(0), tid);
    bf16x8 bq0, bq1;
    { const int uf = NA_UNIT(0), cb = uf & 3, rb = (uf >> 2) & 15; const size_t qoff = (size_t)(b * SEQ + (8 * rb + wave) * GW + 16 * cb + q) * 1024 + h * 64;
      bq0 = *(const bf16x8*)(QB + qoff + 8 * g); bq1 = *(const bf16x8*)(QB + qoff + 32 + 8 * g); }
#if defined(NA_PROF)
    volatile LAS unsigned long long* nacc = (volatile LAS unsigned long long*)(lds + NA_RPB + 2048);
    if (tid == 0) { nacc[0] = 0; nacc[1] = 0; nacc[2] = 0; nacc[3] = 0; nacc[4] = 0; }
    unsigned long long tprev = __builtin_amdgcn_s_memrealtime();
#define NAP(k) do { if (tid == 0) { const unsigned long long tn = __builtin_amdgcn_s_memrealtime(); nacc[k] += tn - tprev; tprev = tn; } } while (0)
#else
#define NAP(k) do {} while (0)
#endif
    for (int iu = 0; iu < 16; ++iu) {
        const int u = NA_UNIT(iu), cb = u & 3, rb = (u >> 2) & 15;
        const int kr0 = min(max(8 * rb - 4, 0), GROWS - 15), kc0 = cb == 0 ? 0 : (cb == 1 ? 8 : (cb == 2 ? 24 : 32));
        const int r = 8 * rb + wave, qc = 16 * cb + q;
        const size_t qoff = (size_t)(b * SEQ + r * GW + qc) * 1024 + h * 64;
        na_commit_win(win, lds, tid);
        __syncthreads();
        NAP(0);
        { int tq = tid; asm volatile("" : "+v"(tq));
#pragma unroll
        for (int it = 0; it < 4; ++it) { const int c = tq + it * NTHR; const int kk = c >> 3, ch = c & 7; const size_t go = (size_t)(M_LAT + b * CTX + kk) * 1024 + h * 64 + ch * 8;
            cx.k[it] = *(const u32x4*)(KB + go); cx.v[it] = *(const u32x4*)(VB + go); } }
        asm volatile("" ::: "memory");
        f32x4 o[4];
#pragma unroll
        for (int dt = 0; dt < 4; ++dt) o[dt] = (f32x4){0.f, 0.f, 0.f, 0.f};
        float lsum = 0.f;
        const int wr0 = min(max(r - 4, 0), GROWS - 8), rel0 = wr0 - kr0, wc0 = min(max(qc - 8, 0), GW - 16);
        int boff[8]; bool bval[8];
#pragma unroll
        for (int e = 0; e < 8; ++e) { const int kc = kc0 + 4 * g + (e & 3) + 16 * (e >> 2); bval[e] = kc >= wc0 && kc < wc0 + 16; boff[e] = min(max(kc - qc + 15, 0), 30); }
        const LAS float* brow = rpbl + ((kr0 + rel0) - r + 7) * 31;
        {
          for (int hb = 0; hb < 8; hb += NA_BATCH) {
            f32x4 sw[NA_BATCH][2]; bf16x8 pf[NA_BATCH];
#pragma unroll
            for (int i = 0; i < NA_BATCH; ++i) na_keys(lds, (rel0 + hb + i) * 32, q, g, bq0, bq1, sw[i][0], sw[i][1]);
#pragma unroll
            for (int i = 0; i < NA_BATCH; ++i) { f32x4 p0, p1;
#pragma unroll
                for (int e = 0; e < 4; ++e) {
                    const float xa = bval[e] ? fmaf(sw[i][0][e], 1.44269504f, brow[(hb + i) * 31 + boff[e]]) : -1000.f, xb = bval[4 + e] ? fmaf(sw[i][1][e], 1.44269504f, brow[(hb + i) * 31 + boff[4 + e]]) : -1000.f;
                    p0[e] = __builtin_amdgcn_exp2f(xa); p1[e] = __builtin_amdgcn_exp2f(xb); }
                lsum += (p0[0] + p0[1]) + (p0[2] + p0[3]) + (p1[0] + p1[1]) + (p1[2] + p1[3]);
                pf[i] = packf8(p0, p1); }
#pragma unroll
            for (int i = 0; i < NA_BATCH; ++i) na_pv(lds, (rel0 + hb + i) * 32, lane, pf[i], o);
          }
        }
        __syncthreads();
        NAP(1);
        na_commit_ctx(cx, lds, tid);
        __syncthreads();
        NAP(2);
        bf16x8 nq0 = bq0, nq1 = bq1;
        if (iu < 15) { const int un = NA_UNIT(iu + 1); na_issue_win(p, win, un, tid);
            const int cbn = un & 3, rbn = (un >> 2) & 15; const size_t qn = (size_t)(b * SEQ + (8 * rbn + wave) * GW + 16 * cbn + q) * 1024 + h * 64;
            nq0 = *(const bf16x8*)(QB + qn + 8 * g); nq1 = *(const bf16x8*)(QB + qn + 32 + 8 * g); }
        asm volatile("" ::: "memory");
        for (int hb = 0; hb < 8; hb += NA_BATCH) {   f32x4 sw[NA_BATCH][2]; bf16x8 pf[NA_BATCH];
#pragma unroll
            for (int i = 0; i < NA_BATCH; ++i) na_keys(lds, 32 * (hb + i), q, g, bq0, bq1, sw[i][0], sw[i][1]);
#pragma unroll
            for (int i = 0; i < NA_BATCH; ++i) { f32x4 p0, p1;
#pragma unroll
                for (int e = 0; e < 4; ++e) { p0[e] = __builtin_amdgcn_exp2f(sw[i][0][e] * 1.44269504f); p1[e] = __builtin_amdgcn_exp2f(sw[i][1][e] * 1.44269504f); }
                lsum += (p0[0] + p0[1]) + (p0[2] + p0[3]) + (p1[0] + p1[1]) + (p1[2] + p1[3]);
                pf[i] = packf8(p0, p1); }
#pragma unroll
            for (int i = 0; i < NA_BATCH; ++i) na_pv(lds, 32 * (hb + i), lane, pf[i], o);
        }
        lsum += __shfl_xor(lsum, 16); lsum += __shfl_xor(lsum, 32);
        const float inv = 1.f / lsum;
#pragma unroll
        for (int dt = 0; dt < 4; ++dt) *(u32x2*)(QB + qoff + 16 * dt + 4 * g) = pack4(o[dt] * inv);
        bq0 = nq0; bq1 = nq1;
        __syncthreads();
        NAP(3);
    }
}

constexpr int MA_RS = 288, MA_V = 0, MA_KW = 128 * MA_RS, MA_G = 2 * 128 * MA_RS, MA_WF = MA_G + 2048, MA_WB = MA_WF + 512;
struct MaPre { u32x4 k[2], v[4]; float gate; };
DI void ma_issue(const P& p, MaPre& r, int u, int tid) {
    const int c = u % NCH, h = (u / NCH) & 7, b = u / (NCH * NHA), row0 = chunk_row0(b, c);
    const bf16* KA = (const bf16*)(p.ws + WS_KA); const bf16* VA = (const bf16*)(p.ws + WS_VA);
    r.gate = ((const float*)(p.ws + WS_GATES))[(size_t)(row0 + (tid & 127)) * 32 + (tid >> 7) * 8 + h];
#pragma unroll
    for (int i = 0; i < 2; ++i) { const int ci = tid + i * NTHR, tok = ci >> 3, ch = ci & 7; r.k[i] = *(const u32x4*)(KA + (size_t)(row0 + tok) * 512 + h * 64 + ch * 8); }
#pragma unroll
    for (int i = 0; i < 4; ++i) { const int ci = tid + i * NTHR, tok = ci >> 4, ch = ci & 15; r.v[i] = *(const u32x4*)(VA + (size_t)(row0 + tok) * 1024 + h * 128 + ch * 8); }
}
DI void ma_phase(const P& p, LAS unsigned char* lds, int bx, int G, int tid, int wave, int lane) {
    constexpr int NU_ = NB * NHA * NCH;
    LAS float* gl = (LAS float*)(lds + MA_G); LAS float* wf = (LAS float*)(lds + MA_WF); LAS float* wb = (LAS float*)(lds + MA_WB);
    int u = bx; MaPre r;
    if (u < NU_) ma_issue(p, r, u, tid);
    for (; u < NU_; u += G) {
        const int c = u % NCH, h = (u / NCH) & 7, b = u / (NCH * NHA);
        gl[(tid >> 7) * 128 + (tid & 127)] = r.gate;
#pragma unroll
        for (int i = 0; i < 4; ++i) { const int ci = tid + i * NTHR, tok = ci >> 4, ch = ci & 15; *(LAS u32x4*)(lds + MA_V + tok * MA_RS + ch * 16) = r.v[i]; }
        const u32x4 kc0 = r.k[0], kc1 = r.k[1];
        __syncthreads();
        if (u + G < NU_) ma_issue(p, r, u + G, tid);
        asm volatile("" ::: "memory");
    if (wave < 2) {
        const int dir = wave; const LAS float* ig = gl + (2 * dir) * 128; const LAS float* lf = gl + (2 * dir + 1) * 128;
        const float lf0 = lf[2 * lane], lf1 = lf[2 * lane + 1], ig0 = ig[2 * lane], ig1 = ig[2 * lane + 1];
        const float p1 = lf0 + lf1, incl = wave_incl_add(p1, lane), excl = incl - p1, total = __shfl(incl, 63);
        float ge0, ge1;
        if (dir == 0) { ge0 = total - (excl + lf0) + ig0; ge1 = total - incl + ig1; }
        else { ge0 = excl + ig0; ge1 = excl + lf0 + ig1; }
        const float mx = wave_max(fmaxf(ge0, ge1));
        LAS float* w = dir ? wb : wf; w[2 * lane] = __expf(ge0 - mx); w[2 * lane + 1] = __expf(ge1 - mx);
        if (lane == 0) { float* ch = (float*)(p.ws + WS_CH) + ((((size_t)b * NHA + h) * 2 + dir) * NCH + c) * 2; ch[0] = total; ch[1] = mx; }
        if (c >= 2) {
            float b0, b1, e0, e1, x0, x1;
            if (dir == 0) { b0 = excl + lf0; b1 = incl; e0 = ig0 - b0; e1 = ig1 - b1; const float pm = wave_incl_max(fmaxf(e0, e1), lane); float pv = __shfl_up(pm, 1); if (lane == 0) pv = -3.0e38f; x0 = fmaxf(pv, e0); x1 = pm; }
            else { b0 = total - excl; b1 = total - (excl + lf0); e0 = ig0 - b0; e1 = ig1 - b1; const float sm = wave_incl_max_rev(fmaxf(e0, e1), lane); float nx = __shfl_down(sm, 1); if (lane == 63) nx = -3.0e38f; x0 = sm; x1 = fmaxf(nx, e1); }
            float* sc = (float*)(p.ws + WS_SC) + ((((size_t)b * NHA + h) * 64 + (c - 2)) * 6 + 3 * dir) * 128 + 2 * lane;
            typedef float f32x2v __attribute__((ext_vector_type(2)));
            *(f32x2v*)sc = (f32x2v){e0, e1}; *(f32x2v*)(sc + 128) = (f32x2v){x0, x1}; *(f32x2v*)(sc + 256) = (f32x2v){b0, b1}; }
    }
        __syncthreads();
#pragma unroll
        for (int i = 0; i < 2; ++i) { const int ci = tid + i * NTHR, tok = ci >> 3, ch = ci & 7; const u32x4 kv = i ? kc1 : kc0;
            f32x4 a, bb; unpack8(kv, a, bb); const float f = wf[tok], rr = wb[tok];
            *(LAS u32x4*)(lds + MA_KW + tok * MA_RS + ch * 16) = pack8(a * f, bb * f); *(LAS u32x4*)(lds + MA_KW + tok * MA_RS + 128 + ch * 16) = pack8(a * rr, bb * rr); }
        __syncthreads();
    {
        bf16x8 a[4];
#pragma unroll
        for (int s = 0; s < 4; ++s) a[s] = tr_frag(lds + MA_KW, MA_RS, s, 16 * wave, lane);
        const int dir = wave >> 2, g = lane >> 4;
        bf16* UC = (bf16*)(p.ws + WS_UC) + ((((size_t)dir * NB + b) * NHA + h) * NCH + c) * 8192 + 16 * (wave & 3) + 4 * g;
#pragma unroll
        for (int nt = 0; nt < 8; ++nt) { f32x4 acc = {0.f, 0.f, 0.f, 0.f};
#pragma unroll
            for (int s = 0; s < 4; ++s) acc = mfma16(a[s], tr_frag(lds + MA_V, MA_RS, s, 16 * nt, lane), acc);
            *(u32x2*)(UC + (16 * nt + (lane & 15)) * 64) = pack4(acc); }
    }
    if (tid < 128) { float s = 0.f; const LAS unsigned char* kw = lds + MA_KW + tid * 2;
        for (int i = 0; i < 128; ++i) s += bf2f(*(const LAS bf16*)(kw + i * MA_RS));
        ((float*)(p.ws + WS_NU))[((((size_t)b * NHA + h) * 2 + (tid >> 6)) * NCH + c) * 64 + (tid & 63)] = s; }
        __syncthreads();
    }
}

DI int scan_chunk(int dir, int i) { return dir == 0 ? i : (i < 2 ? 1 - i : NCH + 1 - i); }
DI void mB_unit(const P& p, int blk, int tid) {
    const int bhd = blk >> 2, dir = bhd & 1, bh = bhd >> 1, b = bh >> 3, h = bh & 7;
    const float* CH = (const float*)(p.ws + WS_CH) + (size_t)bhd * NCH * 2;
    bf16* UC = (bf16*)(p.ws + WS_UC) + (((size_t)dir * NB + b) * NHA + h) * NCH * 8192 + (blk & 3) * 2048 + tid * 4;
    float* NU = (float*)(p.ws + WS_NU) + (size_t)bhd * NCH * 64 + tid * 4; float* MIN = (float*)(p.ws + WS_MIN) + (size_t)bhd * NCH;
    const bool do_n = (blk & 3) == 0 && tid < 16, do_m = (blk & 3) == 0 && tid == 0;
    float m = 0.f; f32x4 s = {0.f, 0.f, 0.f, 0.f}, ns = {0.f, 0.f, 0.f, 0.f};
    for (int bt = 0; bt < 6; ++bt) {
        u32x2 uv[11]; f32x4 nv[11]; float blv[11], mlv[11];
#pragma unroll
        for (int k = 0; k < 11; ++k) { const int c = scan_chunk(dir, bt * 11 + k); uv[k] = *(const u32x2*)(UC + (size_t)c * 8192); blv[k] = CH[c * 2]; mlv[k] = CH[c * 2 + 1]; nv[k] = do_n ? *(const f32x4*)(NU + c * 64) : (f32x4){0.f, 0.f, 0.f, 0.f}; }
#pragma unroll
        for (int k = 0; k < 11; ++k) { const int c = scan_chunk(dir, bt * 11 + k);
            const float bl = blv[k], ml = mlv[k], mn = fmaxf(bl + m, ml), dec = __expf(bl + m - mn), scl = __expf(ml - mn);
            f32x4 uf; uf[0] = __uint_as_float(uv[k].x << 16); uf[1] = __uint_as_float(uv[k].x & 0xffff0000u); uf[2] = __uint_as_float(uv[k].y << 16); uf[3] = __uint_as_float(uv[k].y & 0xffff0000u);
            *(u32x2*)(UC + (size_t)c * 8192) = pack4(s); s = s * dec + uf * scl;
            if (do_n) { *(f32x4*)(NU + c * 64) = ns; ns = ns * dec + nv[k] * scl; }
            if (do_m) MIN[c] = m;
            m = mn; }
    }
}

constexpr int MC_KS = 144, MC_VS = 288, MC_K = 0, MC_V = 128 * MC_KS, MC_CF = MC_V + 128 * MC_VS, MC_CB = MC_CF + 128 * MC_KS, MC_SC = MC_CB + 128 * MC_KS,
              MC_EF = MC_SC, MC_PF = MC_SC + 512, MC_BF = MC_SC + 1024, MC_EB = MC_SC + 1536, MC_PB = MC_SC + 2048, MC_BB = MC_SC + 2560, MC_NF = MC_SC + 3072, MC_NB = MC_NF + 256, MC_END = MC_NB + 256;
static_assert(MC_END <= 131072, "step C LDS");
DI bf16x8 scale8(const bf16x8& v, float f) { f32x4 a, b; unpack8(__builtin_bit_cast(u32x4, v), a, b); return packf8(a * f, b * f); }
struct McPre { u32x4 k[2], cf[2], cb[2], v[4]; float sc0, sc1, nval, m_f, m_b; bf16x8 q0, q1; };
DI void mc_issue(const P& p, McPre& r, int u, int tid) {
    const int j = u & 63, h = (u >> 6) & 7, b = u >> 9, c = j + 2, row0 = b * SEQ + 128 * j;
    const bf16* KA = (const bf16*)(p.ws + WS_KA); const bf16* VA = (const bf16*)(p.ws + WS_VA);
    const bf16* cf = (const bf16*)(p.ws + WS_UC) + ((((size_t)0 * NB + b) * NHA + h) * NCH + c) * 8192; const bf16* cb = (const bf16*)(p.ws + WS_UC) + ((((size_t)1 * NB + b) * NHA + h) * NCH + c) * 8192;
    { const float* sc = (const float*)(p.ws + WS_SC) + (((size_t)b * NHA + h) * 64 + j) * 768 + 2 * tid; r.sc0 = tid < 384 ? sc[0] : 0.f; r.sc1 = tid < 384 ? sc[1] : 0.f; }
#pragma unroll
    for (int i = 0; i < 2; ++i) { const int ci = tid + i * NTHR, tok = ci >> 3, ch = ci & 7;
        r.k[i] = *(const u32x4*)(KA + (size_t)(row0 + tok) * 512 + h * 64 + ch * 8); r.cf[i] = *(const u32x4*)(cf + tok * 64 + ch * 8); r.cb[i] = *(const u32x4*)(cb + tok * 64 + ch * 8); }
#pragma unroll
    for (int i = 0; i < 4; ++i) { const int ci = tid + i * NTHR, tok = ci >> 4, ch = ci & 15; r.v[i] = *(const u32x4*)(VA + (size_t)(row0 + tok) * 1024 + h * 128 + ch * 8); }
    const size_t bhd_f = ((size_t)b * NHA + h) * 2;
    r.nval = tid < 128 ? ((const float*)(p.ws + WS_NU))[((bhd_f + (tid >> 6)) * NCH + c) * 64 + (tid & 63)] : 0.f;
    r.m_f = ((const float*)(p.ws + WS_MIN))[bhd_f * NCH + c]; r.m_b = ((const float*)(p.ws + WS_MIN))[(bhd_f + 1) * NCH + c];
    { const int lane = tid & 63, t = 16 * (tid >> 6) + (lane & 15), g = lane >> 4;
      const bf16* qp = (const bf16*)(p.ws + WS_QA) + (size_t)(row0 + t) * 512 + h * 64 + 8 * g; r.q0 = *(const bf16x8*)qp; r.q1 = *(const bf16x8*)(qp + 32);
 }
}
DI void mc_commit(const McPre& r, LAS unsigned char* lds, int tid) {
    if (tid < 384) { ((LAS float*)(lds + MC_SC))[2 * tid] = r.sc0; ((LAS float*)(lds + MC_SC))[2 * tid + 1] = r.sc1; }
#pragma unroll
    for (int i = 0; i < 2; ++i) { const int ci = tid + i * NTHR, tok = ci >> 3, ch = ci & 7;
        *(LAS u32x4*)(lds + MC_K + tok * MC_KS + ch * 16) = r.k[i]; *(LAS u32x4*)(lds + MC_CF + tok * MC_KS + ch * 16) = r.cf[i]; *(LAS u32x4*)(lds + MC_CB + tok * MC_KS + ch * 16) = r.cb[i]; }
#pragma unroll
    for (int i = 0; i < 4; ++i) { const int ci = tid + i * NTHR, tok = ci >> 4, ch = ci & 15; *(LAS u32x4*)(lds + MC_V + tok * MC_VS + ch * 16) = r.v[i]; }
    if (tid < 128) ((LAS float*)(lds + MC_NF))[tid] = r.nval;
}
#if defined(MC_PROF)
#define MCP(k) do { if (tid == 0) { volatile LAS unsigned long long* a_ = (volatile LAS unsigned long long*)(lds + 139264); const unsigned long long tn = __builtin_amdgcn_s_memrealtime(); a_[k] += tn - a_[7]; a_[7] = tn; } } while (0)
#else
#define MCP(k) do {} while (0)
#endif
DI void mc_compute(const P& p, LAS unsigned char* lds, int u, int tid, int wave, int lane, bool do_store, const bf16x8 bq0, const bf16x8 bq1, float m_in_f, float m_in_b) {
    const int j = u & 63, h = (u >> 6) & 7, b = u >> 9, c = j + 2;
    const int row0 = b * SEQ + 128 * j;
    const bf16* QA = (const bf16*)(p.ws + WS_QA); bf16* VA = (bf16*)(p.ws + WS_VA);
    const size_t bhd_f = ((size_t)b * NHA + h) * 2, bhd_b = bhd_f + 1;
    const int q = lane & 15, g = lane >> 4, t = 16 * wave + q;
    const bf16* OA = (const bf16*)(p.ws + WS_OA) + (size_t)(row0 + t) * 1024 + h * 128 + 4 * g;
    u32x2 ov[8];
#pragma unroll
    for (int dt = 0; dt < 8; ++dt) ov[dt] = *(const u32x2*)(OA + 16 * dt);
    f32x4 st[8];
#pragma unroll
    for (int kt = 0; kt < 8; ++kt) { const LAS unsigned char* kp = lds + MC_K + (16 * kt + q) * MC_KS + 16 * g;
        st[kt] = mfma16(ldsb128(kp), bq0, (f32x4){0.f, 0.f, 0.f, 0.f}); st[kt] = mfma16(ldsb128(kp + 64), bq1, st[kt]); }
    MCP(1);
    const float Mft = fmaxf(m_in_f, ((const LAS float*)(lds + MC_PF))[t]), Mbt = fmaxf(m_in_b, ((const LAS float*)(lds + MC_PB))[t]);
    const float aft = __expf(m_in_f - Mft), abt = __expf(m_in_b - Mbt), fft = __expf(-(((const LAS float*)(lds + MC_BF))[t] + Mft)), fbt = __expf(-(((const LAS float*)(lds + MC_BB))[t] + Mbt));
    float den_f = 0.f, den_b = 0.f; f32x4 sb[8];
#pragma unroll
    for (int kt = 0; kt < 8; ++kt) {
        const f32x4 ef = *(const LAS f32x4*)(lds + MC_EF + (16 * kt + 4 * g) * 4), eb = *(const LAS f32x4*)(lds + MC_EB + (16 * kt + 4 * g) * 4);
#pragma unroll
        for (int e = 0; e < 4; ++e) { const int s = 16 * kt + 4 * g + e;
            const float wf = __expf(s <= t ? ef[e] - Mft : -1000.f), wb = __expf(s >= t ? eb[e] - Mbt : -1000.f);
            sb[kt][e] = st[kt][e] * wb; st[kt][e] *= wf; den_f += st[kt][e]; den_b += sb[kt][e]; }
    }
    float qn_f = 0.f, qn_b = 0.f;
    { f32x4 a0, a1, c0, c1; unpack8(__builtin_bit_cast(u32x4, bq0), a0, a1); unpack8(__builtin_bit_cast(u32x4, bq1), c0, c1);
      const LAS float* nf = (const LAS float*)(lds + MC_NF) + 8 * g; const LAS float* nb = (const LAS float*)(lds + MC_NB) + 8 * g;
#pragma unroll
      for (int e = 0; e < 4; ++e) { qn_f += a0[e] * nf[e] + a1[e] * nf[4 + e] + c0[e] * nf[32 + e] + c1[e] * nf[36 + e]; qn_b += a0[e] * nb[e] + a1[e] * nb[4 + e] + c0[e] * nb[32 + e] + c1[e] * nb[36 + e]; } }
    den_f += __shfl_xor(den_f, 16); den_f += __shfl_xor(den_f, 32); den_b += __shfl_xor(den_b, 16); den_b += __shfl_xor(den_b, 32);
    qn_f += __shfl_xor(qn_f, 16); qn_f += __shfl_xor(qn_f, 32); qn_b += __shfl_xor(qn_b, 16); qn_b += __shfl_xor(qn_b, 32);
    const float inv_f = 1.f / fmaxf(fabsf(aft * qn_f + den_f), fft), inv_b = 1.f / fmaxf(fabsf(abt * qn_b + den_b), fbt);
    MCP(2);
    bf16x8 pf[4];
#pragma unroll
    for (int i = 0; i < 4; ++i) { f32x4 pp[2];
#pragma unroll
        for (int hh = 0; hh < 2; ++hh) { const int kt = 2 * i + hh;
            pp[hh] = st[kt] * inv_f + sb[kt] * inv_b; }
        pf[i] = packf8(pp[0], pp[1]); }
    const bf16x8 qf0 = scale8(bq0, aft * inv_f), qf1 = scale8(bq1, aft * inv_f), qb0 = scale8(bq0, abt * inv_b), qb1 = scale8(bq1, abt * inv_b);
    f32x4 oacc[8]; float ss = 0.f;
#pragma unroll
    for (int dt = 0; dt < 8; ++dt) { f32x4 o = {0.f, 0.f, 0.f, 0.f};
#pragma unroll
        for (int i = 0; i < 4; ++i) o = mfma16(tr_frag(lds + MC_V, MC_VS, i, 16 * dt, lane), pf[i], o);
        const LAS unsigned char* cfp = lds + MC_CF + (16 * dt + q) * MC_KS + 16 * g; const LAS unsigned char* cbp = lds + MC_CB + (16 * dt + q) * MC_KS + 16 * g;
        o = mfma16(ldsb128(cfp), qf0, o); o = mfma16(ldsb128(cfp + 64), qf1, o); o = mfma16(ldsb128(cbp), qb0, o); o = mfma16(ldsb128(cbp + 64), qb1, o);
        oacc[dt] = o; ss += (o[0] * o[0] + o[1] * o[1]) + (o[2] * o[2] + o[3] * o[3]); }
    MCP(3);
    ss += __shfl_xor(ss, 16); ss += __shfl_xor(ss, 32);
    const float rn = rsqrtf(ss * (1.f / 128.f) + EPS);
    bf16* __restrict__ HA = VA + (size_t)(row0 + t) * 1024 + h * 128 + 4 * g;
    const float* __restrict__ gn = p.mlstm_g + h * 128 + 4 * g;
#pragma unroll
    for (int dt = 0; dt < 8; ++dt) { f32x4 og;
        og[0] = __uint_as_float(ov[dt].x << 16); og[1] = __uint_as_float(ov[dt].x & 0xffff0000u); og[2] = __uint_as_float(ov[dt].y << 16); og[3] = __uint_as_float(ov[dt].y & 0xffff0000u);
        const u32x2 w = pack4(oacc[dt] * rn * *(const f32x4*)(gn + 16 * dt) * og); if (do_store) *(u32x2*)(HA + 16 * dt) = w; else asm volatile("" :: "v"(w.x), "v"(w.y)); }
}
DI void mc_phase(const P& p, LAS unsigned char* lds, int bx, int G, int tid, int wave, int lane) {
    constexpr int NU_ = NB * NHA * 64;
#if defined(MC_PROF)
    if (tid == 0) { volatile LAS unsigned long long* a_ = (volatile LAS unsigned long long*)(lds + 139264); for (int i = 0; i < 7; ++i) a_[i] = 0; a_[7] = __builtin_amdgcn_s_memrealtime(); }
#endif
    int u = bx; McPre r;
    if (u < NU_) mc_issue(p, r, u, tid);
    for (; u < NU_; u += G) {
        mc_commit(r, lds, tid);
        __syncthreads();
        MCP(0);
        const bf16x8 cq0 = r.q0, cq1 = r.q1; const float cmf = r.m_f, cmb = r.m_b;
        if (u + G < NU_) mc_issue(p, r, u + G, tid);
        asm volatile("" ::: "memory");
        mc_compute(p, lds, u, tid, wave, lane, true, cq0, cq1, cmf, cmb);
        __syncthreads();
        MCP(4);
    }
}

DI void phase_p0(const P& p, LAS unsigned char* lds, int bx, int G, int tid, int gw, int ngw, int wave, int lane) {
    for (int i = bx * 8 + tid; tid < 8 && i < 128 * 16; i += G * 8) { const int pos = i >> 4, f = i & 15;   const float ang = (float)pos * powf(10000.f, -(float)f / 16.f);
        float* t = (float*)(p.ws + WS_ROPE); t[pos * 32 + f] = (float)cos((double)ang); t[pos * 32 + 16 + f] = (float)sin((double)ang); }
    for (int i = bx * NTHR + tid; i < M_LAT; i += G * NTHR) ((float*)(p.ws + WS_SUMSQ))[i] = 0.f;
    if (bx < 192) { LAS float* A = (LAS float*)lds; LAS float* red = A + 5 * 1024;
        for (int i = tid; i < 5 * 1024; i += NTHR) { const float v = i < 4096 ? p.c[i] : p.c_ctx[i - 4096]; A[i] = v / (1.f + expf(-v)); }
        __syncthreads();
        gemv_task<5>(p.w_mod, 6144, 32 * bx, A, red, (float*)(p.ws + WS_MODV), 6144, p.b_mod, tid); }
    __syncthreads();
    phase_convert(p, lds, gw, ngw, wave, lane, 0, TAIL_CONV_LATE ? CI_WIN : CI_TOTAL);
    __syncthreads();
}
DI void phase_p1(const P& p, LAS unsigned char* lds, int bx, int G, int tid, int gw, int ngw, int lane) {
    if (!TAIL_CONV_LATE) phase_bgu(p, gw, ngw, lane);
    bf16* HX = (bf16*)(p.ws + WS_HX);
    for (int mr = 0; mr < 5; ++mr) {
        const float* mv = (const float*)(p.ws + WS_MODV) + mr * 6144;
        const int rbeg = mr < 4 ? mr * SEQ : M_LAT, rend = mr < 4 ? (mr + 1) * SEQ : M_ALL;
        f32x4 sc[4], sh[4];
#pragma unroll
        for (int jj = 0; jj < 4; ++jj) { const int k = 4 * lane + 256 * jj; sc[jj] = *(const f32x4*)(p.norm1_g + k) * (*(const f32x4*)(mv + 1024 + k) + 1.f); sh[jj] = *(const f32x4*)(mv + k); }
        f32x4 v[4], vn[4];
        int row = rbeg + gw;
        if (row < rend) { const float* xr = row < M_LAT ? p.x + (size_t)row * DM : p.ctx + (size_t)(row - M_LAT) * DM;
#pragma unroll
            for (int jj = 0; jj < 4; ++jj) v[jj] = *(const f32x4*)(xr + 4 * lane + 256 * jj); }
        for (; row < rend; row += ngw) {
            const int nrow = row + ngw;
            if (nrow < rend) { const float* xn = nrow < M_LAT ? p.x + (size_t)nrow * DM : p.ctx + (size_t)(nrow - M_LAT) * DM;
#pragma unroll
                for (int jj = 0; jj < 4; ++jj) vn[jj] = *(const f32x4*)(xn + 4 * lane + 256 * jj); }
            float ss = 0.f;
#pragma unroll
            for (int jj = 0; jj < 4; ++jj) ss += (v[jj][0] * v[jj][0] + v[jj][1] * v[jj][1]) + (v[jj][2] * v[jj][2] + v[jj][3] * v[jj][3]);
#pragma unroll
            for (int o = 1; o < 64; o <<= 1) ss += __shfl_xor(ss, o);
            const float rstd = rsqrtf(ss * (1.f / DM) + EPS);
#pragma unroll
            for (int jj = 0; jj < 4; ++jj) *(u32x2*)(HX + (size_t)row * DM + 4 * lane + 256 * jj) = pack4(v[jj] * rstd * sc[jj] + sh[jj]);
#pragma unroll
            for (int jj = 0; jj < 4; ++jj) v[jj] = vn[jj];
        }
    }
}
#ifndef PG8_SP2_
#define PG8_SP2_ true
#endif
#ifndef ALIGN_HEAVY
#define ALIGN_HEAVY true
#endif
#ifndef REPEAT_MASK
#define REPEAT_MASK 0
#endif
#define REP(ph) for (int rep_ = 0; rep_ < 1 + ((REPEAT_MASK >> (ph)) & 1); ++rep_)
#ifndef SIMPLE_BAR
#define SIMPLE_BAR 0
#endif
enum { PH_P0 = 0, PH_P1, PH_INPROJ, PH_MA, PH_SCAN_NA, PH_MC, PH_MERGE, PH_OUT, PH_FFN1, PH_FFN2, PH_COUNT };
__global__ void __launch_bounds__(NTHR, 2) mk_fwd(P p, int ph_lo, int ph_hi, int li, int dbg) {
    extern __shared__ __attribute__((aligned(16))) unsigned char lds_raw[];
    LAS unsigned char* lds = (LAS unsigned char*)lds_raw;
    const int tid = threadIdx.x, lane = tid & 63, wave = __builtin_amdgcn_readfirstlane(tid >> 6);
    const int G = gridDim.x, bx = blockIdx.x;
    const int vcu = (G % 8 == 0) ? (bx % 8) * (G / 8) + bx / 8 : bx;
    const int gw = vcu * NWAVES + wave, ngw = G * NWAVES;
    if (tid < 64) ((LAS unsigned*)(lds + LDSCTL_OFF))[tid] = 0u;
    __syncthreads();
    const XcdBarrier bar = xcd_barrier_post((unsigned*)(p.ws + WS_CTL) + 4096 * li, (volatile LAS unsigned*)(lds + LDSCTL_OFF));
    unsigned epoch = 0;
#if defined(TS_A)
    volatile LAS unsigned long long* tsl = (volatile LAS unsigned long long*)(lds + LDSCTL_OFF + 64);
#define STAMP(i) do { if (bx == 0 && tid == 0) tsl[i] = __builtin_amdgcn_s_memrealtime(); } while (0)
#else
#define STAMP(i) do {} while (0)
#endif
#ifndef STAG_INPROJ
#define STAG_INPROJ 28
#define STAG_MERGE 14
#define STAG_OUT 28
#define STAG_FFN1 24
#define STAG_FFN2 80
#endif
#ifndef STAG_S
#define STAG_S 1
#endif
#define STAGGER(d_us) do { const int sg_ = (bx >> 3) % STAG_S; if (STAG_S > 1 && sg_) { if (tid == 0) { const unsigned long long t0_ = __builtin_amdgcn_s_memrealtime(); \
        while (__builtin_amdgcn_s_memrealtime() - t0_ < (unsigned long long)(100 * (d_us)) * sg_ / STAG_S) __builtin_amdgcn_s_sleep(4); } __syncthreads(); } } while (0)
#define IN(k) (ph_lo <= (k) && (k) < ph_hi)
#if SIMPLE_BAR
#define SEAM(k) do { if (IN(k) && IN((k) + 1)) { __threadfence(); __syncthreads(); \
        if (tid == 0) { unsigned* cw = (unsigned*)(p.ws + WS_CTL) + 4096 * li + 3500; ++epoch; xb_add(cw, 1u); while (xb_ld(cw) < epoch * (unsigned)G) __builtin_amdgcn_s_sleep(2); } \
        __syncthreads(); __threadfence(); } } while (0)
#else
#define SEAM(k) do { STAMP(2 * (k) + 1); if (IN(k) && IN((k) + 1)) xcd_barrier(bar); STAMP(2 * (k) + 2); } while (0)
#endif
    STAMP(0);
    if (IN(PH_P0)) REP(PH_P0) phase_p0(p, lds, bx, G, tid, gw, ngw, wave, lane);
    SEAM(PH_P0);
    if (IN(PH_P1)) REP(PH_P1) phase_p1(p, lds, bx, G, tid, gw, ngw, lane);
    SEAM(PH_P1);
    if (IN(PH_INPROJ)) REP(PH_INPROJ) {
        STAGGER(STAG_INPROJ);
        pg8::Gemm g{(const bf16*)(p.ws + WS_HX), (const bf16*)(p.ws + WS_WIN), M_ALL, 33 * 256, DM}; InprojOrder S{G, bx};
        EpiInproj E{p.ws, p.b_gates, p.qn_g, p.kn_g, (bf16*)p.out};
        g.dz = (unsigned*)(p.ws + WS_DUMMY);
        pg8::gemm_phase<EpiInproj, InprojOrder, true, true>(lds, g, S, E);
        if (TAIL_CONV_LATE) { const int rem = INPROJ_UNITS % G;
            if (rem == 0) phase_convert(p, lds, gw, ngw, wave, lane, CI_WIN, CI_TOTAL);
            else if (bx >= rem) phase_convert(p, lds, (bx - rem) * NWAVES + wave, (G - rem) * NWAVES, wave, lane, CI_WIN, CI_TOTAL); }
    }
    SEAM(PH_INPROJ);
    if (IN(PH_MA)) { if (TAIL_CONV_LATE) phase_bgu(p, gw, ngw, lane);
        ma_phase(p, lds, bx, G, tid, wave, lane); }
    SEAM(PH_MA);
    if (IN(PH_SCAN_NA)) {
        for (int blk = bx; blk < 256; blk += G) mB_unit(p, blk, tid);
        for (int u0 = vcu * 16; u0 < 4096; u0 += G * 16) na_phase(p, lds, u0, tid, wave, lane);
    }
    SEAM(PH_SCAN_NA);
    if (IN(PH_MC)) mc_phase(p, lds, bx, G, tid, wave, lane);
    SEAM(PH_MC);
    if (IN(PH_MERGE)) REP(PH_MERGE) {
        STAGGER(STAG_MERGE);
        MergeOrder S; S.so.init(M_LAT, DM, G, bx);
        pg8::Gemm2 g{(const bf16*)(p.ws + WS_VA), (const bf16*)(p.ws + WS_WA), (const bf16*)(p.ws + WS_QB), (const bf16*)(p.ws + WS_WB), M_LAT, DM, DM};
        EpiMerge2 E{(const bf16*)p.out, (bf16*)(p.ws + WS_T1)};
        pg8::gemm_phase2<EpiMerge2, MergeOrder, true, true>(lds, g, S, E);
    }
    SEAM(PH_MERGE);
    if (IN(PH_OUT)) {
        STAGGER(STAG_OUT);
        pg8::Gemm g{(const bf16*)(p.ws + WS_T1), (const bf16*)(p.ws + WS_WO), M_LAT, DM, DM}; pg8::StaticOrder S; S.init(M_LAT, DM, G, bx);
        EpiOut E{p.x, (bf16*)(p.ws + WS_XN), (bf16*)(p.ws + WS_XS), (float*)(p.ws + WS_SUMSQ), (const float*)(p.ws + WS_MODV), p.norm2_g};
        g.dz = (unsigned*)(p.ws + WS_DUMMY);
        pg8::gemm_phase<EpiOut, pg8::StaticOrder, true, true>(lds, g, S, E);
    }
    SEAM(PH_OUT);
    if (IN(PH_FFN1)) REP(PH_FFN1) {
        STAGGER(STAG_FFN1);
        pg8::Gemm g{(const bf16*)(p.ws + WS_XS), (const bf16*)(p.ws + WS_WGU), M_LAT, 2 * DFF, DM}; pg8::StaticOrder S; S.init(M_LAT, 2 * DFF, G, bx);
        EpiFfn1 E{(bf16*)(p.ws + WS_HFF), (const float*)(p.ws + WS_SUMSQ), (const float*)(p.ws + WS_BGU)};
        g.dz = (unsigned*)(p.ws + WS_DUMMY);
        pg8::gemm_phase<EpiFfn1, pg8::StaticOrder, true, true>(lds, g, S, E);
    }
    SEAM(PH_FFN1);
    if (IN(PH_FFN2)) {
        STAGGER(STAG_FFN2);
        pg8::Gemm g{(const bf16*)(p.ws + WS_HFF), (const bf16*)(p.ws + WS_WD), M_LAT, DM, DFF}; pg8::StaticOrder S; S.init(M_LAT, DM, G, bx);
        EpiFfn2 E{p.out, (const bf16*)(p.ws + WS_XN), (const float*)(p.ws + WS_MODV)};
        g.dz = (unsigned*)(p.ws + WS_DUMMY);
        pg8::gemm_phase<EpiFfn2, pg8::StaticOrder, true, true>(lds, g, S, E);
    }
#if defined(TS_A)
    STAMP(2 * PH_FFN2 + 1);
#if defined(MC_PROF)
    if (bx == 0 && tid == 0) { volatile LAS unsigned long long* nacc = (volatile LAS unsigned long long*)(lds + 139264); const unsigned long long ta = nacc[TS_A], tb = nacc[TS_B], t0 = __builtin_amdgcn_s_memrealtime();
#elif defined(NA_PROF)
    if (bx == 0 && tid == 0) { volatile LAS unsigned long long* nacc = (volatile LAS unsigned long long*)(lds + NA_RPB + 2048); const unsigned long long ta = nacc[TS_A], tb = nacc[TS_B], t0 = __builtin_amdgcn_s_memrealtime();
#else
    if (bx == 0 && tid == 0) { unsigned long long ta = 0; if (TS_A == 100) { for (int k_ = 0; k_ < 9; ++k_) ta += tsl[2 * k_ + 2] - tsl[2 * k_ + 1]; } else if (TS_A == 101) ta = tsl[19] - tsl[0]; else ta = tsl[(TS_A % 100) + 1] - tsl[TS_A % 100];
        const unsigned long long tb = tsl[TS_B + 1] - tsl[TS_B], t0 = __builtin_amdgcn_s_memrealtime();
#endif
        while (__builtin_amdgcn_s_memrealtime() - t0 < ta + (unsigned long long)TS_MUL * 100ull * (tb / 100ull)) __builtin_amdgcn_s_sleep(8); }
#endif
#undef IN
#undef SEAM
}

extern "C" void kernel_launch(void* const* d_in, const int* in_sizes, int n_in, void* d_out, int out_size, void* d_ws, size_t ws_size, hipStream_t stream) {
    if (n_in != 20 || ws_size < WS_END || out_size != M_LAT * DM) { fprintf(stderr, "kernel_launch: unexpected shapes (n_in %d, ws %zu, out %d); nothing launched\n", n_in, ws_size, out_size); return; }
    P p{};
    const float** f = (const float**)&p;
    for (int i = 0; i < 20; ++i) f[i] = (const float*)d_in[i];
    p.out = (float*)d_out; p.ws = (unsigned char*)d_ws;
    static int grid = 0;
    if (!grid) {
        if (hipFuncSetAttribute((const void*)mk_fwd, hipFuncAttributeMaxDynamicSharedMemorySize, LDS_BYTES) != hipSuccess) { fprintf(stderr, "kernel_launch: cannot get %d bytes of dynamic LDS\n", LDS_BYTES); grid = -1; return; }
        int dev = 0, cus = 0, per_cu = 0;
        (void)hipGetDevice(&dev); (void)hipDeviceGetAttribute(&cus, hipDeviceAttributeMultiprocessorCount, dev);
        (void)hipOccupancyMaxActiveBlocksPerMultiprocessor(&per_cu, (const void*)mk_fwd, NTHR, LDS_BYTES);
        if (per_cu < 1 || cus < 1) { fprintf(stderr, "kernel_launch: occupancy query says %d workgroups per CU on %d CUs; nothing launched\n", per_cu, cus); grid = -1; return; }
        grid = cus;
    }
    if (grid < 0) return;
    (void)hipMemsetAsync(d_ws, 0, CTL_ZERO_BYTES, stream);
    int lo = PH_P0, hi = PH_COUNT, li = 0, dbg = 0; void* args[] = {&p, &lo, &hi, &li, &dbg};
    const hipError_t e = hipLaunchCooperativeKernel((const void*)mk_fwd, dim3(grid), dim3(NTHR), args, LDS_BYTES, stream);
    if (e != hipSuccess) fprintf(stderr, "kernel_launch: cooperative launch failed: %s (grid %d)\n", hipGetErrorString(e), grid);
}
```

```cpp
#include <hip/hip_runtime.h>
#include <hip/hip_cooperative_groups.h>
#include <cstdio>
#include <cstdint>
namespace cg = cooperative_groups;

typedef unsigned short bf16;
#define DI __device__ __forceinline__
#define LAS __attribute__((address_space(3)))
DI float bf2f(bf16 b) { return __uint_as_float(((unsigned)b) << 16); }
DI bf16 f2bf(float f) { unsigned u = __float_as_uint(f); return (bf16)((u + 0x7fffu + ((u >> 16) & 1u)) >> 16); }
DI float sigmoidf_(float x) { return 1.f / (1.f + __expf(-x)); }
DI float logsigmoidf_(float x) { return fminf(x, 0.f) - log1pf(__expf(-fabsf(x))); }

constexpr int NB = 4, SEQ = 8192, DM = 1024, CTX = 256, GW = 64, GROWS = 128;
constexpr int M_LAT = NB * SEQ, M_CTX = NB * CTX, M_ALL = M_LAT + M_CTX;
constexpr int NHA = 8, DKA = 64, DVA = 128, NHB = 16, DHB = 64;
constexpr int DIN = 8224, DFF = 2816, NCH = 66;
constexpr float EPS = 1e-6f, GCAP = 15.f;
constexpr int C_QA = 0, C_KA = 512, C_VA = 1024, C_OA = 2048, C_G = 3072, C_QB = 3104, C_KB = 4128, C_VB = 5152, C_MG = 6176;

constexpr size_t MiB = 1u << 20;
constexpr size_t WS_MODV = 1 * MiB;
constexpr size_t WS_ROPE = WS_MODV + 128 * 1024;
constexpr size_t WS_SUMSQ = WS_ROPE + 32 * 1024;
constexpr size_t WS_CH = WS_SUMSQ + 128 * 1024;
constexpr size_t WS_MIN = WS_CH + 64 * 1024;
constexpr size_t WS_BGU = WS_MIN + 32 * 1024;
constexpr size_t WS_NU = WS_BGU + 128 * 1024;
constexpr size_t WS_GATES = 3 * MiB;
constexpr size_t WS_W = 8 * MiB;
constexpr size_t WS_WIN = WS_W, WS_WA = 25 * MiB, WS_WB = 27 * MiB, WS_WO = 29 * MiB, WS_WGU = 31 * MiB, WS_WD = 42 * MiB;
constexpr size_t WS_HX = 48 * MiB, WS_QA = 114 * MiB, WS_KA = 147 * MiB, WS_VA = 180 * MiB, WS_OA = 246 * MiB, WS_QB = 310 * MiB, WS_KB = 374 * MiB, WS_VB = 440 * MiB, WS_END = 506 * MiB;
constexpr size_t WS_T1 = WS_QA, WS_XS = WS_HX, WS_HFF = WS_QB, WS_TMP = WS_KB;
constexpr size_t WS_XN = WS_VA;
constexpr size_t WS_SC = WS_WIN;
constexpr size_t WS_UC = WS_HX;
static_assert(WS_NU + 4 * 8 * 2 * 66 * 64 * 4 <= WS_GATES && WS_GATES + (size_t)M_ALL * 32 * 4 <= WS_W, "misc map");
static_assert(WS_WIN + (size_t)33 * 256 * 1024 * 2 <= WS_WA && WS_WGU + (size_t)5632 * 1024 * 2 <= WS_WD && WS_WD + (size_t)1024 * 2816 * 2 <= WS_HX, "weight map");

struct P {
    const float *x, *c, *ctx, *c_ctx, *w_mod, *b_mod, *norm1_g, *w_in, *b_gates, *mlstm_g, *qn_g, *kn_g, *rpb, *w_a, *w_b, *w_o, *norm2_g, *w_fg, *w_fu, *w_fd;
    float* out; unsigned char* ws;
};
#ifndef PG8_WGM
#define PG8_WGM 4
#endif
namespace pg8 {
#define PG8_LAS __attribute__((address_space(3)))
typedef unsigned short bf16_t;
typedef short bf16x8 __attribute__((ext_vector_type(8)));
typedef float f32x4 __attribute__((ext_vector_type(4)));
typedef unsigned u32x4 __attribute__((ext_vector_type(4)));
constexpr int BM = 256, BK = 64, HALF = 128, HTB = HALF * BK * 2  , STAGE_BYTES = 8 * HTB, NXCD = 8, WGM = PG8_WGM;

__host__ __device__ __forceinline__ int lds_byte(int r, int c) { const int st = (r >> 4) * 2 + (c >> 5), rr = r & 15, cc = c & 31, ob = rr * 64 + cc * 2; return st * 1024 + (ob ^ (((ob >> 9) & 1) << 5)); }
__host__ __device__ __forceinline__ void stage_rc(int b, int& R, int& C) { const int st = b / 1024, sb = b % 1024, swz = sb ^ (((sb >> 9) & 1) << 5); R = (st >> 1) * 16 + swz / 64; C = (st & 1) * 32 + (swz % 64) / 2; }
__host__ __device__ __forceinline__ int perm32(int rho) { const int n = rho >> 4, i = rho & 15; return 8 * (i >> 2) + 4 * n + (i & 3); }

struct Unit { int pm, pn; };
struct Gemm { const bf16_t* A; const bf16_t* Bt; int M, N, K; int wave; };
__device__ __forceinline__ int lane_now() { int l; asm volatile("v_mbcnt_lo_u32_b32 %0, -1, 0\n\tv_mbcnt_hi_u32_b32 %0, -1, %0" : "=v"(l)); return l; }

struct StaticOrder {
    int nM, nN, nwg, G, c;
    __host__ __device__ void init(int M, int N, int G_, int c_) { nM = M / BM; nN = N / BM; nwg = nM * nN; G = G_; c = c_; }
    __host__ __device__ bool next(int i, Unit& u) const {
        const long L = (long)i * G + c; if (L >= nwg) return false;
        int wgid = (int)L; { const int q = nwg / NXCD, r = nwg % NXCD, xcd = wgid % NXCD, off = wgid / NXCD; wgid = (xcd < r ? xcd * (q + 1) : r * (q + 1) + (xcd - r) * q) + off; }
        const int nig = WGM * nN, gid = wgid / nig, fm = gid * WGM, gsz = (nM - fm) < WGM ? (nM - fm) : WGM;
        u.pm = fm + ((wgid % nig) % gsz); u.pn = (wgid % nig) / gsz; return true;
    }
    __device__ __forceinline__ void a_ready(const Unit&) const {}
    __device__ __forceinline__ void done(const Unit&) const {}
};
__device__ __forceinline__ unsigned cvt_pk_bf16(float lo, float hi) { unsigned r; asm volatile("v_cvt_pk_bf16_f32 %0, %1, %2" : "=v"(r) : "v"(lo), "v"(hi)); return r; }
typedef float f32x2 __attribute__((ext_vector_type(2)));
template <class Epi, class Sched, bool ALIGN_EPI = false, bool SP2 = false>
__device__ __forceinline__ void gemm_phase(PG8_LAS unsigned char* lds, const Gemm g, const Sched& S, const Epi& E) {
    const int wid = g.wave, lane = lane_now(), tid = wid * 64 + lane, wr = wid >> 2, wc = wid & 3, fr = lane & 15, fq = lane >> 4;
    const int K = g.K, nt = K / BK;
    unsigned voffA[2], voffB[2];
#pragma unroll
    for (int i = 0; i < 2; ++i) { int R, C; stage_rc(tid * 16 + i * 8192, R, C); const int Rb = Epi::PERM ? ((R & ~31) + perm32(R & 31)) : R;
        voffA[i] = (unsigned)(R * K + C) * 2u; voffB[i] = (unsigned)(Rb * K + C) * 2u; }
    const size_t kstep = (size_t)(BK * 2);
    const size_t hstep = (size_t)HALF * K * 2;
    const size_t tstep = 2 * hstep;
    const unsigned ldsw = (unsigned)wid * 1024u;
    const int aoff = lds_byte(wr * 64 + fr, fq * 8), boff = lds_byte(wc * 32 + fr, fq * 8);
#define PG8_SA(b, h) (((b) * 2 + (h)) * HTB)
#define PG8_SB(b, h) ((4 + (b) * 2 + (h)) * HTB)
#define PG8_STAGE(bufoff, gbase, voff) do { _Pragma("unroll") for (int _i = 0; _i < 2; ++_i) \
        __builtin_amdgcn_global_load_lds((const unsigned*)((const char*)(gbase) + (voff)[_i]), (PG8_LAS unsigned*)(lds + (bufoff) + ldsw + _i * 8192), 16, 0, 0); } while (0)
#define PG8_LDA(dst, b, h) do { _Pragma("unroll") for (int m = 0; m < 4; ++m) _Pragma("unroll") for (int k = 0; k < 2; ++k) dst[m][k] = *(const PG8_LAS bf16x8*)(lds + PG8_SA(b, h) + aoff + m * 2048 + k * 1024); } while (0)
#define PG8_LDB(dst, b, h) do { _Pragma("unroll") for (int n = 0; n < 2; ++n) _Pragma("unroll") for (int k = 0; k < 2; ++k) dst[n][k] = *(const PG8_LAS bf16x8*)(lds + PG8_SB(b, h) + boff + n * 2048 + k * 1024); } while (0)
#define PG8_MMA(ai, bj, At, Bt) do { __builtin_amdgcn_s_setprio(1); _Pragma("unroll") for (int m = 0; m < 4; ++m) _Pragma("unroll") for (int n = 0; n < 2; ++n) _Pragma("unroll") for (int k = 0; k < 2; ++k) \
        acc[ai][bj][m][n] = __builtin_amdgcn_mfma_f32_16x16x32_bf16(Bt[n][k], At[m][k], acc[ai][bj][m][n], 0, 0, 0); __builtin_amdgcn_s_setprio(0); } while (0)
#define PG8_WAIT_V(n) asm volatile("s_waitcnt vmcnt(" #n ")" ::: "memory")
#define PG8_WAIT_L(n) asm volatile("s_waitcnt lgkmcnt(" #n ")" ::: "memory")
#define PG8_BAR __builtin_amdgcn_s_barrier()
#define PG8_SCHED __builtin_amdgcn_sched_barrier(0)
    Unit cur, nxt; int ui = 0;
    if (!S.next(0, cur)) return;
    f32x4 acc[2][2][4][2];
#pragma unroll
    for (int a = 0; a < 2; ++a)
#pragma unroll
        for (int b = 0; b < 2; ++b)
#pragma unroll
            for (int m = 0; m < 4; ++m)
#pragma unroll
                for (int n = 0; n < 2; ++n) acc[a][b][m][n] = (f32x4){0.f, 0.f, 0.f, 0.f};
    bf16x8 At[4][2], B0[2][2], B1[2][2];
    const char* cA = (const char*)g.A + (size_t)cur.pm * tstep; const char* cB = (const char*)g.Bt + (size_t)cur.pn * tstep;
    S.a_ready(cur);
    if constexpr (SP2) {
        PG8_STAGE(PG8_SB(0, 0), cB, voffB); PG8_STAGE(PG8_SB(0, 1), cB + hstep, voffB); PG8_STAGE(PG8_SA(0, 0), cA, voffA); PG8_STAGE(PG8_SA(0, 1), cA + hstep, voffA);
        if (wr == 1) PG8_BAR;
        PG8_WAIT_V(2); PG8_BAR;
        PG8_STAGE(PG8_SB(1, 0), cB + kstep, voffB); PG8_STAGE(PG8_SA(1, 0), cA + kstep, voffA); PG8_STAGE(PG8_SB(1, 1), cB + hstep + kstep, voffB);
        PG8_WAIT_V(6); PG8_BAR;
    } else {
        PG8_STAGE(PG8_SB(0, 0), cB, voffB); PG8_STAGE(PG8_SA(0, 0), cA, voffA); PG8_STAGE(PG8_SB(0, 1), cB + hstep, voffB); PG8_STAGE(PG8_SA(0, 1), cA + hstep, voffA);
        if (wr == 1) PG8_BAR;
        PG8_WAIT_V(4); PG8_BAR;
        PG8_STAGE(PG8_SB(1, 0), cB + kstep, voffB); PG8_STAGE(PG8_SA(1, 0), cA + kstep, voffA); PG8_STAGE(PG8_SB(1, 1), cB + hstep + kstep, voffB);
        PG8_WAIT_V(6); PG8_BAR;
    }
    for (;;) {
        const bool has_next = S.next(ui + 1, nxt);
        const char* nA = has_next ? (const char*)g.A + (size_t)nxt.pm * tstep : cA; const char* nB = has_next ? (const char*)g.Bt + (size_t)nxt.pn * tstep : cB;
        for (int t = 0; t < nt; t += 2) {
            const bool last = (t == nt - 2);
            const char* a1 = cA + (size_t)(t + 1) * kstep;
            const char* a2 = last ? nA : cA + (size_t)(t + 2) * kstep; const char* b2 = last ? nB : cB + (size_t)(t + 2) * kstep;
            const char* a3 = a2 + kstep; const char* b3 = b2 + kstep;
            if (last && has_next) S.a_ready(nxt);
            if constexpr (SP2) {
            PG8_LDB(B0, 0, 0); PG8_LDB(B1, 0, 1); PG8_SCHED; PG8_LDA(At, 0, 0); PG8_STAGE(PG8_SA(1, 1), a1 + hstep, voffA);
            PG8_WAIT_V(8); PG8_WAIT_L(0); PG8_BAR; PG8_MMA(0, 0, At, B0); PG8_MMA(0, 1, At, B1); PG8_BAR; PG8_SCHED;
            PG8_LDA(At, 0, 1); PG8_STAGE(PG8_SB(0, 0), b2, voffB); PG8_STAGE(PG8_SB(0, 1), b2 + hstep, voffB); PG8_STAGE(PG8_SA(0, 0), a2, voffA);
            PG8_WAIT_V(8); PG8_WAIT_L(0); PG8_BAR; PG8_MMA(1, 0, At, B0); PG8_MMA(1, 1, At, B1); PG8_BAR; PG8_SCHED;
            PG8_LDB(B0, 1, 0); PG8_LDB(B1, 1, 1); PG8_SCHED; PG8_LDA(At, 1, 0); PG8_STAGE(PG8_SA(0, 1), a2 + hstep, voffA);
            PG8_WAIT_V(8); PG8_WAIT_L(0); PG8_BAR; PG8_MMA(0, 0, At, B0); PG8_MMA(0, 1, At, B1); PG8_BAR; PG8_SCHED;
            PG8_LDA(At, 1, 1); PG8_STAGE(PG8_SB(1, 0), b3, voffB); PG8_STAGE(PG8_SB(1, 1), b3 + hstep, voffB); PG8_STAGE(PG8_SA(1, 0), a3, voffA);
            PG8_WAIT_V(8); PG8_WAIT_L(0); PG8_BAR; PG8_MMA(1, 0, At, B0); PG8_MMA(1, 1, At, B1); PG8_BAR; PG8_SCHED;
            } else {
            PG8_LDB(B0, 0, 0); PG8_SCHED; PG8_LDA(At, 0, 0); PG8_STAGE(PG8_SA(1, 1), a1 + hstep, voffA);
            PG8_WAIT_L(8); PG8_BAR; PG8_WAIT_L(0); PG8_MMA(0, 0, At, B0); PG8_BAR; PG8_SCHED;
            PG8_LDB(B1, 0, 1); PG8_STAGE(PG8_SB(0, 0), b2, voffB);
            PG8_BAR; PG8_WAIT_L(0); PG8_MMA(0, 1, At, B1); PG8_BAR;
            PG8_LDA(At, 0, 1); PG8_STAGE(PG8_SA(0, 0), a2, voffA);
            PG8_BAR; PG8_WAIT_L(0); PG8_MMA(1, 0, At, B0); PG8_BAR; PG8_SCHED;
            PG8_STAGE(PG8_SB(0, 1), b2 + hstep, voffB);
            PG8_WAIT_V(6); PG8_BAR; PG8_MMA(1, 1, At, B1); PG8_BAR;
            PG8_LDB(B0, 1, 0); PG8_SCHED; PG8_LDA(At, 1, 0); PG8_STAGE(PG8_SA(0, 1), a2 + hstep, voffA);
            PG8_WAIT_L(8); PG8_BAR; PG8_WAIT_L(0); PG8_MMA(0, 0, At, B0); PG8_BAR; PG8_SCHED;
            PG8_LDB(B1, 1, 1); PG8_STAGE(PG8_SB(1, 0), b3, voffB);
            PG8_BAR; PG8_WAIT_L(0); PG8_MMA(0, 1, At, B1); PG8_BAR;
            PG8_LDA(At, 1, 1); PG8_STAGE(PG8_SA(1, 0), a3, voffA);
            PG8_BAR; PG8_WAIT_L(0); PG8_MMA(1, 0, At, B0); PG8_BAR; PG8_SCHED;
            PG8_STAGE(PG8_SB(1, 1), b3 + hstep, voffB);
            PG8_WAIT_V(6); PG8_BAR; PG8_MMA(1, 1, At, B1); PG8_BAR;
            }
        }
        if constexpr (ALIGN_EPI) { if (wr == 0) PG8_BAR; }
        if constexpr (!Epi::AFTER_DRAIN) { E(acc, cur, wr, wc, fr, fq); S.done(cur); }
        if (!has_next) break;
#pragma unroll
        for (int a = 0; a < 2; ++a)
#pragma unroll
            for (int b = 0; b < 2; ++b)
#pragma unroll
                for (int m = 0; m < 4; ++m)
#pragma unroll
                    for (int n = 0; n < 2; ++n) acc[a][b][m][n] = (f32x4){0.f, 0.f, 0.f, 0.f};
        cur = nxt; cA = nA; cB = nB; ++ui;
        if constexpr (ALIGN_EPI) { if (wr == 1) PG8_BAR; }
    }
    PG8_WAIT_V(0);
    if constexpr (!ALIGN_EPI) { if (wr == 0) PG8_BAR; }
    PG8_BAR;
    if constexpr (Epi::AFTER_DRAIN) { E.fused(acc, cur, wr, wc, fr, fq, lds, wid, lane); S.done(cur); }
#undef PG8_SA
#undef PG8_SB
#undef PG8_STAGE
#undef PG8_LDA
#undef PG8_LDB
#undef PG8_MMA
#undef PG8_WAIT_V
#undef PG8_WAIT_L
#undef PG8_BAR
#undef PG8_SCHED
}
struct Unit2 { int pm, pn, sub; };
struct Gemm2 { const bf16_t* A1; const bf16_t* Bt1; const bf16_t* A2; const bf16_t* Bt2; int M, N, K; int wave; };
template <class Epi, class Sched, bool ALIGN_EPI = false, bool SP2 = false>
__device__ __forceinline__ void gemm_phase2(PG8_LAS unsigned char* lds, const Gemm2 g, const Sched& S, const Epi& E) {
    const int wid = g.wave, lane = lane_now(), tid = wid * 64 + lane, wr = wid >> 2, wc = wid & 3, fr = lane & 15, fq = lane >> 4;
    const int K = g.K, nt = K / BK;
    unsigned voffA[2], voffB[2];
#pragma unroll
    for (int i = 0; i < 2; ++i) { int R, C; stage_rc(tid * 16 + i * 8192, R, C); const int Rb = Epi::PERM ? ((R & ~31) + perm32(R & 31)) : R;
        voffA[i] = (unsigned)(R * K + C) * 2u; voffB[i] = (unsigned)(Rb * K + C) * 2u; }
    const size_t kstep = (size_t)(BK * 2);
    const size_t hstep = (size_t)HALF * K * 2;
    const size_t tstep = 2 * hstep;
    const unsigned ldsw = (unsigned)wid * 1024u;
    const int aoff = lds_byte(wr * 64 + fr, fq * 8), boff = lds_byte(wc * 32 + fr, fq * 8);
#define PG8_SA(b, h) (((b) * 2 + (h)) * HTB)
#define PG8_SB(b, h) ((4 + (b) * 2 + (h)) * HTB)
#define PG8_STAGE(bufoff, gbase, voff) do { _Pragma("unroll") for (int _i = 0; _i < 2; ++_i) \
        __builtin_amdgcn_global_load_lds((const unsigned*)((const char*)(gbase) + (voff)[_i]), (PG8_LAS unsigned*)(lds + (bufoff) + ldsw + _i * 8192), 16, 0, 0); } while (0)
#define PG8_LDA(dst, b, h) do { _Pragma("unroll") for (int m = 0; m < 4; ++m) _Pragma("unroll") for (int k = 0; k < 2; ++k) dst[m][k] = *(const PG8_LAS bf16x8*)(lds + PG8_SA(b, h) + aoff + m * 2048 + k * 1024); } while (0)
#define PG8_LDB(dst, b, h) do { _Pragma("unroll") for (int n = 0; n < 2; ++n) _Pragma("unroll") for (int k = 0; k < 2; ++k) dst[n][k] = *(const PG8_LAS bf16x8*)(lds + PG8_SB(b, h) + boff + n * 2048 + k * 1024); } while (0)
#define PG8_MMA(ai, bj, At, Bt) do { __builtin_amdgcn_s_setprio(1); _Pragma("unroll") for (int m = 0; m < 4; ++m) _Pragma("unroll") for (int n = 0; n < 2; ++n) _Pragma("unroll") for (int k = 0; k < 2; ++k) \
        acc[ai][bj][m][n] = __builtin_amdgcn_mfma_f32_16x16x32_bf16(Bt[n][k], At[m][k], acc[ai][bj][m][n], 0, 0, 0); __builtin_amdgcn_s_setprio(0); } while (0)
#define PG8_WAIT_V(n) asm volatile("s_waitcnt vmcnt(" #n ")" ::: "memory")
#define PG8_WAIT_L(n) asm volatile("s_waitcnt lgkmcnt(" #n ")" ::: "memory")
#define PG8_BAR __builtin_amdgcn_s_barrier()
#define PG8_SCHED __builtin_amdgcn_sched_barrier(0)
    Unit2 cur, nxt; int ui = 0;
    if (!S.next(0, cur)) return;
    f32x4 acc[2][2][4][2];
#pragma unroll
    for (int a = 0; a < 2; ++a)
#pragma unroll
        for (int b = 0; b < 2; ++b)
#pragma unroll
            for (int m = 0; m < 4; ++m)
#pragma unroll
                for (int n = 0; n < 2; ++n) acc[a][b][m][n] = (f32x4){0.f, 0.f, 0.f, 0.f};
    bf16x8 At[4][2], B0[2][2], B1[2][2];
    const char* cA = (const char*)(cur.sub ? g.A2 : g.A1) + (size_t)cur.pm * tstep; const char* cB = (const char*)(cur.sub ? g.Bt2 : g.Bt1) + (size_t)cur.pn * tstep;
    S.a_ready(cur);
    if constexpr (SP2) {
        PG8_STAGE(PG8_SB(0, 0), cB, voffB); PG8_STAGE(PG8_SB(0, 1), cB + hstep, voffB); PG8_STAGE(PG8_SA(0, 0), cA, voffA); PG8_STAGE(PG8_SA(0, 1), cA + hstep, voffA);
        if (wr == 1) PG8_BAR;
        PG8_WAIT_V(2); PG8_BAR;
        PG8_STAGE(PG8_SB(1, 0), cB + kstep, voffB); PG8_STAGE(PG8_SA(1, 0), cA + kstep, voffA); PG8_STAGE(PG8_SB(1, 1), cB + hstep + kstep, voffB);
        PG8_WAIT_V(6); PG8_BAR;
    } else {
        PG8_STAGE(PG8_SB(0, 0), cB, voffB); PG8_STAGE(PG8_SA(0, 0), cA, voffA); PG8_STAGE(PG8_SB(0, 1), cB + hstep, voffB); PG8_STAGE(PG8_SA(0, 1), cA + hstep, voffA);
        if (wr == 1) PG8_BAR;
        PG8_WAIT_V(4); PG8_BAR;
        PG8_STAGE(PG8_SB(1, 0), cB + kstep, voffB); PG8_STAGE(PG8_SA(1, 0), cA + kstep, voffA); PG8_STAGE(PG8_SB(1, 1), cB + hstep + kstep, voffB);
        PG8_WAIT_V(6); PG8_BAR;
    }
    for (;;) {
        const bool has_next = S.next(ui + 1, nxt);
        const char* nA = has_next ? (const char*)(nxt.sub ? g.A2 : g.A1) + (size_t)nxt.pm * tstep : cA; const char* nB = has_next ? (const char*)(nxt.sub ? g.Bt2 : g.Bt1) + (size_t)nxt.pn * tstep : cB;
        for (int t = 0; t < nt; t += 2) {
            const bool last = (t == nt - 2);
            const char* a1 = cA + (size_t)(t + 1) * kstep;
            const char* a2 = last ? nA : cA + (size_t)(t + 2) * kstep; const char* b2 = last ? nB : cB + (size_t)(t + 2) * kstep;
            const char* a3 = a2 + kstep; const char* b3 = b2 + kstep;
            if (last && has_next) S.a_ready(nxt);
            if constexpr (SP2) {
            PG8_LDB(B0, 0, 0); PG8_LDB(B1, 0, 1); PG8_SCHED; PG8_LDA(At, 0, 0); PG8_STAGE(PG8_SA(1, 1), a1 + hstep, voffA);
            PG8_WAIT_V(8); PG8_WAIT_L(0); PG8_BAR; PG8_MMA(0, 0, At, B0); PG8_MMA(0, 1, At, B1); PG8_BAR; PG8_SCHED;
            PG8_LDA(At, 0, 1); PG8_STAGE(PG8_SB(0, 0), b2, voffB); PG8_STAGE(PG8_SB(0, 1), b2 + hstep, voffB); PG8_STAGE(PG8_SA(0, 0), a2, voffA);
            PG8_WAIT_V(8); PG8_WAIT_L(0); PG8_BAR; PG8_MMA(1, 0, At, B0); PG8_MMA(1, 1, At, B1); PG8_BAR; PG8_SCHED;
            PG8_LDB(B0, 1, 0); PG8_LDB(B1, 1, 1); PG8_SCHED; PG8_LDA(At, 1, 0); PG8_STAGE(PG8_SA(0, 1), a2 + hstep, voffA);
            PG8_WAIT_V(8); PG8_WAIT_L(0); PG8_BAR; PG8_MMA(0, 0, At, B0); PG8_MMA(0, 1, At, B1); PG8_BAR; PG8_SCHED;
            PG8_LDA(At, 1, 1); PG8_STAGE(PG8_SB(1, 0), b3, voffB); PG8_STAGE(PG8_SB(1, 1), b3 + hstep, voffB); PG8_STAGE(PG8_SA(1, 0), a3, voffA);
            PG8_WAIT_V(8); PG8_WAIT_L(0); PG8_BAR; PG8_MMA(1, 0, At, B0); PG8_MMA(1, 1, At, B1); PG8_BAR; PG8_SCHED;
            } else {
            PG8_LDB(B0, 0, 0); PG8_SCHED; PG8_LDA(At, 0, 0); PG8_STAGE(PG8_SA(1, 1), a1 + hstep, voffA);
            PG8_WAIT_L(8); PG8_BAR; PG8_WAIT_L(0); PG8_MMA(0, 0, At, B0); PG8_BAR; PG8_SCHED;
            PG8_LDB(B1, 0, 1); PG8_STAGE(PG8_SB(0, 0), b2, voffB);
            PG8_BAR; PG8_WAIT_L(0); PG8_MMA(0, 1, At, B1); PG8_BAR;
            PG8_LDA(At, 0, 1); PG8_STAGE(PG8_SA(0, 0), a2, voffA);
            PG8_BAR; PG8_WAIT_L(0); PG8_MMA(1, 0, At, B0); PG8_BAR; PG8_SCHED;
            PG8_STAGE(PG8_SB(0, 1), b2 + hstep, voffB);
            PG8_WAIT_V(6); PG8_BAR; PG8_MMA(1, 1, At, B1); PG8_BAR;
            PG8_LDB(B0, 1, 0); PG8_SCHED; PG8_LDA(At, 1, 0); PG8_STAGE(PG8_SA(0, 1), a2 + hstep, voffA);
            PG8_WAIT_L(8); PG8_BAR; PG8_WAIT_L(0); PG8_MMA(0, 0, At, B0); PG8_BAR; PG8_SCHED;
            PG8_LDB(B1, 1, 1); PG8_STAGE(PG8_SB(1, 0), b3, voffB);
            PG8_BAR; PG8_WAIT_L(0); PG8_MMA(0, 1, At, B1); PG8_BAR;
            PG8_LDA(At, 1, 1); PG8_STAGE(PG8_SA(1, 0), a3, voffA);
            PG8_BAR; PG8_WAIT_L(0); PG8_MMA(1, 0, At, B0); PG8_BAR; PG8_SCHED;
            PG8_STAGE(PG8_SB(1, 1), b3 + hstep, voffB);
            PG8_WAIT_V(6); PG8_BAR; PG8_MMA(1, 1, At, B1); PG8_BAR;
            }
        }
        if constexpr (ALIGN_EPI) { if (wr == 0) PG8_BAR; }
        if constexpr (!Epi::AFTER_DRAIN) { E(acc, cur, wr, wc, fr, fq); S.done(cur); }
        if (!has_next) break;
        if (cur.sub) {
#pragma unroll
        for (int a = 0; a < 2; ++a)
#pragma unroll
            for (int b = 0; b < 2; ++b)
#pragma unroll
                for (int m = 0; m < 4; ++m)
#pragma unroll
                    for (int n = 0; n < 2; ++n) acc[a][b][m][n] = (f32x4){0.f, 0.f, 0.f, 0.f};
        }
        cur = nxt; cA = nA; cB = nB; ++ui;
        if constexpr (ALIGN_EPI) { if (wr == 1) PG8_BAR; }
    }
    PG8_WAIT_V(0);
    if constexpr (!ALIGN_EPI) { if (wr == 0) PG8_BAR; }
    PG8_BAR;
    if constexpr (Epi::AFTER_DRAIN) { E.fused(acc, cur, wr, wc, fr, fq, lds, wid, lane); S.done(cur); }
#undef PG8_SA
#undef PG8_SB
#undef PG8_STAGE
#undef PG8_LDA
#undef PG8_LDB
#undef PG8_MMA
#undef PG8_WAIT_V
#undef PG8_WAIT_L
#undef PG8_BAR
#undef PG8_SCHED
}
}
#define XB_TMO      128
#define XB_XCNT(j)  (256  + 64 * (j))
#define XB_XSUB(j)  (1280 + 64 * (j))
#define XB_XGEN(j)  (2304 + 64 * (j))
#define XB_TOP      3328
#define XB_TOPGEN   3392
#define XCD_BAR_WORDS 3456
#define XB_SPIN_CAP (1u << 18)

__device__ __forceinline__ unsigned xb_ld(unsigned* p)              { return __hip_atomic_load(p, __ATOMIC_RELAXED, __HIP_MEMORY_SCOPE_AGENT); }
__device__ __forceinline__ unsigned xb_add(unsigned* p, unsigned v) { return __hip_atomic_fetch_add(p, v, __ATOMIC_RELAXED, __HIP_MEMORY_SCOPE_AGENT); }
__device__ __forceinline__ unsigned xb_xcc_id() { return (unsigned)__builtin_amdgcn_s_getreg((3 << 11) | 20) & 0xFu; }
#define XB_SPIN(cond, bar) do { unsigned _sp = 0; while (cond) { __builtin_amdgcn_s_sleep(1); \
    if ((++_sp & 255u) == 0u) { if (xb_ld(&(bar)[XB_TMO])) break; if (_sp > XB_SPIN_CAP) { atomicAdd(&(bar)[XB_TMO], 1u); break; } } } } while (0)

struct XcdBarrier {
    unsigned* bar; unsigned x; bool w0;
    volatile LAS unsigned* st;
};

__device__ __forceinline__ XcdBarrier xcd_barrier_post(bool wave0, unsigned* bar, volatile LAS unsigned* st) {
    XcdBarrier b; b.bar = bar; b.x = xb_xcc_id(); b.st = st; b.w0 = wave0;
    if (wave0 && pg8::lane_now() == 0) (void)xb_add(&bar[XB_XCNT(b.x)], 1u);
    return b;
}
__device__ __forceinline__ void xcd_barrier_complete(unsigned* bar, unsigned x, unsigned& nloc, unsigned& nx) {
    const unsigned G = gridDim.x * gridDim.y * gridDim.z;
    unsigned sum, cnt, mine, sp = 0u;
    for (;;) {
        sum = 0u; cnt = 0u; mine = 0u;
#pragma unroll
        for (unsigned j = 0; j < 16; ++j) { const unsigned c = xb_ld(&bar[XB_XCNT(j)]); sum += c; cnt += (c > 0u) ? 1u : 0u; mine = (j == x) ? c : mine; }
        if (sum == G) break;
        __builtin_amdgcn_s_sleep(1);
        if ((++sp & 255u) == 0u) { if (xb_ld(&bar[XB_TMO])) break; if (sp > XB_SPIN_CAP) { atomicAdd(&bar[XB_TMO], 1u); break; } }
    }
    nloc = mine > 0u ? mine : 1u; nx = cnt > 0u ? cnt : 1u;
}

__device__ __forceinline__ void xcd_barrier(const XcdBarrier& b) {
    asm volatile("s_waitcnt vmcnt(0)" ::: "memory");
    __syncthreads();
    if (b.w0 && pg8::lane_now() == 0) {
        unsigned* bar = b.bar;
        __builtin_amdgcn_s_waitcnt(0);
        unsigned nloc = b.st[0], nx = b.st[1];
        if (nloc == 0u) { xcd_barrier_complete(bar, b.x, nloc, nx); b.st[0] = nloc; b.st[1] = nx; }
        const unsigned old = xb_add(&bar[XB_XSUB(b.x)], 1u);
        const unsigned gen = old / nloc;
        if (old + 1u == (gen + 1u) * nloc) {
            __builtin_amdgcn_fence(__ATOMIC_RELEASE, "agent");
            asm volatile("s_waitcnt vmcnt(0)" ::: "memory");
            const unsigned og = xb_add(&bar[XB_TOP], 1u);
            const unsigned tg = og / nx;
            if (og + 1u == (tg + 1u) * nx) xb_add(&bar[XB_TOPGEN], 1u);
            else XB_SPIN(xb_ld(&bar[XB_TOPGEN]) == tg, bar);
            __builtin_amdgcn_fence(__ATOMIC_ACQUIRE, "agent");
            xb_add(&bar[XB_XGEN(b.x)], 1u);
            asm volatile("s_waitcnt vmcnt(0)" ::: "memory");
        } else {
            XB_SPIN(xb_ld(&bar[XB_XGEN(b.x)]) == gen, bar);
            __builtin_amdgcn_fence(__ATOMIC_ACQUIRE, "agent");
            asm volatile("s_waitcnt vmcnt(0)" ::: "memory");
        }
    }
    __syncthreads();
}
using pg8::f32x4; using pg8::Unit; using pg8::lane_now;
typedef unsigned u32x4 __attribute__((ext_vector_type(4)));
typedef unsigned u32x2 __attribute__((ext_vector_type(2)));
constexpr int NWAVES = 8, NTHR = 512;
constexpr int LDS_BYTES = 147456;
constexpr int LDSCTL_OFF = LDS_BYTES - 256;
constexpr size_t WS_CTL = 0, CTL_ZERO_BYTES = 64 * 1024;
#define LDS_WAIT() asm volatile("s_waitcnt lgkmcnt(0)" ::: "memory")
typedef float f32x2_t __attribute__((ext_vector_type(2))); typedef __bf16 bf16x2_t __attribute__((ext_vector_type(2)));
DI unsigned cvtpk(float lo, float hi) { f32x2_t v = {lo, hi}; bf16x2_t b = __builtin_convertvector(v, bf16x2_t); return __builtin_bit_cast(unsigned, b); }
#ifndef NT_STORES
#define NT_STORES 0
#endif
DI void st16(void* p, const u32x4& v) { if (NT_STORES) __builtin_nontemporal_store(v, (u32x4*)p); else *(u32x4*)p = v; }
DI void st16f(void* p, const f32x4& v) { if (NT_STORES) __builtin_nontemporal_store(v, (f32x4*)p); else *(f32x4*)p = v; }
DI void st8(void* p, const u32x2& v) { if (NT_STORES) __builtin_nontemporal_store(v, (u32x2*)p); else *(u32x2*)p = v; }
DI float fsig(float x) { return __builtin_amdgcn_rcpf(1.f + __expf(-x)); }
DI float fsig2(float y) { return __builtin_amdgcn_rcpf(1.f + __builtin_amdgcn_exp2f(y)); }
DI u32x4 pack8(const f32x4& a, const f32x4& b) { u32x4 w; w.x = cvtpk(a[0], a[1]); w.y = cvtpk(a[2], a[3]); w.z = cvtpk(b[0], b[1]); w.w = cvtpk(b[2], b[3]); return w; }
DI u32x2 pack4(const f32x4& a) { u32x2 w; w.x = cvtpk(a[0], a[1]); w.y = cvtpk(a[2], a[3]); return w; }
DI void unpack8(const u32x4& w, f32x4& a, f32x4& b) {
    a[0] = __uint_as_float(w.x << 16); a[1] = __uint_as_float(w.x & 0xffff0000u); a[2] = __uint_as_float(w.y << 16); a[3] = __uint_as_float(w.y & 0xffff0000u);
    b[0] = __uint_as_float(w.z << 16); b[1] = __uint_as_float(w.z & 0xffff0000u); b[2] = __uint_as_float(w.w << 16); b[3] = __uint_as_float(w.w & 0xffff0000u); }


DI size_t xn_slot(int pm, int pn, int wave, int lane) { return ((size_t)((pm * 4 + pn) * 8 + wave) * 16 * 64 + lane) * 8; }
DI float sum_rows4(float x) {
    unsigned a = __builtin_bit_cast(unsigned, x);
    u32x2 r = __builtin_amdgcn_permlane16_swap(a, a, false, false);
    unsigned rx = r.x, ry = r.y; asm volatile("" : "+v"(rx), "+v"(ry));
    x = __builtin_bit_cast(float, rx) + __builtin_bit_cast(float, ry);
    a = __builtin_bit_cast(unsigned, x);
    r = __builtin_amdgcn_permlane32_swap(a, a, false, false);
    rx = r.x; ry = r.y; asm volatile("" : "+v"(rx), "+v"(ry));
    return __builtin_bit_cast(float, rx) + __builtin_bit_cast(float, ry); }
struct EpiInproj {
    static constexpr bool PERM = false, AFTER_DRAIN = false;
    unsigned char* ws; const float *b_gates, *qn_g, *kn_g; bf16* MG;
    DI void operator()(const f32x4 (&acc)[2][2][4][2], const Unit& u, int wr, int wc, int fr, int fq) const {
        const int pn = u.pn; const bool lat = u.pm < M_LAT / 256;
        const int row0 = u.pm * 256 + wr * 64 + fr;
        if (pn < 4) {
            const bool isq = pn < 2; bf16* __restrict__ T = (bf16*)(ws + (isq ? WS_QA : WS_KA)); const int tcol = 256 * (pn & 1) + 64 * wc + 4 * fq;
            const float* __restrict__ rope = (const float*)(ws + WS_ROPE);     const float sc = isq ? 0.125f : 1.f;
#pragma unroll
            for (int ai = 0; ai < 2; ++ai)
#pragma unroll
                for (int m = 0; m < 4; ++m) { const int row = row0 + ai * 128 + m * 16; bf16* rp = T + (size_t)row * 512 + tcol;
                    const int t = row & (SEQ - 1);
#pragma unroll
                    for (int bj = 0; bj < 2; ++bj) { f32x4 cs = {1.f, 1.f, 1.f, 1.f}, sn = {0.f, 0.f, 0.f, 0.f};
                        if (lat) { const int pos = bj ? (t & 63) : (t >> 6); cs = *(const f32x4*)(rope + pos * 32 + 4 * fq); sn = *(const f32x4*)(rope + pos * 32 + 16 + 4 * fq); }
                        const f32x4 x1 = acc[ai][bj][m][0], x2 = acc[ai][bj][m][1];
                        const f32x4 o1 = (x1 * cs - x2 * sn) * sc, o2 = (x2 * cs + x1 * sn) * sc;
                        st8(rp + 32 * bj, pack4(o1)); st8(rp + 32 * bj + 16, pack4(o2)); } }
        } else if (pn < 8 || (pn >= 20 && pn < 24)) {
            bf16* T = (bf16*)(ws + (pn < 8 ? WS_VA : WS_VB)); const int tcol = 256 * (pn & 3) + 64 * wc + 8 * fq;
#pragma unroll
            for (int ai = 0; ai < 2; ++ai)
#pragma unroll
                for (int m = 0; m < 4; ++m) { bf16* rp = T + (size_t)(row0 + ai * 128 + m * 16) * 1024 + tcol;
#pragma unroll
                    for (int bj = 0; bj < 2; ++bj) st16(rp + 32 * bj, pack8(acc[ai][bj][m][0], acc[ai][bj][m][1])); }
        } else if (pn < 12) {
            if (!lat) return;
            bf16* T = (bf16*)(ws + WS_OA); const int hd = 2 * (pn & 3) + (wc >> 1);
#pragma unroll
            for (int ai = 0; ai < 2; ++ai)
#pragma unroll
                for (int m = 0; m < 4; ++m) { const int R = row0 + ai * 128 + m * 16, tk = R & 127;
                    bf16* rp = T + ((size_t)(R >> 7) * 8 + hd) * 16384 + ((tk >> 4) * 8 * 64 + (tk & 15) + 32 * (fq & 1)) * 4;
#pragma unroll
                    for (int bj = 0; bj < 2; ++bj) { f32x4 a = acc[ai][bj][m][0], b = acc[ai][bj][m][1];
#pragma unroll
                        for (int j = 0; j < 4; ++j) { a[j] = fsig2(a[j]); b[j] = fsig2(b[j]); }
                        bf16* dp = rp + (4 * (wc & 1) + 2 * bj + (fq >> 1)) * 256;
                        st8(dp, pack4(a)); st8(dp + 64, pack4(b)); } }
        } else if (pn < 20) {
            const bool isq = pn < 16; if (isq && !lat) return;
            bf16* T = (bf16*)(ws + (isq ? WS_QB : WS_KB)); const int tcol = 256 * (pn & 3) + 64 * wc + 8 * fq;
            const float* g = isq ? qn_g : kn_g; const float sc = isq ? 0.125f * 1.44269504f : 1.f;
            f32x4 gv[2][2];
#pragma unroll
            for (int bj = 0; bj < 2; ++bj)
#pragma unroll
                for (int n = 0; n < 2; ++n) gv[bj][n] = *(const f32x4*)(g + 32 * bj + 8 * fq + 4 * n) * sc;
#pragma unroll
            for (int ai = 0; ai < 2; ++ai)
#pragma unroll
                for (int m = 0; m < 4; ++m) { bf16* rp = T + (size_t)(row0 + ai * 128 + m * 16) * 1024 + tcol;
                    float ss = 0.f;
#pragma unroll
                    for (int bj = 0; bj < 2; ++bj)
#pragma unroll
                        for (int n = 0; n < 2; ++n) { const f32x4 v = acc[ai][bj][m][n]; ss += (v[0] * v[0] + v[1] * v[1]) + (v[2] * v[2] + v[3] * v[3]); }
                    ss = sum_rows4(ss);
                    const float rs = rsqrtf(ss * (1.f / 64.f) + EPS);
#pragma unroll
                    for (int bj = 0; bj < 2; ++bj) st16(rp + 32 * bj, pack8(acc[ai][bj][m][0] * rs * gv[bj][0], acc[ai][bj][m][1] * rs * gv[bj][1])); }
        } else if (pn >= 25) {
            if (!lat) return;
            const int tcol = 256 * (pn - 25) + 64 * wc + 8 * fq;
#pragma unroll
            for (int ai = 0; ai < 2; ++ai)
#pragma unroll
                for (int m = 0; m < 4; ++m) { bf16* rp = MG + (size_t)(row0 + ai * 128 + m * 16) * 2048 + tcol;
#pragma unroll
                    for (int bj = 0; bj < 2; ++bj) { f32x4 a = acc[ai][bj][m][0], b = acc[ai][bj][m][1];
#pragma unroll
                        for (int j = 0; j < 4; ++j) { a[j] = fsig2(a[j]); b[j] = fsig2(b[j]); }
                        st16(rp + 32 * bj, pack8(a, b)); } }
        } else {
            if (wc != 0) return;
            float* G = (float*)(ws + WS_GATES);
#pragma unroll
            for (int n = 0; n < 2; ++n) { int g0 = 16 * n + 4 * fq; asm volatile("" : "+v"(g0));
                const f32x4 bias = *(const f32x4*)(b_gates + g0); const bool lf = (g0 >> 3) & 1;
#pragma unroll
                for (int ai = 0; ai < 2; ++ai)
#pragma unroll
                    for (int m = 0; m < 4; ++m) { f32x4 v = acc[ai][0][m][n] + bias;
#pragma unroll
                        for (int j = 0; j < 4; ++j) { const float cp = GCAP * tanhf(v[j] * (1.f / GCAP)); v[j] = lf ? logsigmoidf_(cp) : cp; }
#pragma unroll
                        for (int j = 0; j < 4; ++j) G[(size_t)(g0 + j) * M_ALL + row0 + ai * 128 + m * 16] = v[j]; } }
        }
    }
};
struct EpiMG {
    static constexpr bool PERM = false, AFTER_DRAIN = false;
    bf16* MG; int mask;
    DI void operator()(const f32x4 (&acc)[2][2][4][2], const Unit& u, int wr, int wc, int fr, int fq) const {
        if (!((mask >> u.pn) & 1)) return;
        const int row0 = u.pm * 256 + wr * 64 + fr, tcol = 256 * u.pn + 64 * wc + 8 * fq;
#pragma unroll
        for (int ai = 0; ai < 2; ++ai)
#pragma unroll
            for (int m = 0; m < 4; ++m) { bf16* rp = MG + (size_t)(row0 + ai * 128 + m * 16) * 2048 + tcol;
#pragma unroll
                for (int bj = 0; bj < 2; ++bj) { f32x4 a = acc[ai][bj][m][0], b = acc[ai][bj][m][1];
#pragma unroll
                    for (int j = 0; j < 4; ++j) { a[j] = fsig(a[j]); b[j] = fsig(b[j]); }
                    st16(rp + 32 * bj, pack8(a, b)); } }
    }
};
template <bool SECOND> struct EpiMerge {
    static constexpr bool PERM = false, AFTER_DRAIN = false;
    const bf16* MG; bf16* TMP; bf16* T1;
    DI void operator()(const f32x4 (&acc)[2][2][4][2], const Unit& u, int wr, int wc, int fr, int fq) const {
        const int row0 = u.pm * 256 + wr * 64 + fr, tcol = 256 * u.pn + 64 * wc + 8 * fq;
#pragma unroll
        for (int ai = 0; ai < 2; ++ai)
#pragma unroll
            for (int m = 0; m < 4; ++m) { const size_t row = row0 + ai * 128 + m * 16;
#pragma unroll
                for (int bj = 0; bj < 2; ++bj) { const int col = tcol + 32 * bj;
                    f32x4 ga, gb; unpack8(*(const u32x4*)(MG + row * 2048 + (SECOND ? 1024 : 0) + col), ga, gb);
                    bf16* tp = TMP + row * 1024 + col;
                    if (!SECOND) { *(u32x4*)tp = pack8(ga * acc[ai][bj][m][0], gb * acc[ai][bj][m][1]); }
                    else { f32x4 t0, t1; unpack8(*(const u32x4*)tp, t0, t1);
                        st16(T1 + row * 1024 + col, pack8(t0 + ga * acc[ai][bj][m][0], t1 + gb * acc[ai][bj][m][1])); } } }
    }
};
struct MergeOrder {
    pg8::StaticOrder so;
    __device__ __forceinline__ bool next(int i, pg8::Unit2& u) const { Unit t; if (!so.next(i >> 1, t)) return false; u.pm = t.pm; u.pn = t.pn; u.sub = i & 1; return true; }
    __device__ __forceinline__ void a_ready(const pg8::Unit2&) const {}
    __device__ __forceinline__ void done(const pg8::Unit2&) const {}
};
struct EpiMerge2 {
    static constexpr bool PERM = false, AFTER_DRAIN = false;
    const bf16* MG; bf16* T1;
    DI void operator()(f32x4 (&acc)[2][2][4][2], const pg8::Unit2& u, int wr, int wc, int fr, int fq) const {
        const int row0 = u.pm * 256 + wr * 64 + fr, tcol = 256 * u.pn + 64 * wc + 8 * fq;
        const bf16* __restrict__ MG = this->MG; bf16* __restrict__ T1 = this->T1;
#pragma unroll
        for (int ai = 0; ai < 2; ++ai)
#pragma unroll
            for (int m = 0; m < 4; ++m) { const size_t row = row0 + ai * 128 + m * 16;
#pragma unroll
                for (int bj = 0; bj < 2; ++bj) { const int col = tcol + 32 * bj;
                    f32x4 b0, b1; unpack8(*(const u32x4*)(MG + row * 2048 + 1024 + col), b0, b1);
                    if (u.sub == 0) { f32x4 a0, a1; unpack8(*(const u32x4*)(MG + row * 2048 + col), a0, a1);
#pragma unroll
                        for (int j = 0; j < 4; ++j) { acc[ai][bj][m][0][j] *= a0[j] * __builtin_amdgcn_rcpf(b0[j]); acc[ai][bj][m][1][j] *= a1[j] * __builtin_amdgcn_rcpf(b1[j]); }
                    } else st16(T1 + row * 1024 + col, pack8(acc[ai][bj][m][0] * b0, acc[ai][bj][m][1] * b1)); } }
    }
};
struct EpiOut {
    static constexpr bool PERM = false, AFTER_DRAIN = false;
    const float* x; bf16* XN; bf16* XS; float* sumsq; const float* modv; const float* norm2_g;
    DI void operator()(const f32x4 (&acc)[2][2][4][2], const Unit& u, int wr, int wc, int fr, int fq) const {
        const int row0 = u.pm * 256 + wr * 64 + fr, tcol = 256 * u.pn + 64 * wc + 8 * fq, b = u.pm >> 5;
        const float* mv = modv + b * 6144;
        f32x4 g1[2][2], s2[2][2];
#pragma unroll
        for (int bj = 0; bj < 2; ++bj)
#pragma unroll
            for (int n = 0; n < 2; ++n) { const int col = tcol + 32 * bj + 4 * n; g1[bj][n] = *(const f32x4*)(mv + 2048 + col); s2[bj][n] = *(const f32x4*)(norm2_g + col) * (*(const f32x4*)(mv + 4096 + col) + 1.f); }
        f32x4 xv[8][4];
#define EPIOUT_LOAD(gi) do { const size_t r_ = row0 + ((gi) >> 2) * 128 + ((gi) & 3) * 16; _Pragma("unroll") for (int bj = 0; bj < 2; ++bj) { const size_t o_ = r_ * 1024 + tcol + 32 * bj; xv[gi][2 * bj] = *(const f32x4*)(x + o_); xv[gi][2 * bj + 1] = *(const f32x4*)(x + o_ + 4); } } while (0)
        EPIOUT_LOAD(0); EPIOUT_LOAD(1);
#pragma unroll
        for (int gi = 0; gi < 8; ++gi) { const int ai = gi >> 2, m = gi & 3; const size_t row = row0 + ai * 128 + m * 16; float ss = 0.f;
            if (gi + 2 < 8) EPIOUT_LOAD(gi + 2);
#pragma unroll
            for (int bj = 0; bj < 2; ++bj) { const size_t o = row * 1024 + tcol + 32 * bj;
                const f32x4 x0 = xv[gi][2 * bj] + g1[bj][0] * acc[ai][bj][m][0], x1 = xv[gi][2 * bj + 1] + g1[bj][1] * acc[ai][bj][m][1];
                st16(XN + xn_slot(u.pm, u.pn, wr * 4 + wc, 16 * fq + fr) + (gi * 2 + bj) * 512, pack8(x0, x1));
                st16(XS + o, pack8(x0 * s2[bj][0], x1 * s2[bj][1]));
                ss += (x0[0] * x0[0] + x0[1] * x0[1]) + (x0[2] * x0[2] + x0[3] * x0[3]) + (x1[0] * x1[0] + x1[1] * x1[1]) + (x1[2] * x1[2] + x1[3] * x1[3]); }
            ss = sum_rows4(ss);
            if (fq == 0) atomicAdd(sumsq + row, ss); }
#undef EPIOUT_LOAD
    }
};
struct EpiFfn1 {
    static constexpr bool PERM = false, AFTER_DRAIN = false;
    bf16* HFF; const float* sumsq; const float* bgu;
    DI void operator()(const f32x4 (&acc)[2][2][4][2], const Unit& u, int wr, int wc, int fr, int fq) const {
        const int row0 = u.pm * 256 + wr * 64 + fr, hcol = 128 * u.pn + 32 * wc + 8 * fq, b = u.pm >> 5;
        const float* bg = bgu + (size_t)b * 2 * DFF + hcol; const float* bu = bg + DFF;
        const f32x4 bg0 = *(const f32x4*)bg * -1.44269504f, bg1 = *(const f32x4*)(bg + 4) * -1.44269504f, bu0 = *(const f32x4*)bu * -0.693147181f, bu1 = *(const f32x4*)(bu + 4) * -0.693147181f;
        float rsv[8];
#pragma unroll
        for (int gi = 0; gi < 8; ++gi) rsv[gi] = rsqrtf(sumsq[row0 + (gi >> 2) * 128 + (gi & 3) * 16] * (1.f / DM) + EPS);
#pragma unroll
        for (int ai = 0; ai < 2; ++ai)
#pragma unroll
            for (int m = 0; m < 4; ++m) { const size_t row = row0 + ai * 128 + m * 16;
                const float rs = rsv[ai * 4 + m];
                const float rg = rs * -1.44269504f, ru = rs * -0.693147181f;
                f32x4 g0 = acc[ai][0][m][0] * rg + bg0, g1 = acc[ai][0][m][1] * rg + bg1; const f32x4 u0 = acc[ai][1][m][0] * ru + bu0, u1 = acc[ai][1][m][1] * ru + bu1;
#pragma unroll
                for (int j = 0; j < 4; ++j) { g0[j] = g0[j] * fsig2(g0[j]) * u0[j]; g1[j] = g1[j] * fsig2(g1[j]) * u1[j]; }
                st16(HFF + row * DFF + hcol, pack8(g0, g1)); }
    }
};
struct EpiFfn2 {
    static constexpr bool PERM = false, AFTER_DRAIN = false;
    float* out; const bf16* XN; const float* modv;
    DI void operator()(const f32x4 (&acc)[2][2][4][2], const Unit& u, int wr, int wc, int fr, int fq) const {
        const int row0 = u.pm * 256 + wr * 64 + fr, tcol = 256 * u.pn + 64 * wc + 8 * fq, b = u.pm >> 5;
        const float* mv = modv + b * 6144 + 5120;
        f32x4 g2[2][2];
#pragma unroll
        for (int bj = 0; bj < 2; ++bj)
#pragma unroll
            for (int n = 0; n < 2; ++n) g2[bj][n] = *(const f32x4*)(mv + tcol + 32 * bj + 4 * n);
        u32x4 xv[8][2];
#pragma unroll
        for (int gi = 0; gi < 8; ++gi)
#pragma unroll
            for (int bj = 0; bj < 2; ++bj) xv[gi][bj] = *(const u32x4*)(XN + xn_slot(u.pm, u.pn, wr * 4 + wc, 16 * fq + fr) + (gi * 2 + bj) * 512);
#pragma unroll
        for (int gi = 0; gi < 8; ++gi) { const int ai = gi >> 2, m = gi & 3; const size_t row = row0 + ai * 128 + m * 16;
#pragma unroll
            for (int bj = 0; bj < 2; ++bj) { float* o = out + row * 1024 + tcol + 32 * bj; f32x4 x0, x1; unpack8(xv[gi][bj], x0, x1);
                st16f(o, x0 + g2[bj][0] * acc[ai][bj][m][0]); st16f(o + 4, x1 + g2[bj][1] * acc[ai][bj][m][1]); } }
    }
};

#ifndef INPROJ_WGM
#define INPROJ_WGM 4
#endif
struct InprojOrder {
    int G, c;
    __device__ __forceinline__ bool next(int i, Unit& u) const {
        const int L = i * G + c; constexpr int nM = M_LAT / 256, nN = 33, nwg = nM * nN;
        if (L < nwg) { int wgid = L; { const int q = nwg / pg8::NXCD, r = nwg % pg8::NXCD, xcd = wgid % pg8::NXCD, off = wgid / pg8::NXCD; wgid = (xcd < r ? xcd * (q + 1) : r * (q + 1) + (xcd - r) * q) + off; }
            const int nig = INPROJ_WGM * nN, gid = wgid / nig, fm = gid * INPROJ_WGM; u.pm = fm + ((wgid % nig) % INPROJ_WGM); u.pn = (wgid % nig) / INPROJ_WGM; return true; }
        const int r = L - nwg; if (r >= 4 * 17) return false;
        const int t = r % 17; u.pm = nM + r / 17; u.pn = t < 8 ? t : t + 8; return true;
    }
    __device__ __forceinline__ void a_ready(const Unit&) const {}
    __device__ __forceinline__ void done(const Unit&) const {}
};

DI void conv_item(const float* W, int ldw, int L0, bool zero, bool perm8, bf16* dst, int K, int k0, LAS float* scr, int lane, float scale = 1.f) {
    f32x4 wv[8];
#pragma unroll
    for (int i = 0; i < 8; ++i) { const int kk = 8 * i + (lane >> 3); wv[i] = zero ? (f32x4){0.f, 0.f, 0.f, 0.f} : *(const f32x4*)(W + (size_t)(k0 + kk) * ldw + L0 + 4 * (lane & 7)); }
#pragma unroll
    for (int i = 0; i < 8; ++i) { const int kk = 8 * i + (lane >> 3);
#pragma unroll
        for (int j = 0; j < 4; ++j) scr[kk * 33 + 4 * (lane & 7) + j] = wv[i][j] * scale; }
    LDS_WAIT(); asm volatile("" ::: "memory");
    const int c = lane & 7;
#pragma unroll
    for (int jj = 0; jj < 4; ++jj) { const int i = (lane >> 3) + 8 * jj; const int src = perm8 ? (8 * ((i >> 2) & 3) + 4 * (i >> 4) + (i & 3)) : i;
        const LAS float* s = scr + (8 * c) * 33 + src;
        u32x4 o; o.x = cvtpk(s[0], s[33]); o.y = cvtpk(s[2 * 33], s[3 * 33]); o.z = cvtpk(s[4 * 33], s[5 * 33]); o.w = cvtpk(s[6 * 33], s[7 * 33]);
        *(u32x4*)(dst + (size_t)i * K + k0 + 8 * c) = o; }
    LDS_WAIT(); asm volatile("" ::: "memory");
}
DI int inproj_src_col(int pn) {
    return pn < 2 ? C_QA + 256 * pn : pn < 4 ? C_KA + 256 * (pn - 2) : pn < 8 ? C_VA + 256 * (pn - 4) : pn < 12 ? C_OA + 256 * (pn - 8) : pn < 16 ? C_QB + 256 * (pn - 12)
         : pn < 20 ? C_KB + 256 * (pn - 16) : pn < 24 ? C_VB + 256 * (pn - 20) : pn == 24 ? C_G : C_MG + 256 * (pn - 25);
}
#ifndef TAIL_CONV_LATE
#define TAIL_CONV_LATE 1
#endif
constexpr int INPROJ_UNITS = (M_LAT / 256) * 33 + 4 * 17;
constexpr int CI_WIN = 33 * 8 * 16, CI_SQ = 4 * 8 * 16, CI_GU = 22 * 8 * 16, CI_WD = 4 * 8 * 44, CI_TOTAL = CI_WIN + 3 * CI_SQ + CI_GU + CI_WD;
DI void phase_convert(const P& p, LAS unsigned char* lds, int gw, int ngw, int wave, int lane, int it_lo, int it_hi) {
    LAS float* scr = (LAS float*)(lds + wave * 16384);
    for (int it = it_lo + gw; it < it_hi; it += ngw) {
        int r = it;
        if (r < CI_WIN) { const int kb = r / 264, rem = r % 264, g8 = rem & 7, pn = rem >> 3, bj = g8 >> 2, wc = g8 & 3;
            const bool zero = pn == 24 && g8 != 0; const int L0 = pn == 24 ? C_G : inproj_src_col(pn) + 64 * wc + 32 * bj;
            conv_item(p.w_in, DIN, L0, zero, pn >= 4 && pn != 24, (bf16*)(p.ws + WS_WIN) + (size_t)(pn * 256 + 128 * bj + 32 * wc) * 1024, 1024, kb * 64, scr, lane,
                      ((pn >= 8 && pn < 12) || pn >= 25) ? -1.44269504f : 1.f); continue; }
        r -= CI_WIN;
        if (r < 3 * CI_SQ) { const int which = r / CI_SQ; r -= which * CI_SQ; const int kb = r >> 5, g8 = r & 7, pn = (r >> 3) & 3, bj = g8 >> 2, wc = g8 & 3;
            const float* W = which == 0 ? p.w_a : which == 1 ? p.w_b : p.w_o; bf16* D = (bf16*)(p.ws + (which == 0 ? WS_WA : which == 1 ? WS_WB : WS_WO));
            conv_item(W, 1024, 256 * pn + 64 * wc + 32 * bj, false, true, D + (size_t)(pn * 256 + 128 * bj + 32 * wc) * 1024, 1024, kb * 64, scr, lane); continue; }
        r -= 3 * CI_SQ;
        if (r < CI_GU) { const int kb = r / 176, rem = r % 176, g8 = rem & 7, pn = rem >> 3, bj = g8 >> 2, wc = g8 & 3;
            conv_item(bj ? p.w_fu : p.w_fg, DFF, 128 * pn + 32 * wc, false, true, (bf16*)(p.ws + WS_WGU) + (size_t)(pn * 256 + 128 * bj + 32 * wc) * 1024, 1024, kb * 64, scr, lane); continue; }
        r -= CI_GU;
        { const int kb = r >> 5, g = r & 31, g8 = g & 7, pn = g >> 3, bj = g8 >> 2, wc = g8 & 3;
            conv_item(p.w_fd, 1024, 256 * pn + 64 * wc + 32 * bj, false, true, (bf16*)(p.ws + WS_WD) + (size_t)(pn * 256 + 128 * bj + 32 * wc) * DFF, DFF, kb * 64, scr, lane); }
    }
}
template <int R> DI void gemv_task(const float* W, int ldw, int col0, const LAS float* A, LAS float* red, float* out, int ldo, const float* bias, int tid) {
    const int col = tid & 31, kg = tid >> 5;
    float acc[R];
#pragma unroll
    for (int r = 0; r < R; ++r) acc[r] = 0.f;
#pragma unroll 32
    for (int i = 0; i < 64; ++i) { const int k = kg + 16 * i; const float w = W[(size_t)k * ldw + col0 + col];
#pragma unroll
        for (int r = 0; r < R; ++r) acc[r] += A[r * 1024 + k] * w; }
#pragma unroll
    for (int r = 0; r < R; ++r) red[(kg * R + r) * 32 + col] = acc[r];
    __syncthreads();
    if (tid < R * 32) { const int r = tid >> 5, c = tid & 31; float s = bias ? bias[col0 + c] : 0.f;
#pragma unroll
        for (int g = 0; g < 16; ++g) s += red[(g * R + r) * 32 + c];
        out[(size_t)r * ldo + col0 + c] = s; }
    __syncthreads();
}
DI void phase_bgu(const P& p, int gw, int ngw, int lane) {
    const float* modv = (const float*)(p.ws + WS_MODV); const bf16* W = (const bf16*)(p.ws + WS_WGU);
    for (int np = gw; np < 2 * DFF; np += ngw) {
        const int pn = np >> 8, bj = (np >> 7) & 1, wc = (np >> 5) & 3, i = np & 31, hid = 128 * pn + 32 * wc + 8 * ((i >> 2) & 3) + 4 * (i >> 4) + (i & 3);
        const u32x4 w0 = *(const u32x4*)(W + (size_t)np * 1024 + 8 * lane), w1 = *(const u32x4*)(W + (size_t)np * 1024 + 512 + 8 * lane);
        f32x4 a0, a1, c0, c1; unpack8(w0, a0, a1); unpack8(w1, c0, c1);
#pragma unroll
        for (int b = 0; b < 4; ++b) { const float* sh = modv + b * 6144 + 3072;
            const f32x4 s0 = *(const f32x4*)(sh + 8 * lane), s1 = *(const f32x4*)(sh + 8 * lane + 4), s2 = *(const f32x4*)(sh + 512 + 8 * lane), s3 = *(const f32x4*)(sh + 516 + 8 * lane);
            const f32x4 pr = a0 * s0 + a1 * s1 + c0 * s2 + c1 * s3; float d = (pr[0] + pr[1]) + (pr[2] + pr[3]);
#pragma unroll
            for (int o = 1; o < 64; o <<= 1) d += __shfl_xor(d, o);
            if (lane == 0) ((float*)(p.ws + WS_BGU))[(size_t)(b * 2 + bj) * DFF + hid] = d; }
    }
}

typedef short bf16x8 __attribute__((ext_vector_type(8)));
typedef short s16x4 __attribute__((ext_vector_type(4)));
typedef short v4i16_t __attribute__((ext_vector_type(4)));
DI f32x4 mfma16(bf16x8 a, bf16x8 b, f32x4 c) { return __builtin_amdgcn_mfma_f32_16x16x32_bf16(a, b, c, 0, 0, 0); }
DI s16x4 tr4(const LAS unsigned char* p) { return __builtin_bit_cast(s16x4, __builtin_amdgcn_ds_read_tr16_b64_v4i16((LAS v4i16_t*)p)); }
DI bf16x8 cat8(s16x4 a, s16x4 b) { return __builtin_shufflevector(a, b, 0, 1, 2, 3, 4, 5, 6, 7); }
DI bf16x8 ldsb128(const LAS unsigned char* p) { return *(const LAS bf16x8*)p; }
DI bf16x8 packf8(const f32x4& a, const f32x4& b) { return __builtin_bit_cast(bf16x8, pack8(a, b)); }
DI bf16x8 tr_frag(const LAS unsigned char* img, int RS, int s, int c0, int lane) {
    const int g = lane >> 4, i = lane & 15;
    const LAS unsigned char* p = img + (32 * s + 4 * g + (i >> 2)) * RS + (c0 + 4 * (i & 3)) * 2;
    return cat8(tr4(p), tr4(p + 16 * RS));
}
DI float wave_incl_add(float v, int lane) {
#pragma unroll
    for (int o = 1; o < 64; o <<= 1) { const float t = __shfl_up(v, o); if (lane >= o) v += t; }
    return v; }
DI float wave_incl_max(float v, int lane) {
#pragma unroll
    for (int o = 1; o < 64; o <<= 1) { const float t = __shfl_up(v, o); if (lane >= o) v = fmaxf(v, t); }
    return v; }
DI float wave_incl_max_rev(float v, int lane) {
#pragma unroll
    for (int o = 1; o < 64; o <<= 1) { const float t = __shfl_down(v, o); if (lane + o < 64) v = fmaxf(v, t); }
    return v; }
DI float wave_max(float v) {
#pragma unroll
    for (int o = 1; o < 64; o <<= 1) v = fmaxf(v, __shfl_xor(v, o));
    return v; }
DI u32x4 pair_rows16(const u32x2& wa, const u32x2& wb) {
    const u32x2 px = __builtin_amdgcn_permlane16_swap(wa.x, wb.x, false, false), py = __builtin_amdgcn_permlane16_swap(wa.y, wb.y, false, false);
    return (u32x4){px.x, py.x, px.y, py.y}; }
DI int pair_col(int g) { return (g & 1) ? 4 * g + 12 : 4 * g; }
template <int CTRL, int RMASK> DI float dppf(float old, float src) { return __builtin_bit_cast(float, __builtin_amdgcn_update_dpp(__builtin_bit_cast(int, old), __builtin_bit_cast(int, src), CTRL, RMASK, 0xf, false)); }
DI float rdlane(float v, int l) { return __builtin_bit_cast(float, __builtin_amdgcn_readlane(__builtin_bit_cast(int, v), l)); }
DI float dpp_incl_add(float v) {
    v += dppf<0x111, 0xf>(0.f, v); v += dppf<0x112, 0xf>(0.f, v); v += dppf<0x114, 0xf>(0.f, v); v += dppf<0x118, 0xf>(0.f, v);
    v += dppf<0x142, 0xa>(0.f, v); v += dppf<0x143, 0xc>(0.f, v); return v; }
DI float dpp_incl_max(float v) {
    const float ng = -3.0e38f;
    v = fmaxf(v, dppf<0x111, 0xf>(ng, v)); v = fmaxf(v, dppf<0x112, 0xf>(ng, v)); v = fmaxf(v, dppf<0x114, 0xf>(ng, v)); v = fmaxf(v, dppf<0x118, 0xf>(ng, v));
    v = fmaxf(v, dppf<0x142, 0xa>(ng, v)); v = fmaxf(v, dppf<0x143, 0xc>(ng, v)); return v; }
DI float dpp_incl_max_rev(float v, int lane) {
    const float ng = -3.0e38f;
    v = fmaxf(v, dppf<0x101, 0xf>(ng, v)); v = fmaxf(v, dppf<0x102, 0xf>(ng, v)); v = fmaxf(v, dppf<0x104, 0xf>(ng, v)); v = fmaxf(v, dppf<0x108, 0xf>(ng, v));
    const float r1 = rdlane(v, 16), r2 = rdlane(v, 32), r3 = rdlane(v, 48);
    const float up = lane < 16 ? fmaxf(r1, fmaxf(r2, r3)) : lane < 32 ? fmaxf(r2, r3) : lane < 48 ? r3 : ng;
    return fmaxf(v, up); }
DI int chunk_row0(int b, int c) { return c < 2 ? M_LAT + b * CTX + 128 * c : b * SEQ + 128 * (c - 2); }

#ifndef NA_BATCH
#define NA_BATCH 8
#endif
constexpr int NA_RS = 144, NA_KOFF = 0, NA_VOFF = 480 * NA_RS, NA_RPB = 2 * 480 * NA_RS;
DI void na_keys(const LAS unsigned char* lds, int kbase, int q, int g, const bf16x8& bq0, const bf16x8& bq1, f32x4& s0, f32x4& s1) {
    const LAS unsigned char* kp = lds + NA_KOFF + (kbase + q) * NA_RS + 16 * g;
    s0 = mfma16(ldsb128(kp), bq0, (f32x4){0.f, 0.f, 0.f, 0.f}); s0 = mfma16(ldsb128(kp + 64), bq1, s0);
    s1 = mfma16(ldsb128(kp + 16 * NA_RS), bq0, (f32x4){0.f, 0.f, 0.f, 0.f}); s1 = mfma16(ldsb128(kp + 16 * NA_RS + 64), bq1, s1);
}
struct NaKF { bf16x8 a0, a1, b0, b1; };
DI void na_kload(const LAS unsigned char* lds, int kbase, int q, int g, NaKF& f) {
    const LAS unsigned char* kp = lds + NA_KOFF + (kbase + q) * NA_RS + 16 * g;
    f.a0 = ldsb128(kp); f.a1 = ldsb128(kp + 64); f.b0 = ldsb128(kp + 16 * NA_RS); f.b1 = ldsb128(kp + 16 * NA_RS + 64); }
DI void na_kmma(const NaKF& f, const bf16x8& bq0, const bf16x8& bq1, f32x4& s0, f32x4& s1) {
    s0 = mfma16(f.a0, bq0, (f32x4){0.f, 0.f, 0.f, 0.f}); s0 = mfma16(f.a1, bq1, s0);
    s1 = mfma16(f.b0, bq0, (f32x4){0.f, 0.f, 0.f, 0.f}); s1 = mfma16(f.b1, bq1, s1); }
DI void na_pv(const LAS unsigned char* lds, int kbase, int lane, const bf16x8& pf, f32x4 (&o)[4], f32x4& osum) {
    const int g = lane >> 4, i = lane & 15;
    { const short one = (short)0x3F80; const bf16x8 ones = {one, one, one, one, one, one, one, one};
      osum = mfma16(ones, pf, osum); }
    const LAS unsigned char* vp = lds + NA_VOFF + (kbase + 4 * g + (i >> 2)) * NA_RS + 8 * (i & 3);
#pragma unroll
    for (int dt = 0; dt < 4; ++dt) o[dt] = mfma16(cat8(tr4(vp + 32 * dt), tr4(vp + 32 * dt + 16 * NA_RS)), pf, o[dt]);
}
struct NaWin { u32x4 k[8], v[8]; };
struct NaCtx { u32x4 k[4], v[4]; };
DI void na_issue_win(const P& p, NaWin& r, int u, int tid) {
    asm volatile("" : "+v"(tid));
    const int cb = u & 3, rb = (u >> 2) & 15, h = (u >> 6) & 15, b = u >> 10;
    const int kr0 = min(max(8 * rb - 4, 0), GROWS - 15), kc0 = cb == 0 ? 0 : (cb == 1 ? 8 : (cb == 2 ? 24 : 32));
    const bf16* KB = (const bf16*)(p.ws + WS_KB); const bf16* VB = (const bf16*)(p.ws + WS_VB);
#pragma unroll
    for (int it = 0; it < 8; ++it) { const int c = tid + it * NTHR;
        if (c < 480 * 8) { const int kk = c >> 3, ch = c & 7; const int tok = (kr0 + (kk >> 5)) * GW + kc0 + (kk & 31);
            const size_t go = (size_t)(b * SEQ + tok) * 1024 + h * 64 + ch * 8; r.k[it] = *(const u32x4*)(KB + go); r.v[it] = *(const u32x4*)(VB + go); } }
}
DI void na_commit_win(const NaWin& r, LAS unsigned char* lds, int tid) {
    asm volatile("" : "+v"(tid));
#pragma unroll
    for (int it = 0; it < 8; ++it) { const int c = tid + it * NTHR;
        if (c < 480 * 8) { const int kk = c >> 3, ch = c & 7; *(LAS u32x4*)(lds + NA_KOFF + kk * NA_RS + ch * 16) = r.k[it]; *(LAS u32x4*)(lds + NA_VOFF + kk * NA_RS + ch * 16) = r.v[it]; } }
}
DI void na_commit_ctx(const NaCtx& r, LAS unsigned char* lds, int tid) {
    asm volatile("" : "+v"(tid));
#pragma unroll
    for (int it = 0; it < 4; ++it) { const int c = tid + it * NTHR; const int kk = c >> 3, ch = c & 7;
        *(LAS u32x4*)(lds + NA_KOFF + kk * NA_RS + ch * 16) = r.k[it]; *(LAS u32x4*)(lds + NA_VOFF + kk * NA_RS + ch * 16) = r.v[it]; }
}
DI void na_phase(const P& p, LAS unsigned char* lds, int u0, int tid, int wave, int lane) {
    const int h = (u0 >> 6) & 15, b = u0 >> 10;
#define NA_UNIT(iu_) ((u0 & ~63) + (iu_) * 4 + ((u0 >> 4) & 3))
    bf16* QB = (bf16*)(p.ws + WS_QB); const bf16* KB = (const bf16*)(p.ws + WS_KB); const bf16* VB = (const bf16*)(p.ws + WS_VB);
    LAS float* rpbl = (LAS float*)(lds + NA_RPB);
    for (int i = tid; i < 15 * 32; i += NTHR) { const int r_ = i >> 5, c_ = i & 31; rpbl[i] = c_ < 31 ? __builtin_amdgcn_exp2f(p.rpb[h * 465 + r_ * 31 + c_] * 1.44269504f) : 0.f; }
    NaCtx cx;
    const int q = lane & 15, g = lane >> 4;
    NaWin win; na_issue_win(p, win, NA_UNIT(0), tid);
    bf16x8 bq0, bq1;
    { const int uf = NA_UNIT(0), cb = uf & 3, rb = (uf >> 2) & 15; const size_t qoff = (size_t)(b * SEQ + (8 * rb + wave) * GW + 16 * cb + q) * 1024 + h * 64;
      bq0 = *(const bf16x8*)(QB + qoff + 8 * g); bq1 = *(const bf16x8*)(QB + qoff + 32 + 8 * g); }
#if defined(NA_PROF)
    volatile LAS unsigned long long* nacc = (volatile LAS unsigned long long*)(lds + NA_RPB + 2048);
    if (tid == 0) { nacc[0] = 0; nacc[1] = 0; nacc[2] = 0; nacc[3] = 0; nacc[4] = 0; }
    unsigned long long tprev = __builtin_amdgcn_s_memrealtime();
#define NAP(k) do { if (tid == 0) { const unsigned long long tn = __builtin_amdgcn_s_memrealtime(); nacc[k] += tn - tprev; tprev = tn; } } while (0)
#else
#define NAP(k) do {} while (0)
#endif
    for (int iu = 0; iu < 16; ++iu) {
        const int u = NA_UNIT(iu), cb = u & 3, rb = (u >> 2) & 15;
        const int kr0 = min(max(8 * rb - 4, 0), GROWS - 15), kc0 = cb == 0 ? 0 : (cb == 1 ? 8 : (cb == 2 ? 24 : 32));
        const int r = 8 * rb + wave, qc = 16 * cb + q;
        const size_t qoff = (size_t)(b * SEQ + r * GW + qc) * 1024 + h * 64;
        na_commit_win(win, lds, tid);
        __syncthreads();
        NAP(0);
        { int tq = tid; asm volatile("" : "+v"(tq));
#pragma unroll
        for (int it = 0; it < 4; ++it) { const int c = tq + it * NTHR; const int kk = c >> 3, ch = c & 7; const size_t go = (size_t)(M_LAT + b * CTX + kk) * 1024 + h * 64 + ch * 8;
            cx.k[it] = *(const u32x4*)(KB + go); cx.v[it] = *(const u32x4*)(VB + go); } }
        asm volatile("" ::: "memory");
        f32x4 o[4];
#pragma unroll
        for (int dt = 0; dt < 4; ++dt) o[dt] = (f32x4){0.f, 0.f, 0.f, 0.f};
        f32x4 osum = {0.f, 0.f, 0.f, 0.f};
        const int wr0 = min(max(r - 4, 0), GROWS - 8), rel0 = wr0 - kr0, wc0 = min(max(qc - 8, 0), GW - 16);
        int boff[8]; bool bval[8];
#pragma unroll
        for (int e = 0; e < 8; ++e) { const int kc = kc0 + 4 * g + (e & 3) + 16 * (e >> 2); bval[e] = kc >= wc0 && kc < wc0 + 16; boff[e] = bval[e] ? min(max(kc - qc + 15, 0), 30) : 31; }
        const LAS float* brow = rpbl + ((kr0 + rel0) - r + 7) * 32;
        {
          for (int hb = 0; hb < 8; hb += NA_BATCH) {
            f32x4 sw[NA_BATCH][2]; bf16x8 pf[NA_BATCH];
            { NaKF kf[2]; na_kload(lds, (rel0 + hb) * 32, q, g, kf[0]);
#pragma unroll
            for (int i = 0; i < NA_BATCH; ++i) { if (i + 1 < NA_BATCH) na_kload(lds, (rel0 + hb + i + 1) * 32, q, g, kf[(i + 1) & 1]); na_kmma(kf[i & 1], bq0, bq1, sw[i][0], sw[i][1]); } }
#pragma unroll
            for (int i = 0; i < NA_BATCH; ++i) { f32x4 p0, p1;
#pragma unroll
                for (int e = 0; e < 4; ++e) {
                    p0[e] = __builtin_amdgcn_exp2f(sw[i][0][e]) * brow[(hb + i) * 32 + boff[e]]; p1[e] = __builtin_amdgcn_exp2f(sw[i][1][e]) * brow[(hb + i) * 32 + boff[4 + e]]; }
                pf[i] = packf8(p0, p1); }
#pragma unroll
            for (int i = 0; i < NA_BATCH; ++i) na_pv(lds, (rel0 + hb + i) * 32, lane, pf[i], o, osum);
          }
        }
        __syncthreads();
        NAP(1);
        na_commit_ctx(cx, lds, tid);
        __syncthreads();
        NAP(2);
        bf16x8 nq0 = bq0, nq1 = bq1;
        if (iu < 15) { const int un = NA_UNIT(iu + 1); na_issue_win(p, win, un, tid);
            const int cbn = un & 3, rbn = (un >> 2) & 15; const size_t qn = (size_t)(b * SEQ + (8 * rbn + wave) * GW + 16 * cbn + q) * 1024 + h * 64;
            nq0 = *(const bf16x8*)(QB + qn + 8 * g); nq1 = *(const bf16x8*)(QB + qn + 32 + 8 * g); }
        asm volatile("" ::: "memory");
        for (int hb = 0; hb < 8; hb += NA_BATCH) {   f32x4 sw[NA_BATCH][2]; bf16x8 pf[NA_BATCH];
            { NaKF kf[2]; na_kload(lds, 32 * hb, q, g, kf[0]);
#pragma unroll
            for (int i = 0; i < NA_BATCH; ++i) { if (i + 1 < NA_BATCH) na_kload(lds, 32 * (hb + i + 1), q, g, kf[(i + 1) & 1]); na_kmma(kf[i & 1], bq0, bq1, sw[i][0], sw[i][1]); } }
#pragma unroll
            for (int i = 0; i < NA_BATCH; ++i) { f32x4 p0, p1;
#pragma unroll
                for (int e = 0; e < 4; ++e) { p0[e] = __builtin_amdgcn_exp2f(sw[i][0][e]); p1[e] = __builtin_amdgcn_exp2f(sw[i][1][e]); }
                pf[i] = packf8(p0, p1); }
#pragma unroll
            for (int i = 0; i < NA_BATCH; ++i) na_pv(lds, 32 * (hb + i), lane, pf[i], o, osum);
        }
        const float inv = 1.f / osum[0];
#pragma unroll
        for (int k = 0; k < 2; ++k) *(u32x4*)(QB + qoff + 32 * k + pair_col(g)) = pair_rows16(pack4(o[2 * k] * inv), pack4(o[2 * k + 1] * inv));
        bq0 = nq0; bq1 = nq1;
        __syncthreads();
        NAP(3);
    }
}

constexpr int MA_RS = 288, MA_V = 0, MA_KW = 128 * MA_RS, MA_G = 2 * 128 * MA_RS, MA_WF = MA_G + 2048, MA_WB = MA_WF + 512;
struct MaPre { u32x4 k[2], v[4]; };
typedef float f32x2v __attribute__((ext_vector_type(2)));
struct MaGates { f32x2v ig, lf; };
DI void ma_issue(const P& p, MaPre& r, int u, int tid) {
    const int c = u % NCH, h = (u / NCH) & 7, b = u / (NCH * NHA), row0 = chunk_row0(b, c);
    const bf16* KA = (const bf16*)(p.ws + WS_KA); const bf16* VA = (const bf16*)(p.ws + WS_VA);
#pragma unroll
    for (int i = 0; i < 2; ++i) { const int ci = tid + i * NTHR, tok = ci >> 3, ch = ci & 7; r.k[i] = *(const u32x4*)(KA + (size_t)(row0 + tok) * 512 + h * 64 + ch * 8); }
#pragma unroll
    for (int i = 0; i < 4; ++i) { const int ci = tid + i * NTHR, tok = ci >> 4, ch = ci & 15; r.v[i] = *(const u32x4*)(VA + (size_t)(row0 + tok) * 1024 + h * 128 + ch * 8); }
}
DI void ma_issue_gates(const P& p, MaGates& gt, int u, int dir, int lane) {
    const int c = u % NCH, h = (u / NCH) & 7, b = u / (NCH * NHA), row0 = chunk_row0(b, c);
    const float* G = (const float*)(p.ws + WS_GATES) + row0 + 2 * lane;
    gt.ig = *(const f32x2v*)(G + (size_t)((2 * dir) * 8 + h) * M_ALL); gt.lf = *(const f32x2v*)(G + (size_t)((2 * dir + 1) * 8 + h) * M_ALL);
}
DI void ma_scan(const P& p, const MaGates& gt, int u, int dir, int lane, LAS float* w) {
    const int c = u % NCH, h = (u / NCH) & 7, b = u / (NCH * NHA);
    const float lf0 = gt.lf[0], lf1 = gt.lf[1], ig0 = gt.ig[0], ig1 = gt.ig[1];
    const float p1 = lf0 + lf1, incl = dpp_incl_add(p1), excl = incl - p1, total = rdlane(incl, 63);
    float ge0, ge1;
    if (dir == 0) { ge0 = total - (excl + lf0) + ig0; ge1 = total - incl + ig1; }
    else { ge0 = excl + ig0; ge1 = excl + lf0 + ig1; }
    const float mx = rdlane(dpp_incl_max(fmaxf(ge0, ge1)), 63);
    w[2 * lane] = __expf(ge0 - mx); w[2 * lane + 1] = __expf(ge1 - mx);
    if (lane == 0) { float* ch = (float*)(p.ws + WS_CH) + ((((size_t)b * NHA + h) * 2 + dir) * NCH + c) * 2; ch[0] = total; ch[1] = mx; }
    if (c >= 2) {
        float b0, b1, e0, e1, x0, x1;
        if (dir == 0) { b0 = excl + lf0; b1 = incl; e0 = ig0 - b0; e1 = ig1 - b1; const float pm = dpp_incl_max(fmaxf(e0, e1)); const float pv = dppf<0x138, 0xf>(-3.0e38f, pm); x0 = fmaxf(pv, e0); x1 = pm; }
        else { b0 = total - excl; b1 = total - (excl + lf0); e0 = ig0 - b0; e1 = ig1 - b1; const float sm = dpp_incl_max_rev(fmaxf(e0, e1), lane); const float nx = dppf<0x130, 0xf>(-3.0e38f, sm); x0 = sm; x1 = fmaxf(nx, e1); }
        float* sc = (float*)(p.ws + WS_SC) + ((((size_t)b * NHA + h) * 64 + (c - 2)) * 6 + 3 * dir) * 128 + 2 * lane;
        *(f32x2v*)sc = (f32x2v){e0, e1}; *(f32x2v*)(sc + 128) = (f32x2v){x0, x1}; *(f32x2v*)(sc + 256) = (f32x2v){b0, b1}; }
}
DI void ma_phase(const P& p, LAS unsigned char* lds, int bx, int G, int tid, int wave, int lane) {
    constexpr int NU_ = NB * NHA * NCH;
    LAS float* wtab = (LAS float*)(lds + MA_G);
    int u = bx; MaPre r; MaGates gt;
    if (u < NU_) { ma_issue(p, r, u, tid); if (wave < 2) { ma_issue_gates(p, gt, u, wave, lane); ma_scan(p, gt, u, wave, lane, wtab + wave * 128); } }
    for (int it = 0; u < NU_; u += G, ++it) {
        const int c = u % NCH, h = (u / NCH) & 7, b = u / (NCH * NHA);
        const LAS float* wf = wtab + (it & 1) * 256; const LAS float* wb = wf + 128;
#pragma unroll
        for (int i = 0; i < 4; ++i) { const int ci = tid + i * NTHR, tok = ci >> 4, ch = ci & 15; *(LAS u32x4*)(lds + MA_V + tok * MA_RS + ch * 16) = r.v[i]; }
        const u32x4 kc0 = r.k[0], kc1 = r.k[1];
        __syncthreads();
        const bool more = u + G < NU_;
        if (more) { ma_issue(p, r, u + G, tid); if (wave < 2) ma_issue_gates(p, gt, u + G, wave, lane); }
        asm volatile("" ::: "memory");
#pragma unroll
        for (int i = 0; i < 2; ++i) { const int ci = tid + i * NTHR, tok = ci >> 3, ch = ci & 7; const u32x4 kv = i ? kc1 : kc0;
            f32x4 a, bb; unpack8(kv, a, bb); const float f = wf[tok], rr = wb[tok];
            *(LAS u32x4*)(lds + MA_KW + tok * MA_RS + ch * 16) = pack8(a * f, bb * f); *(LAS u32x4*)(lds + MA_KW + tok * MA_RS + 128 + ch * 16) = pack8(a * rr, bb * rr); }
        __syncthreads();
    {
        bf16x8 a[4];
#pragma unroll
        for (int s = 0; s < 4; ++s) a[s] = tr_frag(lds + MA_KW, MA_RS, s, 16 * wave, lane);
        const int dir = wave >> 2, g = lane >> 4;
        bf16* UC = (bf16*)(p.ws + WS_UC) + ((((size_t)dir * NB + b) * NHA + h) * NCH + c) * 8192 + ((wave & 3) * 64 + lane) * 4;
        {
            const short one = (short)0x3F80; const bf16x8 ones = {one, one, one, one, one, one, one, one}; f32x4 accn = {0.f, 0.f, 0.f, 0.f};
#pragma unroll
            for (int s = 0; s < 4; ++s) accn = mfma16(a[s], ones, accn);
            if ((lane & 15) == 0) *(f32x4*)((float*)(p.ws + WS_NU) + ((((size_t)b * NHA + h) * 2 + dir) * NCH + c) * 64 + 16 * (wave & 3) + 4 * g) = accn; }
#pragma unroll
        for (int nt = 0; nt < 8; ++nt) { f32x4 acc = {0.f, 0.f, 0.f, 0.f};
#pragma unroll
            for (int s = 0; s < 4; ++s) acc = mfma16(a[s], tr_frag(lds + MA_V, MA_RS, s, 16 * nt, lane), acc);
            *(u32x2*)(UC + nt * 1024) = pack4(acc); }
    }
        if (more && wave < 2) ma_scan(p, gt, u + G, wave, lane, wtab + ((it + 1) & 1) * 256 + wave * 128);
        __syncthreads();
    }
}

DI int scan_chunk(int dir, int i) { return dir == 0 ? i : (i < 2 ? 1 - i : NCH + 1 - i); }
DI void mB_unit(const P& p, int blk, int tid) {
    const int bhd = blk >> 2, dir = bhd & 1, bh = bhd >> 1, b = bh >> 3, h = bh & 7;
    const float* CH = (const float*)(p.ws + WS_CH) + (size_t)bhd * NCH * 2;
    bf16* UC = (bf16*)(p.ws + WS_UC) + (((size_t)dir * NB + b) * NHA + h) * NCH * 8192 + (blk & 3) * 2048 + tid * 4;
    float* NU = (float*)(p.ws + WS_NU) + (size_t)bhd * NCH * 64 + tid * 4; float* MIN = (float*)(p.ws + WS_MIN) + (size_t)bhd * NCH;
    const bool do_n = (blk & 3) == 0 && tid < 16, do_m = (blk & 3) == 0 && tid == 0;
    float m = 0.f; f32x4 s = {0.f, 0.f, 0.f, 0.f}, ns = {0.f, 0.f, 0.f, 0.f};
    for (int bt = 0; bt < 6; ++bt) {
        u32x2 uv[11]; f32x4 nv[11]; float blv[11], mlv[11];
#pragma unroll
        for (int k = 0; k < 11; ++k) { const int c = scan_chunk(dir, bt * 11 + k); uv[k] = *(const u32x2*)(UC + (size_t)c * 8192); blv[k] = CH[c * 2]; mlv[k] = CH[c * 2 + 1]; nv[k] = do_n ? *(const f32x4*)(NU + c * 64) : (f32x4){0.f, 0.f, 0.f, 0.f}; }
#pragma unroll
        for (int k = 0; k < 11; ++k) { const int c = scan_chunk(dir, bt * 11 + k);
            const float bl = blv[k], ml = mlv[k], mn = fmaxf(bl + m, ml), dec = __expf(bl + m - mn), scl = __expf(ml - mn);
            f32x4 uf; uf[0] = __uint_as_float(uv[k].x << 16); uf[1] = __uint_as_float(uv[k].x & 0xffff0000u); uf[2] = __uint_as_float(uv[k].y << 16); uf[3] = __uint_as_float(uv[k].y & 0xffff0000u);
            *(u32x2*)(UC + (size_t)c * 8192) = pack4(s); s = s * dec + uf * scl;
            if (do_n) { *(f32x4*)(NU + c * 64) = ns; ns = ns * dec + nv[k] * scl; }
            if (do_m) MIN[c] = m;
            m = mn; }
    }
}

constexpr int MC_KS = 144, MC_VS = 288, MC_K = 0, MC_V = 128 * MC_KS, MC_CF = MC_V + 128 * MC_VS, MC_CB = MC_CF + 128 * MC_KS, MC_SC = MC_CB + 128 * MC_KS,
              MC_EF = MC_SC, MC_PF = MC_SC + 512, MC_BF = MC_SC + 1024, MC_EB = MC_SC + 1536, MC_PB = MC_SC + 2048, MC_BB = MC_SC + 2560, MC_NF = MC_SC + 3072, MC_NB = MC_NF + 256, MC_END = MC_NB + 256;
static_assert(MC_END <= 131072, "step C LDS");
DI bf16x8 scale8(const bf16x8& v, float f) { f32x4 a, b; unpack8(__builtin_bit_cast(u32x4, v), a, b); return packf8(a * f, b * f); }
struct McPre { u32x4 k[2], cf[2], cb[2], v[4]; float sc0, sc1, nval, m_f, m_b; bf16x8 q0, q1; };
DI void mc_issue(const P& p, McPre& r, int u, int tid) {
    const int j = u & 63, h = (u >> 6) & 7, b = u >> 9, c = j + 2, row0 = b * SEQ + 128 * j;
    const bf16* KA = (const bf16*)(p.ws + WS_KA); const bf16* VA = (const bf16*)(p.ws + WS_VA);
    const bf16* cf = (const bf16*)(p.ws + WS_UC) + ((((size_t)0 * NB + b) * NHA + h) * NCH + c) * 8192; const bf16* cb = (const bf16*)(p.ws + WS_UC) + ((((size_t)1 * NB + b) * NHA + h) * NCH + c) * 8192;
    { const float* sc = (const float*)(p.ws + WS_SC) + (((size_t)b * NHA + h) * 64 + j) * 768 + 2 * tid; r.sc0 = tid < 384 ? sc[0] : 0.f; r.sc1 = tid < 384 ? sc[1] : 0.f; }
#pragma unroll
    for (int i = 0; i < 2; ++i) { const int ci = tid + i * NTHR, tok = ci >> 3, ch = ci & 7;
        r.k[i] = *(const u32x4*)(KA + (size_t)(row0 + tok) * 512 + h * 64 + ch * 8); r.cf[i] = *(const u32x4*)(cf + tok * 64 + ch * 8); r.cb[i] = *(const u32x4*)(cb + tok * 64 + ch * 8); }
#pragma unroll
    for (int i = 0; i < 4; ++i) { const int ci = tid + i * NTHR, tok = ci >> 4, ch = ci & 15; r.v[i] = *(const u32x4*)(VA + (size_t)(row0 + tok) * 1024 + h * 128 + ch * 8); }
    const size_t bhd_f = ((size_t)b * NHA + h) * 2;
    r.nval = tid < 128 ? ((const float*)(p.ws + WS_NU))[((bhd_f + (tid >> 6)) * NCH + c) * 64 + (tid & 63)] : 0.f;
    r.m_f = ((const float*)(p.ws + WS_MIN))[bhd_f * NCH + c]; r.m_b = ((const float*)(p.ws + WS_MIN))[(bhd_f + 1) * NCH + c];
    { const int lane = tid & 63, t = 16 * (tid >> 6) + (lane & 15), g = lane >> 4;
      const bf16* qp = (const bf16*)(p.ws + WS_QA) + (size_t)(row0 + t) * 512 + h * 64 + 8 * g; r.q0 = *(const bf16x8*)qp; r.q1 = *(const bf16x8*)(qp + 32);
 }
}
DI void mc_commit(const McPre& r, LAS unsigned char* lds, int tid) {
    if (tid < 384) { ((LAS float*)(lds + MC_SC))[2 * tid] = r.sc0; ((LAS float*)(lds + MC_SC))[2 * tid + 1] = r.sc1; }
#pragma unroll
    for (int i = 0; i < 2; ++i) { const int ci = tid + i * NTHR, tok = ci >> 3, ch = ci & 7;
        *(LAS u32x4*)(lds + MC_K + tok * MC_KS + ch * 16) = r.k[i];
        const int k = 2 * ci, l = k & 63, w3 = (k >> 6) & 3, nt = k >> 8, o = (16 * nt + (l & 15)) * MC_KS + (16 * w3 + 4 * (l >> 4)) * 2;
        *(LAS u32x2*)(lds + MC_CF + o) = (u32x2){r.cf[i].x, r.cf[i].y}; *(LAS u32x2*)(lds + MC_CF + o + MC_KS) = (u32x2){r.cf[i].z, r.cf[i].w};
        *(LAS u32x2*)(lds + MC_CB + o) = (u32x2){r.cb[i].x, r.cb[i].y}; *(LAS u32x2*)(lds + MC_CB + o + MC_KS) = (u32x2){r.cb[i].z, r.cb[i].w}; }
#pragma unroll
    for (int i = 0; i < 4; ++i) { const int ci = tid + i * NTHR, tok = ci >> 4, ch = ci & 15; *(LAS u32x4*)(lds + MC_V + tok * MC_VS + ch * 16) = r.v[i]; }
    if (tid < 128) ((LAS float*)(lds + MC_NF))[tid] = r.nval;
}
#if defined(MC_PROF)
#define MCP(k) do { if (tid == 0) { volatile LAS unsigned long long* a_ = (volatile LAS unsigned long long*)(lds + 139264); const unsigned long long tn = __builtin_amdgcn_s_memrealtime(); a_[k] += tn - a_[7]; a_[7] = tn; } } while (0)
#else
#define MCP(k) do {} while (0)
#endif
DI void mc_compute(const P& p, LAS unsigned char* lds, int u, int tid, int wave, int lane, bool do_store, const bf16x8 bq0, const bf16x8 bq1, float m_in_f, float m_in_b) {
    const int j = u & 63, h = (u >> 6) & 7, b = u >> 9, c = j + 2;
    const int row0 = b * SEQ + 128 * j;
    const bf16* QA = (const bf16*)(p.ws + WS_QA); bf16* VA = (bf16*)(p.ws + WS_VA);
    const size_t bhd_f = ((size_t)b * NHA + h) * 2, bhd_b = bhd_f + 1;
    const int q = lane & 15, g = lane >> 4, t = 16 * wave + q;
    const bf16* OA = (const bf16*)(p.ws + WS_OA) + ((size_t)(row0 >> 7) * 8 + h) * 16384 + (wave * 8 * 64 + lane) * 4;
    u32x2 ov[8];
#pragma unroll
    for (int dt = 0; dt < 8; ++dt) ov[dt] = *(const u32x2*)(OA + 256 * dt);
    f32x4 st[8];
#pragma unroll
    for (int kt = 0; kt < 8; ++kt) { const LAS unsigned char* kp = lds + MC_K + (16 * kt + q) * MC_KS + 16 * g;
        st[kt] = mfma16(ldsb128(kp), bq0, (f32x4){0.f, 0.f, 0.f, 0.f}); st[kt] = mfma16(ldsb128(kp + 64), bq1, st[kt]); }
    MCP(1);
    const float Mft = fmaxf(m_in_f, ((const LAS float*)(lds + MC_PF))[t]), Mbt = fmaxf(m_in_b, ((const LAS float*)(lds + MC_PB))[t]);
    const float aft = __expf(m_in_f - Mft), abt = __expf(m_in_b - Mbt), fft = __expf(-(((const LAS float*)(lds + MC_BF))[t] + Mft)), fbt = __expf(-(((const LAS float*)(lds + MC_BB))[t] + Mbt));
    float den_f = 0.f, den_b = 0.f; f32x4 sbd = {0.f, 0.f, 0.f, 0.f};
#pragma unroll
    for (int kt = 0; kt < 8; ++kt) {
        if (kt == wave) {
            const f32x4 ef = *(const LAS f32x4*)(lds + MC_EF + (16 * kt + 4 * g) * 4), eb = *(const LAS f32x4*)(lds + MC_EB + (16 * kt + 4 * g) * 4);
#pragma unroll
            for (int e = 0; e < 4; ++e) { const int s = 16 * kt + 4 * g + e;
                const float wf = __expf(s <= t ? ef[e] - Mft : -1000.f), wb = __expf(s >= t ? eb[e] - Mbt : -1000.f);
                sbd[e] = st[kt][e] * wb; st[kt][e] *= wf; den_f += st[kt][e]; den_b += sbd[e]; }
        } else {
            const bool fw = kt < wave;
            const f32x4 tb = *(const LAS f32x4*)(lds + (fw ? MC_EF : MC_EB) + (16 * kt + 4 * g) * 4); const float nMs = (fw ? Mft : Mbt) * -1.44269504f; float ds = 0.f;
#pragma unroll
            for (int e = 0; e < 4; ++e) { st[kt][e] *= __builtin_amdgcn_exp2f(fmaf(tb[e], 1.44269504f, nMs)); ds += st[kt][e]; }
            if (fw) den_f += ds; else den_b += ds;
        }
    }
    float qn_f = 0.f, qn_b = 0.f;
    { f32x4 a0, a1, c0, c1; unpack8(__builtin_bit_cast(u32x4, bq0), a0, a1); unpack8(__builtin_bit_cast(u32x4, bq1), c0, c1);
      const LAS float* nf = (const LAS float*)(lds + MC_NF) + 8 * g; const LAS float* nb = (const LAS float*)(lds + MC_NB) + 8 * g;
#pragma unroll
      for (int e = 0; e < 4; ++e) { qn_f += a0[e] * nf[e] + a1[e] * nf[4 + e] + c0[e] * nf[32 + e] + c1[e] * nf[36 + e]; qn_b += a0[e] * nb[e] + a1[e] * nb[4 + e] + c0[e] * nb[32 + e] + c1[e] * nb[36 + e]; } }
    den_f = sum_rows4(den_f); den_b = sum_rows4(den_b);
    qn_f = sum_rows4(qn_f); qn_b = sum_rows4(qn_b);
    const float inv_f = 1.f / fmaxf(fabsf(aft * qn_f + den_f), fft), inv_b = 1.f / fmaxf(fabsf(abt * qn_b + den_b), fbt);
    MCP(2);
    bf16x8 pf[4];
#pragma unroll
    for (int i = 0; i < 4; ++i) { f32x4 pp[2];
#pragma unroll
        for (int hh = 0; hh < 2; ++hh) { const int kt = 2 * i + hh;
            if (kt == wave) pp[hh] = st[kt] * inv_f + sbd * inv_b; else pp[hh] = st[kt] * (kt < wave ? inv_f : inv_b); }
        pf[i] = packf8(pp[0], pp[1]); }
    const bf16x8 qf0 = scale8(bq0, aft * inv_f), qf1 = scale8(bq1, aft * inv_f), qb0 = scale8(bq0, abt * inv_b), qb1 = scale8(bq1, abt * inv_b);
    f32x4 oacc[8]; float ss = 0.f;
#pragma unroll
    for (int dt = 0; dt < 8; ++dt) { f32x4 o = {0.f, 0.f, 0.f, 0.f};
#pragma unroll
        for (int i = 0; i < 4; ++i) o = mfma16(tr_frag(lds + MC_V, MC_VS, i, 16 * dt, lane), pf[i], o);
        const LAS unsigned char* cfp = lds + MC_CF + (16 * dt + q) * MC_KS + 16 * g; const LAS unsigned char* cbp = lds + MC_CB + (16 * dt + q) * MC_KS + 16 * g;
        o = mfma16(ldsb128(cfp), qf0, o); o = mfma16(ldsb128(cfp + 64), qf1, o); o = mfma16(ldsb128(cbp), qb0, o); o = mfma16(ldsb128(cbp + 64), qb1, o);
        oacc[dt] = o; ss += (o[0] * o[0] + o[1] * o[1]) + (o[2] * o[2] + o[3] * o[3]); }
    MCP(3);
    ss = sum_rows4(ss);
    const float rn = rsqrtf(ss * (1.f / 128.f) + EPS);
    bf16* __restrict__ HA = VA + (size_t)(row0 + t) * 1024 + h * 128 + pair_col(g);
    const float* __restrict__ gn = p.mlstm_g + h * 128 + 4 * g;
#pragma unroll
    for (int k = 0; k < 4; ++k) { u32x2 w2[2];
#pragma unroll
        for (int hh = 0; hh < 2; ++hh) { const int dt = 2 * k + hh; f32x4 og;
            og[0] = __uint_as_float(ov[dt].x << 16); og[1] = __uint_as_float(ov[dt].x & 0xffff0000u); og[2] = __uint_as_float(ov[dt].y << 16); og[3] = __uint_as_float(ov[dt].y & 0xffff0000u);
            w2[hh] = pack4(oacc[dt] * rn * *(const f32x4*)(gn + 16 * dt) * og); }
        const u32x4 w = pair_rows16(w2[0], w2[1]);
        if (do_store) *(u32x4*)(HA + 32 * k) = w; else asm volatile("" :: "v"(w.x), "v"(w.y), "v"(w.z), "v"(w.w)); }
}
DI void mc_phase(const P& p, LAS unsigned char* lds, int bx, int G, int tid, int wave, int lane, unsigned* qctr) {
    constexpr int NU_ = NB * NHA * 64;
#if defined(MC_PROF)
    if (tid == 0) { volatile LAS unsigned long long* a_ = (volatile LAS unsigned long long*)(lds + 139264); for (int i = 0; i < 7; ++i) a_[i] = 0; a_[7] = __builtin_amdgcn_s_memrealtime(); }
#endif
    McPre r;
    if (qctr != nullptr && G == 256) {
        volatile LAS int* slot = (volatile LAS int*)(lds + LDSCTL_OFF + 40);
        int u = bx, nx = bx + 256;
        mc_issue(p, r, u, tid);
        for (;;) {
            mc_commit(r, lds, tid);
            __syncthreads();
            unsigned tk = 0; if (tid == 0) tk = __hip_atomic_fetch_add(qctr, 1u, __ATOMIC_RELAXED, __HIP_MEMORY_SCOPE_AGENT);
            const bf16x8 cq0 = r.q0, cq1 = r.q1; const float cmf = r.m_f, cmb = r.m_b;
            if (nx < NU_) mc_issue(p, r, nx, tid);
            asm volatile("" ::: "memory");
            mc_compute(p, lds, u, tid, wave, lane, true, cq0, cq1, cmf, cmb);
            if (tid == 0) *slot = 512 + (int)tk;
            __syncthreads();
            u = nx; nx = *slot;
            if (u >= NU_) break;
        }
        return;
    }
    int u = bx;
    if (u < NU_) mc_issue(p, r, u, tid);
    for (; u < NU_; u += G) {
        mc_commit(r, lds, tid);
        __syncthreads();
        MCP(0);
        const bf16x8 cq0 = r.q0, cq1 = r.q1; const float cmf = r.m_f, cmb = r.m_b;
        if (u + G < NU_) mc_issue(p, r, u + G, tid);
        asm volatile("" ::: "memory");
        mc_compute(p, lds, u, tid, wave, lane, true, cq0, cq1, cmf, cmb);
        __syncthreads();
        MCP(4);
    }
}

DI void phase_p0(const P& p, LAS unsigned char* lds, int bx, int G, int tid, int gw, int ngw, int wave, int lane) {
    for (int i = bx * 8 + tid; tid < 8 && i < 128 * 16; i += G * 8) { const int pos = i >> 4, f = i & 15;   const float ang = (float)pos * powf(10000.f, -(float)f / 16.f);
        float* t = (float*)(p.ws + WS_ROPE); t[pos * 32 + f] = (float)cos((double)ang); t[pos * 32 + 16 + f] = (float)sin((double)ang); }
    for (int i = bx * NTHR + tid; i < M_LAT; i += G * NTHR) ((float*)(p.ws + WS_SUMSQ))[i] = 0.f;
    if (bx < 192) { LAS float* A = (LAS float*)lds; LAS float* red = A + 5 * 1024;
        for (int i = tid; i < 5 * 1024; i += NTHR) { const float v = i < 4096 ? p.c[i] : p.c_ctx[i - 4096]; A[i] = v / (1.f + expf(-v)); }
        __syncthreads();
        gemv_task<5>(p.w_mod, 6144, 32 * bx, A, red, (float*)(p.ws + WS_MODV), 6144, p.b_mod, tid); }
    __syncthreads();
    phase_convert(p, lds, gw, ngw, wave, lane, 0, TAIL_CONV_LATE ? CI_WIN : CI_TOTAL);
    __syncthreads();
}
#ifndef P1_FLAT
#define P1_FLAT 1
#endif
#ifndef P1_DEPTH2
#define P1_DEPTH2 1
#endif
DI void phase_p1(const P& p, LAS unsigned char* lds, int bx, int G, int tid, int gw, int ngw, int lane) {
    if (!TAIL_CONV_LATE) phase_bgu(p, gw, ngw, lane);
    bf16* HX = (bf16*)(p.ws + WS_HX);
    if (P1_FLAT && SEQ % ngw == 0 && M_CTX <= ngw) {
        const int rps = SEQ / ngw, nrow = NB * rps + (gw < M_CTX ? 1 : 0);
        auto rowof = [&](int it) { return it < NB * rps ? (it / rps) * SEQ + gw + (it % rps) * ngw : M_LAT + gw; };
        f32x4 sc[4], sh[4], scn[4], shn[4], v[4], vn[4], vnn[4];
        { const float* mv = (const float*)(p.ws + WS_MODV);
#pragma unroll
          for (int jj = 0; jj < 4; ++jj) { const int k = 4 * lane + 256 * jj; sc[jj] = *(const f32x4*)(p.norm1_g + k) * (*(const f32x4*)(mv + 1024 + k) + 1.f); sh[jj] = *(const f32x4*)(mv + k); }
          const float* xr = p.x + (size_t)rowof(0) * DM;
#pragma unroll
          for (int jj = 0; jj < 4; ++jj) v[jj] = *(const f32x4*)(xr + 4 * lane + 256 * jj);
          if (P1_DEPTH2 && nrow > 1) { const int r1 = rowof(1); const float* x1 = r1 < M_LAT ? p.x + (size_t)r1 * DM : p.ctx + (size_t)(r1 - M_LAT) * DM;
#pragma unroll
            for (int jj = 0; jj < 4; ++jj) vn[jj] = *(const f32x4*)(x1 + 4 * lane + 256 * jj); } }
        for (int it = 0; it < nrow; ++it) {
            const int row = rowof(it); const bool sw = (it + 1) % rps == 0 && it + 1 < nrow;
            if (P1_DEPTH2 && it + 2 < nrow) { const int n2 = rowof(it + 2); const float* x2 = n2 < M_LAT ? p.x + (size_t)n2 * DM : p.ctx + (size_t)(n2 - M_LAT) * DM;
#pragma unroll
                for (int jj = 0; jj < 4; ++jj) vnn[jj] = *(const f32x4*)(x2 + 4 * lane + 256 * jj); }
            if (it + 1 < nrow) { const int nr_ = rowof(it + 1); const float* xn = nr_ < M_LAT ? p.x + (size_t)nr_ * DM : p.ctx + (size_t)(nr_ - M_LAT) * DM;
                if (!P1_DEPTH2) {
#pragma unroll
                for (int jj = 0; jj < 4; ++jj) vn[jj] = *(const f32x4*)(xn + 4 * lane + 256 * jj); }
                if (sw) { const float* mv = (const float*)(p.ws + WS_MODV) + ((it + 1) / rps) * 6144;
#pragma unroll
                    for (int jj = 0; jj < 4; ++jj) { const int k = 4 * lane + 256 * jj; scn[jj] = *(const f32x4*)(p.norm1_g + k) * (*(const f32x4*)(mv + 1024 + k) + 1.f); shn[jj] = *(const f32x4*)(mv + k); } } }
            float ss = 0.f;
#pragma unroll
            for (int jj = 0; jj < 4; ++jj) ss += (v[jj][0] * v[jj][0] + v[jj][1] * v[jj][1]) + (v[jj][2] * v[jj][2] + v[jj][3] * v[jj][3]);
#pragma unroll
            for (int o = 1; o < 64; o <<= 1) ss += __shfl_xor(ss, o);
            const float rstd = rsqrtf(ss * (1.f / DM) + EPS);
#pragma unroll
            for (int jj = 0; jj < 4; ++jj) *(u32x2*)(HX + (size_t)row * DM + 4 * lane + 256 * jj) = pack4(v[jj] * rstd * sc[jj] + sh[jj]);
#pragma unroll
            for (int jj = 0; jj < 4; ++jj) { v[jj] = vn[jj]; if (P1_DEPTH2) vn[jj] = vnn[jj]; if (sw) { sc[jj] = scn[jj]; sh[jj] = shn[jj]; } }
        }
        return;
    }
    for (int mr = 0; mr < 5; ++mr) {
        const float* mv = (const float*)(p.ws + WS_MODV) + mr * 6144;
        const int rbeg = mr < 4 ? mr * SEQ : M_LAT, rend = mr < 4 ? (mr + 1) * SEQ : M_ALL;
        f32x4 sc[4], sh[4];
#pragma unroll
        for (int jj = 0; jj < 4; ++jj) { const int k = 4 * lane + 256 * jj; sc[jj] = *(const f32x4*)(p.norm1_g + k) * (*(const f32x4*)(mv + 1024 + k) + 1.f); sh[jj] = *(const f32x4*)(mv + k); }
        f32x4 v[4], vn[4];
        int row = rbeg + gw;
        if (row < rend) { const float* xr = row < M_LAT ? p.x + (size_t)row * DM : p.ctx + (size_t)(row - M_LAT) * DM;
#pragma unroll
            for (int jj = 0; jj < 4; ++jj) v[jj] = *(const f32x4*)(xr + 4 * lane + 256 * jj); }
        for (; row < rend; row += ngw) {
            const int nrow = row + ngw;
            if (nrow < rend) { const float* xn = nrow < M_LAT ? p.x + (size_t)nrow * DM : p.ctx + (size_t)(nrow - M_LAT) * DM;
#pragma unroll
                for (int jj = 0; jj < 4; ++jj) vn[jj] = *(const f32x4*)(xn + 4 * lane + 256 * jj); }
            float ss = 0.f;
#pragma unroll
            for (int jj = 0; jj < 4; ++jj) ss += (v[jj][0] * v[jj][0] + v[jj][1] * v[jj][1]) + (v[jj][2] * v[jj][2] + v[jj][3] * v[jj][3]);
#pragma unroll
            for (int o = 1; o < 64; o <<= 1) ss += __shfl_xor(ss, o);
            const float rstd = rsqrtf(ss * (1.f / DM) + EPS);
#pragma unroll
            for (int jj = 0; jj < 4; ++jj) *(u32x2*)(HX + (size_t)row * DM + 4 * lane + 256 * jj) = pack4(v[jj] * rstd * sc[jj] + sh[jj]);
#pragma unroll
            for (int jj = 0; jj < 4; ++jj) v[jj] = vn[jj];
        }
    }
}
#ifndef PG8_SP2_
#define PG8_SP2_ true
#endif
#ifndef ALIGN_HEAVY
#define ALIGN_HEAVY true
#endif
#ifndef REPEAT_MASK
#define REPEAT_MASK 0
#endif
#define REP(ph) for (int rep_ = 0; rep_ < 1 + ((REPEAT_MASK >> (ph)) & 1); ++rep_)
#ifndef SIMPLE_BAR
#define SIMPLE_BAR 0
#endif
#ifndef MC_GATE
#define MC_GATE 1
#endif
#ifndef MC_QUEUE
#define MC_QUEUE 1
#endif
enum { PH_P0 = 0, PH_P1, PH_INPROJ, PH_MA, PH_SCAN_NA, PH_MC, PH_MERGE, PH_OUT, PH_FFN1, PH_FFN2, PH_COUNT };
__global__ void __launch_bounds__(NTHR, 2) mk_fwd(P p, int ph_lo, int ph_hi, int li, int dbg) {
    extern __shared__ __attribute__((aligned(16))) unsigned char lds_raw[];
    LAS unsigned char* lds = (LAS unsigned char*)lds_raw;
    const int wave = __builtin_amdgcn_readfirstlane(threadIdx.x >> 6);
#define lane lane_now()
#define tid (wave * 64 + lane_now())
    const int G = gridDim.x, bx = blockIdx.x;
    const int vcu = (G % 8 == 0) ? (bx % 8) * (G / 8) + bx / 8 : bx;
    const int gw = vcu * NWAVES + wave, ngw = G * NWAVES;
    if (tid < 64) ((LAS unsigned*)(lds + LDSCTL_OFF))[tid] = 0u;
    __syncthreads();
    const XcdBarrier bar = xcd_barrier_post(wave == 0, (unsigned*)(p.ws + WS_CTL) + 4096 * li, (volatile LAS unsigned*)(lds + LDSCTL_OFF));
    unsigned epoch = 0;
#if defined(TS_A)
    volatile LAS unsigned long long* tsl = (volatile LAS unsigned long long*)(lds + LDSCTL_OFF + 64);
#define STAMP(i) do { if (bx == 0 && tid == 0) tsl[i] = __builtin_amdgcn_s_memrealtime(); } while (0)
#else
#define STAMP(i) do {} while (0)
#endif
#ifndef STAG_INPROJ
#define STAG_INPROJ 28
#define STAG_MERGE 14
#define STAG_OUT 28
#define STAG_FFN1 24
#define STAG_FFN2 80
#endif
#ifndef STAG_S
#define STAG_S 1
#endif
#define STAGGER(d_us) do { const int sg_ = (bx >> 3) % STAG_S; if (STAG_S > 1 && sg_) { if (tid == 0) { const unsigned long long t0_ = __builtin_amdgcn_s_memrealtime(); \
        while (__builtin_amdgcn_s_memrealtime() - t0_ < (unsigned long long)(100 * (d_us)) * sg_ / STAG_S) __builtin_amdgcn_s_sleep(4); } __syncthreads(); } } while (0)
#define IN(k) (ph_lo <= (k) && (k) < ph_hi)
#if SIMPLE_BAR
#define SEAM(k) do { if (IN(k) && IN((k) + 1)) { __threadfence(); __syncthreads(); \
        if (tid == 0) { unsigned* cw = (unsigned*)(p.ws + WS_CTL) + 4096 * li + 3500; ++epoch; xb_add(cw, 1u); while (xb_ld(cw) < epoch * (unsigned)G) __builtin_amdgcn_s_sleep(2); } \
        __syncthreads(); __threadfence(); } } while (0)
#else
#define SEAM(k) do { STAMP(2 * (k) + 1); if (IN(k) && IN((k) + 1)) xcd_barrier(bar); STAMP(2 * (k) + 2); } while (0)
#endif
    STAMP(0);
    if (IN(PH_P0)) REP(PH_P0) phase_p0(p, lds, bx, G, tid, gw, ngw, wave, lane);
    SEAM(PH_P0);
    if (IN(PH_P1)) REP(PH_P1) phase_p1(p, lds, bx, G, tid, gw, ngw, lane);
    SEAM(PH_P1);
    if (IN(PH_INPROJ)) REP(PH_INPROJ) {
        STAGGER(STAG_INPROJ);
        pg8::Gemm g{(const bf16*)(p.ws + WS_HX), (const bf16*)(p.ws + WS_WIN), M_ALL, 33 * 256, DM}; InprojOrder S{G, bx};
        EpiInproj E{p.ws, p.b_gates, p.qn_g, p.kn_g, (bf16*)p.out};
        g.wave = wave;
        pg8::gemm_phase<EpiInproj, InprojOrder, true, true>(lds, g, S, E);
        if (TAIL_CONV_LATE) { const int rem = INPROJ_UNITS % G;
            if (rem == 0) phase_convert(p, lds, gw, ngw, wave, lane, CI_WIN, CI_TOTAL);
            else if (bx >= rem) phase_convert(p, lds, (bx - rem) * NWAVES + wave, (G - rem) * NWAVES, wave, lane, CI_WIN, CI_TOTAL); }
    }
    SEAM(PH_INPROJ);
    if (IN(PH_MA)) { if (TAIL_CONV_LATE) { constexpr int NUA = NB * NHA * NCH; const int r9 = NUA % G;
            if (r9 == 0) phase_bgu(p, gw, ngw, lane); else if (bx >= r9) phase_bgu(p, (bx - r9) * NWAVES + wave, (G - r9) * NWAVES, lane); }
        ma_phase(p, lds, bx, G, tid, wave, lane); }
    SEAM(PH_MA);
    unsigned* gatew = (unsigned*)(p.ws + WS_CTL) + 4096 * li + 3700;
    if (IN(PH_SCAN_NA)) {
        unsigned nscan = 0;
        for (int blk = bx; blk < 256; blk += G) { mB_unit(p, blk, tid); ++nscan; }
        if (MC_GATE) { asm volatile("s_waitcnt vmcnt(0)" ::: "memory"); __syncthreads();
            if (tid == 0) { __builtin_amdgcn_fence(__ATOMIC_RELEASE, "agent"); asm volatile("s_waitcnt vmcnt(0)" ::: "memory"); if (nscan) xb_add(gatew, nscan); } }
        for (int u0 = vcu * 16; u0 < 4096; u0 += G * 16) na_phase(p, lds, u0, tid, wave, lane);
    }
    if (MC_GATE && IN(PH_SCAN_NA) && IN(PH_MC)) {
        if (tid == 0) { XB_SPIN(xb_ld(gatew) < 256u, bar.bar); __builtin_amdgcn_fence(__ATOMIC_ACQUIRE, "agent"); asm volatile("s_waitcnt vmcnt(0)" ::: "memory"); }
        __syncthreads();
    } else SEAM(PH_SCAN_NA);
    if (IN(PH_MC)) mc_phase(p, lds, bx, G, tid, wave, lane, MC_QUEUE ? (unsigned*)(p.ws + WS_CTL) + 4096 * li + 3892 : nullptr);
    SEAM(PH_MC);
    if (IN(PH_MERGE)) REP(PH_MERGE) {
        STAGGER(STAG_MERGE);
        MergeOrder S; S.so.init(M_LAT, DM, G, bx);
        pg8::Gemm2 g{(const bf16*)(p.ws + WS_VA), (const bf16*)(p.ws + WS_WA), (const bf16*)(p.ws + WS_QB), (const bf16*)(p.ws + WS_WB), M_LAT, DM, DM};
        EpiMerge2 E{(const bf16*)p.out, (bf16*)(p.ws + WS_T1)};
        g.wave = wave;
        pg8::gemm_phase2<EpiMerge2, MergeOrder, true, true>(lds, g, S, E);
    }
    SEAM(PH_MERGE);
    if (IN(PH_OUT)) {
        STAGGER(STAG_OUT);
        pg8::Gemm g{(const bf16*)(p.ws + WS_T1), (const bf16*)(p.ws + WS_WO), M_LAT, DM, DM}; pg8::StaticOrder S; S.init(M_LAT, DM, G, bx);
        EpiOut E{p.x, (bf16*)(p.ws + WS_XN), (bf16*)(p.ws + WS_XS), (float*)(p.ws + WS_SUMSQ), (const float*)(p.ws + WS_MODV), p.norm2_g};
        g.wave = wave;
        pg8::gemm_phase<EpiOut, pg8::StaticOrder, true, true>(lds, g, S, E);
    }
    SEAM(PH_OUT);
    if (IN(PH_FFN1)) REP(PH_FFN1) {
        STAGGER(STAG_FFN1);
        pg8::Gemm g{(const bf16*)(p.ws + WS_XS), (const bf16*)(p.ws + WS_WGU), M_LAT, 2 * DFF, DM}; pg8::StaticOrder S; S.init(M_LAT, 2 * DFF, G, bx);
        EpiFfn1 E{(bf16*)(p.ws + WS_HFF), (const float*)(p.ws + WS_SUMSQ), (const float*)(p.ws + WS_BGU)};
        g.wave = wave;
        pg8::gemm_phase<EpiFfn1, pg8::StaticOrder, true, true>(lds, g, S, E);
    }
    SEAM(PH_FFN1);
    if (IN(PH_FFN2)) {
        STAGGER(STAG_FFN2);
        pg8::Gemm g{(const bf16*)(p.ws + WS_HFF), (const bf16*)(p.ws + WS_WD), M_LAT, DM, DFF}; pg8::StaticOrder S; S.init(M_LAT, DM, G, bx);
        EpiFfn2 E{p.out, (const bf16*)(p.ws + WS_XN), (const float*)(p.ws + WS_MODV)};
        g.wave = wave;
        pg8::gemm_phase<EpiFfn2, pg8::StaticOrder, true, true>(lds, g, S, E);
    }
#if defined(TS_A)
    STAMP(2 * PH_FFN2 + 1);
#if defined(MC_PROF)
    if (bx == 0 && tid == 0) { volatile LAS unsigned long long* nacc = (volatile LAS unsigned long long*)(lds + 139264); const unsigned long long ta = nacc[TS_A], tb = nacc[TS_B], t0 = __builtin_amdgcn_s_memrealtime();
#elif defined(NA_PROF)
    if (bx == 0 && tid == 0) { volatile LAS unsigned long long* nacc = (volatile LAS unsigned long long*)(lds + NA_RPB + 2048); const unsigned long long ta = nacc[TS_A], tb = nacc[TS_B], t0 = __builtin_amdgcn_s_memrealtime();
#else
    if (bx == 0 && tid == 0) { unsigned long long ta = 0; if (TS_A == 100) { for (int k_ = 0; k_ < 9; ++k_) ta += tsl[2 * k_ + 2] - tsl[2 * k_ + 1]; } else if (TS_A == 101) ta = tsl[19] - tsl[0]; else ta = tsl[(TS_A % 100) + 1] - tsl[TS_A % 100];
        const unsigned long long tb = tsl[TS_B + 1] - tsl[TS_B], t0 = __builtin_amdgcn_s_memrealtime();
#endif
        while (__builtin_amdgcn_s_memrealtime() - t0 < ta + (unsigned long long)TS_MUL * 100ull * (tb / 100ull)) __builtin_amdgcn_s_sleep(8); }
#endif
#undef IN
#undef SEAM
}
#undef lane
#undef tid

extern "C" void kernel_launch(void* const* d_in, const int* in_sizes, int n_in, void* d_out, int out_size, void* d_ws, size_t ws_size, hipStream_t stream) {
    if (n_in != 20 || ws_size < WS_END || out_size != M_LAT * DM) { fprintf(stderr, "kernel_launch: unexpected shapes (n_in %d, ws %zu, out %d); nothing launched\n", n_in, ws_size, out_size); return; }
    P p{};
    const float** f = (const float**)&p;
    for (int i = 0; i < 20; ++i) f[i] = (const float*)d_in[i];
    p.out = (float*)d_out; p.ws = (unsigned char*)d_ws;
    static int grid = 0;
    if (!grid) {
        if (hipFuncSetAttribute((const void*)mk_fwd, hipFuncAttributeMaxDynamicSharedMemorySize, LDS_BYTES) != hipSuccess) { fprintf(stderr, "kernel_launch: cannot get %d bytes of dynamic LDS\n", LDS_BYTES); grid = -1; return; }
        int dev = 0, cus = 0, per_cu = 0;
        (void)hipGetDevice(&dev); (void)hipDeviceGetAttribute(&cus, hipDeviceAttributeMultiprocessorCount, dev);
        (void)hipOccupancyMaxActiveBlocksPerMultiprocessor(&per_cu, (const void*)mk_fwd, NTHR, LDS_BYTES);
        if (per_cu < 1 || cus < 1) { fprintf(stderr, "kernel_launch: occupancy query says %d workgroups per CU on %d CUs; nothing launched\n", per_cu, cus); grid = -1; return; }
        grid = cus;
    }
    if (grid < 0) return;
    (void)hipMemsetAsync(d_ws, 0, CTL_ZERO_BYTES, stream);
    int lo = PH_P0, hi = PH_COUNT, li = 0, dbg = 0; void* args[] = {&p, &lo, &hi, &li, &dbg};
    const hipError_t e = hipLaunchCooperativeKernel((const void*)mk_fwd, dim3(grid), dim3(NTHR), args, LDS_BYTES, stream);
    if (e != hipSuccess) fprintf(stderr, "kernel_launch: cooperative launch failed: %s (grid %d)\n", hipGetErrorString(e), grid);
}
```
